# Optimizing an MI355X kernel written in HIP

```python
import jax, jax.numpy as jnp
from jax import lax
import numpy as np

D_MODEL = 1024
BATCH = 2
SEQ = 16384
DEPTH = 4
DEC_BATCH = 8
DEC_SEQ = 8192
PAST_LEN = 128

D_MIX = D_MODEL
HEAD_DIM = 64
D_CONV = D_MIX // 2
D_FOURIER = D_MIX - D_CONV
N_CONV_HEADS = D_CONV // HEAD_DIM
N_FOURIER_GROUPS = D_FOURIER // HEAD_DIM
CONV_WIDTH = 3
D_FF = 4 * D_MODEL
D_IN_PROJ = 3 * D_CONV + D_FOURIER
EPS = 1e-6

kernel_name = "hybrid_shortconv_fnet_encoder"


def rms_norm(x, g):
    xf = x.astype(jnp.float32)
    y = xf * lax.rsqrt(jnp.mean(xf * xf, axis=-1, keepdims=True) + EPS)
    return (y * g.astype(jnp.float32)).astype(x.dtype)


def head_rms_norm(u, g, n_heads):
    b, s, d = u.shape
    uf = u.astype(jnp.float32).reshape(b, s, n_heads, d // n_heads)
    uf = uf * lax.rsqrt(jnp.mean(uf * uf, axis=-1, keepdims=True) + EPS)
    return (uf.reshape(b, s, d) * g.astype(jnp.float32)).astype(u.dtype)


def short_conv_mixer(u, conv_w):
    gate_b, gate_c, v = jnp.split(u, 3, axis=-1)
    z = gate_c * v
    zp = jnp.pad(z, ((0, 0), (1, 1), (0, 0)))
    conv = zp[:, :-2] * conv_w[0] + zp[:, 1:-1] * conv_w[1] + zp[:, 2:] * conv_w[2]
    return gate_b * conv


def fourier_mixer(u):
    b, s, d = u.shape
    ug = u.astype(jnp.float32).reshape(b, s, N_FOURIER_GROUPS, HEAD_DIM)
    yg = jnp.fft.fftn(ug, axes=(1, 3), norm="ortho").real
    return yg.reshape(b, s, d).astype(u.dtype)


def encoder_layer(x, g_mix_pre, w_in, conv_w, g_conv_out, g_fourier_out, w_out,
                  g_mix_post, g_mlp_pre, w_up, w_down, g_mlp_post):
    h = rms_norm(x, g_mix_pre)
    p = jnp.einsum("bsd,de->bse", h, w_in)
    yc = short_conv_mixer(p[..., :3 * D_CONV], conv_w)
    yf = fourier_mixer(p[..., 3 * D_CONV:])
    merged = jnp.concatenate(
        [head_rms_norm(yc, g_conv_out, N_CONV_HEADS),
         head_rms_norm(yf, g_fourier_out, N_FOURIER_GROUPS)], axis=-1)
    m = jnp.einsum("bse,ed->bsd", merged, w_out)
    x = x + rms_norm(m, g_mix_post)
    h2 = rms_norm(x, g_mlp_pre)
    a = jax.nn.relu(jnp.einsum("bsd,df->bsf", h2, w_up))
    f = jnp.einsum("bsf,fd->bsd", a * a, w_down)
    return x + rms_norm(f, g_mlp_post)


def run_trunk(x, g_mix_pre, w_in, conv_w, g_conv_out, g_fourier_out, w_out,
              g_mix_post, g_mlp_pre, w_up, w_down, g_mlp_post):
    for l in range(DEPTH):
        x = encoder_layer(x, g_mix_pre[l], w_in[l], conv_w[l], g_conv_out[l],
                          g_fourier_out[l], w_out[l], g_mix_post[l], g_mlp_pre[l],
                          w_up[l], w_down[l], g_mlp_post[l])
    return x


def setup_inputs(seed: int = 0) -> dict:
    key = jax.random.key(seed)
    ks = jax.random.split(key, 13)
    f32 = jnp.float32

    def gain(k, d):
        return 1.0 + 0.05 * jax.random.normal(k, (DEPTH, d), f32)

    return {
        "x_prompt": jax.random.normal(ks[0], (BATCH, SEQ, D_MODEL), f32),
        "x_sample": jax.random.normal(ks[1], (DEC_BATCH, DEC_SEQ, D_MODEL), f32),
        "g_mix_pre": gain(ks[2], D_MODEL),
        "w_in": jax.random.normal(ks[3], (DEPTH, D_MODEL, D_IN_PROJ), f32) * D_MODEL ** -0.5,
        "conv_w": jax.random.normal(ks[4], (DEPTH, CONV_WIDTH, D_CONV), f32) * CONV_WIDTH ** -0.5,
        "g_conv_out": gain(ks[5], D_CONV),
        "g_fourier_out": gain(ks[6], D_FOURIER),
        "w_out": jax.random.normal(ks[7], (DEPTH, D_MIX, D_MODEL), f32) * D_MIX ** -0.5,
        "g_mix_post": gain(ks[8], D_MODEL),
        "g_mlp_pre": gain(ks[9], D_MODEL),
        "w_up": jax.random.normal(ks[10], (DEPTH, D_MODEL, D_FF), f32) * D_MODEL ** -0.5,
        "w_down": jax.random.normal(ks[11], (DEPTH, D_FF, D_MODEL), f32) * D_FF ** -0.5,
        "g_mlp_post": gain(ks[12], D_MODEL),
    }


def reference(x_prompt, x_sample, g_mix_pre, w_in, conv_w, g_conv_out, g_fourier_out,
              w_out, g_mix_post, g_mlp_pre, w_up, w_down, g_mlp_post):
    y_prompt = run_trunk(x_prompt, g_mix_pre, w_in, conv_w, g_conv_out, g_fourier_out,
                         w_out, g_mix_post, g_mlp_pre, w_up, w_down, g_mlp_post)
    y_sample = run_trunk(x_sample, g_mix_pre, w_in, conv_w, g_conv_out, g_fourier_out,
                         w_out, g_mix_post, g_mlp_pre, w_up, w_down, g_mlp_post)
    return (y_prompt, y_sample)
```

```cpp
#include <hip/hip_runtime.h>
#include <hip/hip_cooperative_groups.h>
#include <cstdio>
namespace cg = cooperative_groups;

#define LAS __attribute__((address_space(3)))
typedef unsigned short bf16_t;
typedef short bf16x8 __attribute__((ext_vector_type(8)));
typedef float f32x4 __attribute__((ext_vector_type(4)));
typedef float f32x2 __attribute__((ext_vector_type(2)));
typedef unsigned u32x4 __attribute__((ext_vector_type(4)));
typedef unsigned u32x2 __attribute__((ext_vector_type(2)));

constexpr int D = 1024, DIN = 2048, DFF = 4096, NL = 4;
constexpr int SP = 16384, BP = 2, SS = 8192, BS = 8;
constexpr int TP = BP * SP, TS = BS * SS, T = TP + TS;
constexpr float EPS = 1e-6f;
constexpr int NCH = 2;
constexpr int TCH = T / NCH;

constexpr size_t MiB = (size_t)1 << 20;
constexpr size_t WS_W = 1 * MiB;
constexpr size_t WL_IN = 0, WL_OUT = 4 * MiB, WL_UP = 6 * MiB, WL_DN = 14 * MiB, WL_SZ = 22 * MiB;
constexpr size_t WS_H = WS_W + NL * WL_SZ;
constexpr size_t WS_R = WS_H + (size_t)T * D * 2;
constexpr size_t WS_P = WS_R;
constexpr size_t WS_INTER = WS_R + (size_t)T * DIN * 2;
constexpr size_t WS_M = WS_R;
constexpr size_t WS_A = WS_R;
constexpr size_t WS_F = WS_INTER;
constexpr size_t WS_END = WS_INTER + (size_t)T * 256 * 8;

constexpr int LDS_STAGE = 131072, LDS_MISC = LDS_STAGE, LDS_BYTES = LDS_STAGE + 4096;
constexpr int NTHREADS = 512, NWAVES = 8;

struct Params {
    const float* xp; const float* xs; const float* g_mix_pre; const float* w_in; const float* conv_w;
    const float* g_conv_out; const float* g_fourier_out; const float* w_out; const float* g_mix_post;
    const float* g_mlp_pre; const float* w_up; const float* w_down; const float* g_mlp_post;
    float* out; unsigned char* ws;
};

__device__ __forceinline__ unsigned cvt_pk_bf16(float lo, float hi) { unsigned r; asm volatile("v_cvt_pk_bf16_f32 %0, %1, %2" : "=v"(r) : "v"(lo), "v"(hi)); return r; }
__device__ __forceinline__ float bf_lo(unsigned w) { return __uint_as_float(w << 16); }
__device__ __forceinline__ float bf_hi(unsigned w) { return __uint_as_float(w & 0xffff0000u); }
__device__ __forceinline__ float wave_sum(float v) {
#pragma unroll
    for (int o = 1; o < 64; o <<= 1) v += __shfl_xor(v, o);
    return v;
}
__device__ __forceinline__ void load8(const bf16_t* ptr, float (&v)[8]) {
    const u32x4 q = *(const u32x4*)ptr;
    v[0] = bf_lo(q.x); v[1] = bf_hi(q.x); v[2] = bf_lo(q.y); v[3] = bf_hi(q.y); v[4] = bf_lo(q.z); v[5] = bf_hi(q.z); v[6] = bf_lo(q.w); v[7] = bf_hi(q.w);
}

namespace pg8 {
constexpr int BM = 256, BK = 64, HALF = 128, HTB = HALF * BK * 2, STAGE_BYTES = 8 * HTB, NXCD = 8, WGM = 8;
__device__ __forceinline__ int lds_byte(int r, int c) { const int st = (r >> 4) * 2 + (c >> 5), rr = r & 15, cc = c & 31, ob = rr * 64 + cc * 2; return st * 1024 + (ob ^ (((ob >> 9) & 1) << 5)); }
__device__ __forceinline__ void stage_rc(int b, int& R, int& C) { const int st = b / 1024, sb = b % 1024, swz = sb ^ (((sb >> 9) & 1) << 5); R = (st >> 1) * 16 + swz / 64; C = (st & 1) * 32 + (swz % 64) / 2; }
__device__ __forceinline__ int perm32(int rho) { const int n = rho >> 4, i = rho & 15; return 8 * (i >> 2) + 4 * n + (i & 3); }

struct Unit { int pm, pn; };
struct Gemm { const bf16_t* A; const bf16_t* Bt; int M, N, K; };

struct StaticOrder {
    int nM, nN, nwg, G, c;
    __device__ void init(int M, int N, int G_, int c_) { nM = M / BM; nN = N / BM; nwg = nM * nN; G = G_; c = c_; }
    __device__ bool next(int i, Unit& u) const {
        const long L = (long)i * G + c; if (L >= nwg) return false;
        int wgid = (int)L; { const int q = nwg / NXCD, r = nwg % NXCD, xcd = wgid % NXCD, off = wgid / NXCD; wgid = (xcd < r ? xcd * (q + 1) : r * (q + 1) + (xcd - r) * q) + off; }
        const int nig = WGM * nN, gid = wgid / nig, fm = gid * WGM, gsz = (nM - fm) < WGM ? (nM - fm) : WGM;
        u.pm = fm + ((wgid % nig) % gsz); u.pn = (wgid % nig) / gsz; return true;
    }
};

struct EpiBf16 {
    bf16_t* O; int ldc; int act;
    __device__ __forceinline__ void operator()(const f32x4 (&acc)[2][2][4][2], const Unit& u, int wr, int wc, int fr, int fq) const {
        const int row0 = u.pm * BM + wr * 64 + fr; const int col0 = u.pn * BM + wc * 32 + 8 * fq;
#pragma unroll
        for (int ai = 0; ai < 2; ++ai)
#pragma unroll
            for (int m = 0; m < 4; ++m) { bf16_t* rowp = O + (size_t)(row0 + ai * HALF + m * 16) * ldc + col0;
#pragma unroll
                for (int bj = 0; bj < 2; ++bj) { f32x4 v0 = acc[ai][bj][m][0], v1 = acc[ai][bj][m][1];
                    if (act) {
#pragma unroll
                        for (int j = 0; j < 4; ++j) { const float a0 = fmaxf(v0[j], 0.f), a1 = fmaxf(v1[j], 0.f); v0[j] = a0 * a0; v1[j] = a1 * a1; } }
                    u32x4 w; w.x = cvt_pk_bf16(v0[0], v0[1]); w.y = cvt_pk_bf16(v0[2], v0[3]); w.z = cvt_pk_bf16(v1[0], v1[1]); w.w = cvt_pk_bf16(v1[2], v1[3]);
                    *(u32x4*)(rowp + bj * HALF) = w; } }
    }
};

template <class Epi, class Sched>
__device__ __forceinline__ void gemm_phase(LAS unsigned char* lds, const Gemm g, const Sched& S, const Epi& E) {
    int tid_ = threadIdx.x; asm volatile("" : "+v"(tid_));
    const int tid = tid_, wid = __builtin_amdgcn_readfirstlane(tid >> 6), lane = tid & 63, wr = wid >> 2, wc = wid & 3, fr = lane & 15, fq = lane >> 4;
    const int K = g.K, nt = K / BK;
    unsigned voffA[2], voffB[2];
#pragma unroll
    for (int i = 0; i < 2; ++i) { int R, C; stage_rc(tid * 16 + i * 8192, R, C); const int Rb = (R & ~31) + perm32(R & 31);
        voffA[i] = (unsigned)(R * K + C) * 2u; voffB[i] = (unsigned)(Rb * K + C) * 2u; }
    const size_t kstep = (size_t)(BK * 2);
    const size_t hstep = (size_t)HALF * K * 2;
    const size_t tstep = 2 * hstep;
    const unsigned ldsw = (unsigned)wid * 1024u;
    const int aoff = lds_byte(wr * 64 + fr, fq * 8), boff = lds_byte(wc * 32 + fr, fq * 8);
#define PG8_SA(b, h) (((b) * 2 + (h)) * HTB)
#define PG8_SB(b, h) ((4 + (b) * 2 + (h)) * HTB)
#define PG8_STAGE(bufoff, gbase, voff) do { _Pragma("unroll") for (int _i = 0; _i < 2; ++_i) \
        __builtin_amdgcn_global_load_lds((const unsigned*)((const char*)(gbase) + (voff)[_i]), (LAS unsigned*)(lds + (bufoff) + ldsw + _i * 8192), 16, 0, 0); } while (0)
#define PG8_LDA(dst, b, h) do { _Pragma("unroll") for (int m = 0; m < 4; ++m) _Pragma("unroll") for (int k = 0; k < 2; ++k) dst[m][k] = *(const LAS bf16x8*)(lds + PG8_SA(b, h) + aoff + m * 2048 + k * 1024); } while (0)
#define PG8_LDB(dst, b, h) do { _Pragma("unroll") for (int n = 0; n < 2; ++n) _Pragma("unroll") for (int k = 0; k < 2; ++k) dst[n][k] = *(const LAS bf16x8*)(lds + PG8_SB(b, h) + boff + n * 2048 + k * 1024); } while (0)
#define PG8_MMA(ai, bj, At, Bt) do { __builtin_amdgcn_s_setprio(1); _Pragma("unroll") for (int m = 0; m < 4; ++m) _Pragma("unroll") for (int n = 0; n < 2; ++n) _Pragma("unroll") for (int k = 0; k < 2; ++k) \
        acc[ai][bj][m][n] = __builtin_amdgcn_mfma_f32_16x16x32_bf16(Bt[n][k], At[m][k], acc[ai][bj][m][n], 0, 0, 0); __builtin_amdgcn_s_setprio(0); } while (0)
#define PG8_WAIT_V(n) asm volatile("s_waitcnt vmcnt(" #n ")" ::: "memory")
#define PG8_WAIT_L(n) asm volatile("s_waitcnt lgkmcnt(" #n ")" ::: "memory")
#define PG8_BAR __builtin_amdgcn_s_barrier()
#define PG8_SCHED __builtin_amdgcn_sched_barrier(0)
    Unit cur, nxt; int ui = 0;
    if (!S.next(0, cur)) return;
    f32x4 acc[2][2][4][2];
#pragma unroll
    for (int a = 0; a < 2; ++a)
#pragma unroll
        for (int b = 0; b < 2; ++b)
#pragma unroll
            for (int m = 0; m < 4; ++m)
#pragma unroll
                for (int n = 0; n < 2; ++n) acc[a][b][m][n] = (f32x4){0.f, 0.f, 0.f, 0.f};
    bf16x8 At[4][2], B0[2][2], B1[2][2];
    const char* cA = (const char*)g.A + (size_t)cur.pm * tstep; const char* cB = (const char*)g.Bt + (size_t)cur.pn * tstep;
    PG8_STAGE(PG8_SB(0, 0), cB, voffB); PG8_STAGE(PG8_SA(0, 0), cA, voffA); PG8_STAGE(PG8_SB(0, 1), cB + hstep, voffB); PG8_STAGE(PG8_SA(0, 1), cA + hstep, voffA);
    if (wr == 1) PG8_BAR;
    PG8_WAIT_V(4); PG8_BAR;
    PG8_STAGE(PG8_SB(1, 0), cB + kstep, voffB); PG8_STAGE(PG8_SA(1, 0), cA + kstep, voffA); PG8_STAGE(PG8_SB(1, 1), cB + hstep + kstep, voffB);
    PG8_WAIT_V(6); PG8_BAR;
    for (;;) {
        const bool has_next = S.next(ui + 1, nxt);
        const char* nA = has_next ? (const char*)g.A + (size_t)nxt.pm * tstep : cA; const char* nB = has_next ? (const char*)g.Bt + (size_t)nxt.pn * tstep : cB;
        for (int t = 0; t < nt; t += 2) {
            const bool last = (t == nt - 2);
            const char* a1 = cA + (size_t)(t + 1) * kstep;
            const char* a2 = last ? nA : cA + (size_t)(t + 2) * kstep; const char* b2 = last ? nB : cB + (size_t)(t + 2) * kstep;
            const char* a3 = a2 + kstep; const char* b3 = b2 + kstep;
            PG8_LDB(B0, 0, 0); PG8_SCHED; PG8_LDA(At, 0, 0); PG8_STAGE(PG8_SA(1, 1), a1 + hstep, voffA);
            PG8_WAIT_L(8); PG8_BAR; PG8_WAIT_L(0); PG8_MMA(0, 0, At, B0); PG8_BAR; PG8_SCHED;
            PG8_LDB(B1, 0, 1); PG8_STAGE(PG8_SB(0, 0), b2, voffB);
            PG8_BAR; PG8_WAIT_L(0); PG8_MMA(0, 1, At, B1); PG8_BAR;
            PG8_LDA(At, 0, 1); PG8_STAGE(PG8_SA(0, 0), a2, voffA);
            PG8_BAR; PG8_WAIT_L(0); PG8_MMA(1, 0, At, B0); PG8_BAR; PG8_SCHED;
            PG8_STAGE(PG8_SB(0, 1), b2 + hstep, voffB);
            PG8_WAIT_V(6); PG8_BAR; PG8_MMA(1, 1, At, B1); PG8_BAR;
            PG8_LDB(B0, 1, 0); PG8_SCHED; PG8_LDA(At, 1, 0); PG8_STAGE(PG8_SA(0, 1), a2 + hstep, voffA);
            PG8_WAIT_L(8); PG8_BAR; PG8_WAIT_L(0); PG8_MMA(0, 0, At, B0); PG8_BAR; PG8_SCHED;
            PG8_LDB(B1, 1, 1); PG8_STAGE(PG8_SB(1, 0), b3, voffB);
            PG8_BAR; PG8_WAIT_L(0); PG8_MMA(0, 1, At, B1); PG8_BAR;
            PG8_LDA(At, 1, 1); PG8_STAGE(PG8_SA(1, 0), a3, voffA);
            PG8_BAR; PG8_WAIT_L(0); PG8_MMA(1, 0, At, B0); PG8_BAR; PG8_SCHED;
            PG8_STAGE(PG8_SB(1, 1), b3 + hstep, voffB);
            PG8_WAIT_V(6); PG8_BAR; PG8_MMA(1, 1, At, B1); PG8_BAR;
        }
        E(acc, cur, wr, wc, fr, fq);
        if (!has_next) break;
#pragma unroll
        for (int a = 0; a < 2; ++a)
#pragma unroll
            for (int b = 0; b < 2; ++b)
#pragma unroll
                for (int m = 0; m < 4; ++m)
#pragma unroll
                    for (int n = 0; n < 2; ++n) acc[a][b][m][n] = (f32x4){0.f, 0.f, 0.f, 0.f};
        cur = nxt; cA = nA; cB = nB; ++ui;
    }
    PG8_WAIT_V(0);
    if (wr == 0) PG8_BAR;
    PG8_BAR;
#undef PG8_SA
#undef PG8_SB
#undef PG8_STAGE
#undef PG8_LDA
#undef PG8_LDB
#undef PG8_MMA
#undef PG8_WAIT_V
#undef PG8_WAIT_L
#undef PG8_BAR
#undef PG8_SCHED
}
}

__device__ __forceinline__ void p0_transpose_item(const float* W, int K, int ldN, int nblk, bf16_t* WT, const float* gain, LAS float* scr, int item, int lane) {
    const int kb = item / nblk, nb = item % nblk, k0 = 64 * kb, n0 = 32 * nb;
#pragma unroll 8
    for (int i = 0; i < 32; ++i) { const int kk = 2 * i + (lane >> 5); const float gk = gain ? gain[k0 + kk] : 1.f;
        scr[kk * 33 + (lane & 31)] = W[(size_t)(k0 + kk) * ldN + n0 + (lane & 31)] * gk; }
    asm volatile("s_waitcnt lgkmcnt(0)" ::: "memory");
    const int c = lane & 7;
#pragma unroll
    for (int j = 0; j < 4; ++j) { const int n = (lane >> 3) + 8 * j; const LAS float* s = scr + (8 * c) * 33 + n;
        u32x4 o; o.x = cvt_pk_bf16(s[0 * 33], s[1 * 33]); o.y = cvt_pk_bf16(s[2 * 33], s[3 * 33]); o.z = cvt_pk_bf16(s[4 * 33], s[5 * 33]); o.w = cvt_pk_bf16(s[6 * 33], s[7 * 33]);
        *(u32x4*)(WT + (size_t)(n0 + n) * K + k0 + 8 * c) = o; }
    asm volatile("s_waitcnt lgkmcnt(0)" ::: "memory");
}
__device__ __forceinline__ void p0_fold_item(const float* Win  , const float* gpre, bf16_t* WT  , const LAS float* tab, int item, int lane) {
    const int kb = item >> 3, g = item & 7, k = kb * 64 + lane;
    const float gk = gpre[k] * 0.125f;
    const f32x4* src = (const f32x4*)(Win + (size_t)k * DIN + 1536 + g * 64);
    float row[64];
#pragma unroll
    for (int i = 0; i < 16; ++i) { const f32x4 v = src[i]; row[4 * i] = v.x * gk; row[4 * i + 1] = v.y * gk; row[4 * i + 2] = v.z * gk; row[4 * i + 3] = v.w * gk; }
    for (int j = 0; j < 64; ++j) {
        const int cj = (j == 0) ? 0 : (j == 1 ? 32 : (j >> 1)), off = (j >= 2 && (j & 1)) ? 16 : 0;
        float acc = 0.f;
#pragma unroll
        for (int d = 0; d < 64; ++d) acc += row[d] * tab[(cj * d + off) & 63];
        WT[(size_t)(1536 + g * 64 + j) * D + k] = (bf16_t)(cvt_pk_bf16(acc, 0.f) & 0xffffu);
    }
}
__device__ __forceinline__ void rms_row_to_bf16(const float* xrow, bf16_t* orow, int lane) {
    const f32x4* xr = (const f32x4*)xrow + lane;
    f32x4 v[4]; float s = 0.f;
#pragma unroll
    for (int j = 0; j < 4; ++j) { v[j] = xr[64 * j]; s += (v[j].x * v[j].x + v[j].y * v[j].y) + (v[j].z * v[j].z + v[j].w * v[j].w); }
    const float rstd = rsqrtf(wave_sum(s) * (1.f / D) + EPS);
    u32x2* o8 = (u32x2*)orow + lane;
#pragma unroll
    for (int j = 0; j < 4; ++j) { u32x2 w; w.x = cvt_pk_bf16(v[j].x * rstd, v[j].y * rstd); w.y = cvt_pk_bf16(v[j].z * rstd, v[j].w * rstd); o8[64 * j] = w; }
}

__device__ __forceinline__ void row_pass_row(const float* xrow, const bf16_t* mrow, const float* gain, float* xdst, bf16_t* hdst, bool write_h, int lane) {
    const f32x4* xr = (const f32x4*)xrow + lane; const u32x2* mr = (const u32x2*)mrow + lane; const f32x4* gr = (const f32x4*)gain + lane;
    f32x4 x[4], m[4]; float s = 0.f;
#pragma unroll
    for (int j = 0; j < 4; ++j) { x[j] = xr[64 * j]; const u32x2 w = mr[64 * j]; m[j] = (f32x4){bf_lo(w.x), bf_hi(w.x), bf_lo(w.y), bf_hi(w.y)};
        s += (m[j].x * m[j].x + m[j].y * m[j].y) + (m[j].z * m[j].z + m[j].w * m[j].w); }
    const float rm = rsqrtf(wave_sum(s) * (1.f / D) + EPS);
    float s1 = 0.f;
#pragma unroll
    for (int j = 0; j < 4; ++j) { const f32x4 gg = gr[64 * j]; x[j] = x[j] + m[j] * rm * gg; s1 += (x[j].x * x[j].x + x[j].y * x[j].y) + (x[j].z * x[j].z + x[j].w * x[j].w); }
    f32x4* xo = (f32x4*)xdst + lane;
#pragma unroll
    for (int j = 0; j < 4; ++j) xo[64 * j] = x[j];
    if (write_h) {
        const float r1 = rsqrtf(wave_sum(s1) * (1.f / D) + EPS);
        u32x2* o8 = (u32x2*)hdst + lane;
#pragma unroll
        for (int j = 0; j < 4; ++j) { u32x2 w; w.x = cvt_pk_bf16(x[j].x * r1, x[j].y * r1); w.y = cvt_pk_bf16(x[j].z * r1, x[j].w * r1); o8[64 * j] = w; }
    }
}

__device__ __forceinline__ void conv_wave_item(const bf16_t* p, const float* cw, bf16_t* Hm, int t0, int pos0, int S, int lane) {
    float w0[8], w1[8], w2[8];
    { const f32x4* a = (const f32x4*)(cw + lane * 8); const f32x4* b = (const f32x4*)(cw + 512 + lane * 8); const f32x4* c = (const f32x4*)(cw + 1024 + lane * 8);
#pragma unroll
      for (int h = 0; h < 2; ++h) { const f32x4 va = a[h], vb = b[h], vc = c[h];
#pragma unroll
        for (int k = 0; k < 4; ++k) { w0[4 * h + k] = va[k]; w1[4 * h + k] = vb[k]; w2[4 * h + k] = vc[k]; } } }
    float zp[8], zc[8], zn[8], ga[8], gb[8];
    const bf16_t* base = p + (size_t)t0 * DIN + lane * 8;
    if (pos0 == 0) {
#pragma unroll
        for (int k = 0; k < 8; ++k) zp[k] = 0.f;
    } else { load8(base - DIN + 512, ga); load8(base - DIN + 1024, gb);
#pragma unroll
        for (int k = 0; k < 8; ++k) zp[k] = ga[k] * gb[k]; }
    load8(base + 512, ga); load8(base + 1024, gb);
#pragma unroll
    for (int k = 0; k < 8; ++k) zc[k] = ga[k] * gb[k];
#pragma unroll 4
    for (int i = 0; i < 16; ++i) {
        const bf16_t* r = base + (size_t)i * DIN;
        if (pos0 + i + 1 == S) {
#pragma unroll
            for (int k = 0; k < 8; ++k) zn[k] = 0.f;
        } else { load8(r + DIN + 512, ga); load8(r + DIN + 1024, gb);
#pragma unroll
            for (int k = 0; k < 8; ++k) zn[k] = ga[k] * gb[k]; }
        load8(r, gb);
        float y[8], ss = 0.f;
#pragma unroll
        for (int k = 0; k < 8; ++k) { y[k] = gb[k] * (zp[k] * w0[k] + zc[k] * w1[k] + zn[k] * w2[k]); ss += y[k] * y[k]; }
        ss += __shfl_xor(ss, 1); ss += __shfl_xor(ss, 2); ss += __shfl_xor(ss, 4);
        const float rs = rsqrtf(ss * (1.f / 64.f) + EPS);
        u32x4 o; o.x = cvt_pk_bf16(y[0] * rs, y[1] * rs); o.y = cvt_pk_bf16(y[2] * rs, y[3] * rs); o.z = cvt_pk_bf16(y[4] * rs, y[5] * rs); o.w = cvt_pk_bf16(y[6] * rs, y[7] * rs);
        *(u32x4*)(Hm + (size_t)(t0 + i) * D + lane * 8) = o;
#pragma unroll
        for (int k = 0; k < 8; ++k) { zp[k] = zc[k]; zc[k] = zn[k]; }
    }
}

__device__ __forceinline__ LAS f32x2* fft_stages(LAS f32x2* X, LAS f32x2* Y, const LAS f32x2* tw, int ntile, int log2n, int tid) {
    const int n = 1 << log2n, half = n >> 1, twsh = 7 - log2n;
    const int total = ntile * half * 32;
    for (int st = 0; st < log2n; ++st) {
        const int s = 1 << st;
        for (int idx = tid; idx < total; idx += NTHREADS) {
            const int c = idx & 31, jj = idx >> 5, tile = jj >> (log2n - 1), j = jj & (half - 1);
            const int p = j >> st, base = tile * n * 32;
            const f32x2 a = X[base + j * 32 + c], b = X[base + (j + half) * 32 + c];
            const f32x2 w = tw[(p << st) << twsh];
            const f32x2 sm = a + b, df = a - b;
            const int o = base + (j + s * p) * 32 + c;
            Y[o] = sm;
            Y[o + s * 32] = (f32x2){df.x * w.x - df.y * w.y, df.x * w.y + df.y * w.x};
        }
        __syncthreads();
        LAS f32x2* t = X; X = Y; Y = t;
    }
    return X;
}
__device__ __forceinline__ int seq_base(int bs) { return bs < BP ? bs * SP : TP + (bs - BP) * SS; }

__device__ __forceinline__ void fft_pass1_item(const bf16_t* p, f32x2* inter, LAS unsigned char* lds, const LAS f32x2* tw, int item, int tid) {
    int bs, g, n2, S, log2N2;
    if (item < 2048) { bs = item >> 10; const int r = item & 1023; n2 = r >> 3; g = r & 7; S = SP; log2N2 = 7; }
    else { const int it = item - 2048; bs = BP + (it >> 9); const int r = it & 511; n2 = r >> 3; g = r & 7; S = SS; log2N2 = 6; }
    const int N2 = 1 << log2N2, tb = seq_base(bs);
    LAS f32x2* X = (LAS f32x2*)lds; LAS f32x2* Y = (LAS f32x2*)(lds + 65536);
#pragma unroll
    for (int i = 0; i < 2; ++i) { const int q = tid + NTHREADS * i, row = q >> 3, ch = q & 7;
        const u32x4 v = *(const u32x4*)(p + (size_t)(tb + N2 * row + n2) * DIN + 1536 + g * 64 + ch * 8);
        LAS f32x4* dst = (LAS f32x4*)(X + row * 32 + ch * 4);
        dst[0] = (f32x4){bf_lo(v.x), bf_hi(v.x), bf_lo(v.y), bf_hi(v.y)}; dst[1] = (f32x4){bf_lo(v.z), bf_hi(v.z), bf_lo(v.w), bf_hi(v.w)}; }
    __syncthreads();
    const LAS f32x2* R = fft_stages(X, Y, tw, 1, 7, tid);
    f32x2* ob = inter + (size_t)tb * 256 + (size_t)g * S * 32;
    const float invS = 1.f / (float)S;
#pragma unroll
    for (int i = 0; i < 8; ++i) { const int idx = tid + NTHREADS * i, c = idx & 31, k1 = idx >> 5;
        const f32x2 v = R[k1 * 32 + c];
        float sn, cs; sincospif(-2.0f * (float)(n2 * k1) * invS, &sn, &cs);
        ob[(size_t)(k1 * N2 + n2) * 32 + c] = (f32x2){v.x * cs - v.y * sn, v.x * sn + v.y * cs}; }
    __syncthreads();
}

__device__ __forceinline__ void fft_pass2_item(const f32x2* inter, bf16_t* Hm, LAS unsigned char* lds, const LAS f32x2* tw, int item, int tid) {
    int bs, g, ip, S, log2N2;
    if (item < 1024) { bs = item >> 9; const int r = item & 511; g = r >> 6; ip = r & 63; S = SP; log2N2 = 7; }
    else { const int it = item - 1024; bs = BP + (it >> 9); const int r = it & 511; g = r >> 6; ip = r & 63; S = SS; log2N2 = 6; }
    const int N2 = 1 << log2N2, tb = seq_base(bs);
    const int k1a = ip == 0 ? 0 : ip, k1b = ip == 0 ? 64 : 128 - ip;
    LAS f32x2* X = (LAS f32x2*)lds; LAS f32x2* Y = (LAS f32x2*)(lds + 65536);
    const f32x2* ib = inter + (size_t)tb * 256 + (size_t)g * S * 32;
    const int chunks = N2 * 16;
    for (int idx = tid; idx < 2 * chunks; idx += NTHREADS) { const int h = idx >= chunks, r = idx - h * chunks;
        const f32x4 v = ((const f32x4*)(ib + (size_t)((h ? k1b : k1a) * N2) * 32))[r];
        ((LAS f32x4*)(X + h * N2 * 32))[r] = v; }
    __syncthreads();
    const LAS f32x2* R = fft_stages(X, Y, tw, 2, log2N2, tid);
    LAS bf16_t* Ost = (LAS bf16_t*)((R == X) ? Y : X);
    const float sc = rsqrtf((float)S);
    for (int idx = tid; idx < 2 * N2 * 32; idx += NTHREADS) {
        const int c = idx & 31, tl = idx >> 5, h = tl >> log2N2, k2 = tl & (N2 - 1);
        const int ph = (ip == 0) ? h : 1 - h;
        const int k2p = (ip == 0 && h == 0) ? ((N2 - k2) & (N2 - 1)) : (N2 - 1 - k2);
        const f32x2 own = R[(h * N2 + k2) * 32 + c], par = R[(ph * N2 + k2p) * 32 + c];
        float v1 = (c == 0) ? 0.5f * (own.x + par.x) : own.x, v2 = (c == 0) ? 0.5f * (own.y + par.y) : par.x;
        v1 *= sc; v2 *= sc;
        float ss = v1 * v1 + v2 * v2;
        ss += __shfl_xor(ss, 1); ss += __shfl_xor(ss, 2); ss += __shfl_xor(ss, 4); ss += __shfl_xor(ss, 8); ss += __shfl_xor(ss, 16);
        const float rs = rsqrtf(ss * (1.f / 64.f) + EPS);
        Ost[tl * 64 + c] = (bf16_t)(cvt_pk_bf16(v1 * rs, 0.f) & 0xffffu);
        Ost[tl * 64 + (c == 0 ? 32 : 64 - c)] = (bf16_t)(cvt_pk_bf16(v2 * rs, 0.f) & 0xffffu);
    }
    __syncthreads();
    for (int idx = tid; idx < 2 * N2 * 8; idx += NTHREADS) {
        const int tl = idx >> 3, ch = idx & 7, h = tl >> log2N2, k2 = tl & (N2 - 1);
        const int tok = tb + (h ? k1b : k1a) + 128 * k2;
        *(u32x4*)(Hm + (size_t)tok * D + 512 + g * 64 + ch * 8) = ((const LAS u32x4*)Ost)[idx];
    }
    __syncthreads();
}

__global__ void __launch_bounds__(NTHREADS, 2) fwd_megakernel(Params P) {
    extern __shared__ __attribute__((aligned(16))) unsigned char shm[];
    cg::grid_group grid = cg::this_grid();
    LAS unsigned char* lds = (LAS unsigned char*)shm;
    const int G = gridDim.x, bid = blockIdx.x, NGW = G * NWAVES;
#define FRESH() int tid = threadIdx.x; asm volatile("" : "+v"(tid)); const int lane = tid & 63, wave = __builtin_amdgcn_readfirstlane(tid >> 6), gw = bid * NWAVES + wave; (void)lane; (void)gw
#define TAB ((LAS float*)(lds + LDS_MISC))
#define TWD ((LAS f32x2*)(lds + LDS_MISC + 512))
    { FRESH();
      if (tid < 64) { TAB[tid] = cospif((float)tid * (1.f / 32.f)); float sn, cs; sincospif((float)tid * (1.f / 64.f), &sn, &cs); TWD[tid] = (f32x2){cs, -sn}; } }
    __syncthreads();

    unsigned char* ws = P.ws;
#define Hb ((bf16_t*)(ws + WS_H))
#define Pb ((bf16_t*)(ws + WS_P))
#define Ib ((f32x2*)(ws + WS_INTER))
#define Mb ((bf16_t*)(ws + WS_M))
#define Ab ((bf16_t*)(ws + WS_A))
#define Fb ((bf16_t*)(ws + WS_F))

    {
        FRESH();
        LAS float* scr = (LAS float*)(lds + wave * 8704);
        constexpr int I_IN = 16 * 48, I_OUT = 16 * 32, I_UP = 16 * 128, I_DN = 64 * 32, I_F = 128, I_L = I_IN + I_OUT + I_UP + I_DN + I_F;
        for (int it = gw; it < NL * I_L; it += NGW) {
            const int l = it / I_L; int r = it % I_L;
            bf16_t* Wl = (bf16_t*)(ws + WS_W + (size_t)l * WL_SZ);
            const float* win = P.w_in + (size_t)l * D * DIN;
            if (r < I_IN) { p0_transpose_item(win, D, DIN, 48, Wl + WL_IN / 2, P.g_mix_pre + l * D, scr, r, lane); continue; } r -= I_IN;
            if (r < I_OUT) {
                const int kb = r / 32; const float* gsrc = kb < 8 ? P.g_conv_out + l * 512 : P.g_fourier_out + l * 512 - 512;
                p0_transpose_item(P.w_out + (size_t)l * D * D, D, D, 32, Wl + WL_OUT / 2, gsrc, scr, r, lane); continue; } r -= I_OUT;
            if (r < I_UP) { p0_transpose_item(P.w_up + (size_t)l * D * DFF, D, DFF, 128, Wl + WL_UP / 2, P.g_mlp_pre + l * D, scr, r, lane); continue; } r -= I_UP;
            if (r < I_DN) { p0_transpose_item(P.w_down + (size_t)l * DFF * D, DFF, D, 32, Wl + WL_DN / 2, nullptr, scr, r, lane); continue; } r -= I_DN;
            p0_fold_item(win, P.g_mix_pre + l * D, Wl + WL_IN / 2, TAB, r, lane);
        }
        for (int t = gw; t < T; t += NGW) rms_row_to_bf16(t < TP ? P.xp + (size_t)t * D : P.xs + (size_t)(t - TP) * D, Hb + (size_t)t * D, lane);
    }
    grid.sync();

    for (int l = 0; l < NL; ++l) {
        const bf16_t* Wl = (const bf16_t*)(ws + WS_W + (size_t)l * WL_SZ);
        { pg8::Gemm g{Hb, Wl + WL_IN / 2, T, DIN, D}; pg8::StaticOrder S; S.init(T, DIN, G, bid); pg8::EpiBf16 E{Pb, DIN, 0};
          pg8::gemm_phase(lds, g, S, E); }
        grid.sync();
        {
            FRESH();
            constexpr int NCONV = T / 128, NP1 = 2048 + 4096;
            for (int it = bid; it < NCONV + NP1; it += G) {
                if (it < NCONV) { const int t0 = it * 128 + wave * 16; const int S = t0 < TP ? SP : SS; const int pos0 = t0 < TP ? (t0 & (SP - 1)) : ((t0 - TP) & (SS - 1));
                    conv_wave_item(Pb, P.conv_w + (size_t)l * 3 * 512, Hb, t0, pos0, S, lane); }
                else fft_pass1_item(Pb, Ib, lds, TWD, it - NCONV, tid);
            }
        }
        grid.sync();
        { FRESH();
          for (int it = bid; it < 1024 + 4096; it += G) fft_pass2_item(Ib, Hb, lds, TWD, it, tid); }
        grid.sync();
        { pg8::Gemm g{Hb, Wl + WL_OUT / 2, T, D, D}; pg8::StaticOrder S; S.init(T, D, G, bid); pg8::EpiBf16 E{Mb, D, 0};
          pg8::gemm_phase(lds, g, S, E); }
        grid.sync();
        { FRESH();
          for (int t = gw; t < T; t += NGW) {
            const float* xr = (l == 0) ? (t < TP ? P.xp + (size_t)t * D : P.xs + (size_t)(t - TP) * D) : P.out + (size_t)t * D;
            row_pass_row(xr, Mb + (size_t)t * D, P.g_mix_post + l * D, P.out + (size_t)t * D, Hb + (size_t)t * D, true, lane);
          } }
        grid.sync();
        for (int ch = 0; ch < NCH; ++ch) {
            { pg8::Gemm g{Hb + (size_t)ch * TCH * D, Wl + WL_UP / 2, TCH, DFF, D}; pg8::StaticOrder S; S.init(TCH, DFF, G, bid); pg8::EpiBf16 E{Ab, DFF, 1};
              pg8::gemm_phase(lds, g, S, E); }
            grid.sync();
            { pg8::Gemm g{Ab, Wl + WL_DN / 2, TCH, D, DFF}; pg8::StaticOrder S; S.init(TCH, D, G, bid); pg8::EpiBf16 E{Fb + (size_t)ch * TCH * D, D, 0};
              pg8::gemm_phase(lds, g, S, E); }
            grid.sync();
        }
        { FRESH();
          for (int t = gw; t < T; t += NGW)
            row_pass_row(P.out + (size_t)t * D, Fb + (size_t)t * D, P.g_mlp_post + l * D, P.out + (size_t)t * D, Hb + (size_t)t * D, l + 1 < NL, lane); }
        if (l + 1 < NL) grid.sync();
    }
}

extern "C" void kernel_launch(void* const* d_in, const int* in_sizes, int n_in, void* d_out, int out_size, void* d_ws, size_t ws_size, hipStream_t stream) {
    static int grid_blocks = 0;
    if (grid_blocks == 0) {
        if (n_in != 13 || out_size != T * D || ws_size < WS_END) { fprintf(stderr, "kernel_launch: unexpected shapes (n_in %d, out %d, ws %zu, need %zu)\n", n_in, out_size, ws_size, (size_t)WS_END); grid_blocks = -1; return; }
        int dev = 0, cus = 0, per_cu = 0;
        hipGetDevice(&dev);
        hipDeviceGetAttribute(&cus, hipDeviceAttributeMultiprocessorCount, dev);
        if (hipFuncSetAttribute((const void*)fwd_megakernel, hipFuncAttributeMaxDynamicSharedMemorySize, LDS_BYTES) != hipSuccess) { fprintf(stderr, "kernel_launch: hipFuncSetAttribute failed\n"); grid_blocks = -1; return; }
        hipOccupancyMaxActiveBlocksPerMultiprocessor(&per_cu, (const void*)fwd_megakernel, NTHREADS, LDS_BYTES);
        if (per_cu < 1) { fprintf(stderr, "kernel_launch: occupancy query says %d blocks per CU\n", per_cu); per_cu = 1; }
        grid_blocks = cus * per_cu;
    }
    if (grid_blocks < 0) return;
    Params p{};
    p.xp = (const float*)d_in[0]; p.xs = (const float*)d_in[1]; p.g_mix_pre = (const float*)d_in[2]; p.w_in = (const float*)d_in[3]; p.conv_w = (const float*)d_in[4];
    p.g_conv_out = (const float*)d_in[5]; p.g_fourier_out = (const float*)d_in[6]; p.w_out = (const float*)d_in[7]; p.g_mix_post = (const float*)d_in[8];
    p.g_mlp_pre = (const float*)d_in[9]; p.w_up = (const float*)d_in[10]; p.w_down = (const float*)d_in[11]; p.g_mlp_post = (const float*)d_in[12];
    p.out = (float*)d_out; p.ws = (unsigned char*)d_ws;
    void* args[] = {&p};
    hipError_t e = hipLaunchCooperativeKernel((const void*)fwd_megakernel, dim3(grid_blocks), dim3(NTHREADS), args, LDS_BYTES, stream);
    if (e != hipSuccess) fprintf(stderr, "cooperative launch failed: %s (grid %d)\n", hipGetErrorString(e), grid_blocks);
}
```

```cpp
#include <hip/hip_runtime.h>
#include <hip/hip_cooperative_groups.h>
#include <cstdio>
namespace cg = cooperative_groups;

#define LAS __attribute__((address_space(3)))
typedef unsigned short bf16_t;
typedef short bf16x8 __attribute__((ext_vector_type(8)));
typedef float f32x4 __attribute__((ext_vector_type(4)));
typedef float f32x2 __attribute__((ext_vector_type(2)));
typedef unsigned u32x4 __attribute__((ext_vector_type(4)));
typedef unsigned u32x2 __attribute__((ext_vector_type(2)));

constexpr int D = 1024, DIN = 2048, DFF = 4096, NL = 4;
constexpr int SP = 16384, BP = 2, SS = 8192, BS = 8;
constexpr int TP = BP * SP, TS = BS * SS, T = TP + TS;
constexpr float EPS = 1e-6f;
constexpr int NCH = 2;
constexpr int TCH = T / NCH;

constexpr size_t MiB = (size_t)1 << 20;
constexpr size_t WS_W = 1 * MiB;
constexpr size_t WL_IN = 0, WL_OUT = 4 * MiB, WL_UP = 6 * MiB, WL_DN = 14 * MiB, WL_SZ = 22 * MiB;
constexpr size_t WS_H = WS_W + NL * WL_SZ;
constexpr size_t WS_R = WS_H + (size_t)T * D * 2;
constexpr size_t WS_P = WS_R;
constexpr size_t WS_INTER = WS_R + (size_t)T * DIN * 2;
constexpr size_t WS_M = WS_R;
constexpr size_t WS_A = WS_R;
constexpr size_t WS_F = WS_INTER;
constexpr size_t WS_END = WS_INTER + (size_t)T * 256 * 8;

constexpr int LDS_STAGE = 131072, LDS_MISC = LDS_STAGE, LDS_BYTES = LDS_STAGE + 4096;
constexpr int NTHREADS = 512, NWAVES = 8;

struct Params {
    const float* xp; const float* xs; const float* g_mix_pre; const float* w_in; const float* conv_w;
    const float* g_conv_out; const float* g_fourier_out; const float* w_out; const float* g_mix_post;
    const float* g_mlp_pre; const float* w_up; const float* w_down; const float* g_mlp_post;
    float* out; unsigned char* ws;
};

__device__ __forceinline__ unsigned cvt_pk_bf16(float lo, float hi) { unsigned r; asm volatile("v_cvt_pk_bf16_f32 %0, %1, %2" : "=v"(r) : "v"(lo), "v"(hi)); return r; }
__device__ __forceinline__ float bf_lo(unsigned w) { return __uint_as_float(w << 16); }
__device__ __forceinline__ float bf_hi(unsigned w) { return __uint_as_float(w & 0xffff0000u); }
__device__ __forceinline__ float wave_sum(float v) {
#pragma unroll
    for (int o = 1; o < 64; o <<= 1) v += __shfl_xor(v, o);
    return v;
}
__device__ __forceinline__ void load8(const bf16_t* ptr, float (&v)[8]) {
    const u32x4 q = *(const u32x4*)ptr;
    v[0] = bf_lo(q.x); v[1] = bf_hi(q.x); v[2] = bf_lo(q.y); v[3] = bf_hi(q.y); v[4] = bf_lo(q.z); v[5] = bf_hi(q.z); v[6] = bf_lo(q.w); v[7] = bf_hi(q.w);
}

namespace pg8 {
constexpr int BM = 256, BK = 64, HALF = 128, HTB = HALF * BK * 2, STAGE_BYTES = 8 * HTB, NXCD = 8, WGM = 8;
__device__ __forceinline__ int lds_byte(int r, int c) { const int st = (r >> 4) * 2 + (c >> 5), rr = r & 15, cc = c & 31, ob = rr * 64 + cc * 2; return st * 1024 + (ob ^ (((ob >> 9) & 1) << 5)); }
__device__ __forceinline__ void stage_rc(int b, int& R, int& C) { const int st = b / 1024, sb = b % 1024, swz = sb ^ (((sb >> 9) & 1) << 5); R = (st >> 1) * 16 + swz / 64; C = (st & 1) * 32 + (swz % 64) / 2; }
__device__ __forceinline__ int perm32(int rho) { const int n = rho >> 4, i = rho & 15; return 8 * (i >> 2) + 4 * n + (i & 3); }

struct Unit { int pm, pn; };
struct Gemm { const bf16_t* A; const bf16_t* Bt; int M, N, K; };

struct StaticOrder {
    int nM, nN, nwg, G, c;
    __device__ void init(int M, int N, int G_, int c_) { nM = M / BM; nN = N / BM; nwg = nM * nN; G = G_; c = c_; }
    __device__ bool next(int i, Unit& u) const {
        const long L = (long)i * G + c; if (L >= nwg) return false;
        int wgid = (int)L; { const int q = nwg / NXCD, r = nwg % NXCD, xcd = wgid % NXCD, off = wgid / NXCD; wgid = (xcd < r ? xcd * (q + 1) : r * (q + 1) + (xcd - r) * q) + off; }
        const int nig = WGM * nN, gid = wgid / nig, fm = gid * WGM, gsz = (nM - fm) < WGM ? (nM - fm) : WGM;
        u.pm = fm + ((wgid % nig) % gsz); u.pn = (wgid % nig) / gsz; return true;
    }
};

struct EpiBf16 {
    bf16_t* O; int ldc; int act;
    __device__ __forceinline__ void operator()(const f32x4 (&acc)[2][2][4][2], const Unit& u, int wr, int wc, int fr, int fq) const {
        const int row0 = u.pm * BM + wr * 64 + fr; const int col0 = u.pn * BM + wc * 32 + 8 * fq;
#pragma unroll
        for (int ai = 0; ai < 2; ++ai)
#pragma unroll
            for (int m = 0; m < 4; ++m) { bf16_t* rowp = O + (size_t)(row0 + ai * HALF + m * 16) * ldc + col0;
#pragma unroll
                for (int bj = 0; bj < 2; ++bj) { f32x4 v0 = acc[ai][bj][m][0], v1 = acc[ai][bj][m][1];
                    if (act) {
#pragma unroll
                        for (int j = 0; j < 4; ++j) { const float a0 = fmaxf(v0[j], 0.f), a1 = fmaxf(v1[j], 0.f); v0[j] = a0 * a0; v1[j] = a1 * a1; } }
                    u32x4 w; w.x = cvt_pk_bf16(v0[0], v0[1]); w.y = cvt_pk_bf16(v0[2], v0[3]); w.z = cvt_pk_bf16(v1[0], v1[1]); w.w = cvt_pk_bf16(v1[2], v1[3]);
                    *(u32x4*)(rowp + bj * HALF) = w; } }
    }
};

template <class Epi, class Sched>
__device__ __forceinline__ void gemm_phase(LAS unsigned char* lds, const Gemm g, const Sched& S, const Epi& E) {
    int tid_ = threadIdx.x; asm volatile("" : "+v"(tid_));
    const int tid = tid_, wid = __builtin_amdgcn_readfirstlane(tid >> 6), lane = tid & 63, wr = wid >> 2, wc = wid & 3, fr = lane & 15, fq = lane >> 4;
    const int K = g.K, nt = K / BK;
    unsigned voffA[2], voffB[2];
#pragma unroll
    for (int i = 0; i < 2; ++i) { int R, C; stage_rc(tid * 16 + i * 8192, R, C); const int Rb = (R & ~31) + perm32(R & 31);
        voffA[i] = (unsigned)(R * K + C) * 2u; voffB[i] = (unsigned)(Rb * K + C) * 2u; }
    const size_t kstep = (size_t)(BK * 2);
    const size_t hstep = (size_t)HALF * K * 2;
    const size_t tstep = 2 * hstep;
    const unsigned ldsw = (unsigned)wid * 1024u;
    const int aoff = lds_byte(wr * 64 + fr, fq * 8), boff = lds_byte(wc * 32 + fr, fq * 8);
#define PG8_SA(b, h) (((b) * 2 + (h)) * HTB)
#define PG8_SB(b, h) ((4 + (b) * 2 + (h)) * HTB)
#define PG8_STAGE(bufoff, gbase, voff) do { _Pragma("unroll") for (int _i = 0; _i < 2; ++_i) \
        __builtin_amdgcn_global_load_lds((const unsigned*)((const char*)(gbase) + (voff)[_i]), (LAS unsigned*)(lds + (bufoff) + ldsw + _i * 8192), 16, 0, 0); } while (0)
#define PG8_LDA(dst, b, h) do { _Pragma("unroll") for (int m = 0; m < 4; ++m) _Pragma("unroll") for (int k = 0; k < 2; ++k) dst[m][k] = *(const LAS bf16x8*)(lds + PG8_SA(b, h) + aoff + m * 2048 + k * 1024); } while (0)
#define PG8_LDB(dst, b, h) do { _Pragma("unroll") for (int n = 0; n < 2; ++n) _Pragma("unroll") for (int k = 0; k < 2; ++k) dst[n][k] = *(const LAS bf16x8*)(lds + PG8_SB(b, h) + boff + n * 2048 + k * 1024); } while (0)
#define PG8_MMA(ai, bj, At, Bt) do { __builtin_amdgcn_s_setprio(1); _Pragma("unroll") for (int m = 0; m < 4; ++m) _Pragma("unroll") for (int n = 0; n < 2; ++n) _Pragma("unroll") for (int k = 0; k < 2; ++k) \
        acc[ai][bj][m][n] = __builtin_amdgcn_mfma_f32_16x16x32_bf16(Bt[n][k], At[m][k], acc[ai][bj][m][n], 0, 0, 0); __builtin_amdgcn_s_setprio(0); } while (0)
#define PG8_WAIT_V(n) asm volatile("s_waitcnt vmcnt(" #n ")" ::: "memory")
#define PG8_WAIT_L(n) asm volatile("s_waitcnt lgkmcnt(" #n ")" ::: "memory")
#define PG8_BAR __builtin_amdgcn_s_barrier()
#define PG8_SCHED __builtin_amdgcn_sched_barrier(0)
    Unit cur, nxt; int ui = 0;
    if (!S.next(0, cur)) return;
    f32x4 acc[2][2][4][2];
#pragma unroll
    for (int a = 0; a < 2; ++a)
#pragma unroll
        for (int b = 0; b < 2; ++b)
#pragma unroll
            for (int m = 0; m < 4; ++m)
#pragma unroll
                for (int n = 0; n < 2; ++n) acc[a][b][m][n] = (f32x4){0.f, 0.f, 0.f, 0.f};
    bf16x8 At[4][2], B0[2][2], B1[2][2];
    const char* cA = (const char*)g.A + (size_t)cur.pm * tstep; const char* cB = (const char*)g.Bt + (size_t)cur.pn * tstep;
    PG8_STAGE(PG8_SB(0, 0), cB, voffB); PG8_STAGE(PG8_SA(0, 0), cA, voffA); PG8_STAGE(PG8_SB(0, 1), cB + hstep, voffB); PG8_STAGE(PG8_SA(0, 1), cA + hstep, voffA);
    if (wr == 1) PG8_BAR;
    PG8_WAIT_V(4); PG8_BAR;
    PG8_STAGE(PG8_SB(1, 0), cB + kstep, voffB); PG8_STAGE(PG8_SA(1, 0), cA + kstep, voffA); PG8_STAGE(PG8_SB(1, 1), cB + hstep + kstep, voffB);
    PG8_WAIT_V(6); PG8_BAR;
    for (;;) {
        const bool has_next = S.next(ui + 1, nxt);
        const char* nA = has_next ? (const char*)g.A + (size_t)nxt.pm * tstep : cA; const char* nB = has_next ? (const char*)g.Bt + (size_t)nxt.pn * tstep : cB;
        for (int t = 0; t < nt; t += 2) {
            const bool last = (t == nt - 2);
            const char* a1 = cA + (size_t)(t + 1) * kstep;
            const char* a2 = last ? nA : cA + (size_t)(t + 2) * kstep; const char* b2 = last ? nB : cB + (size_t)(t + 2) * kstep;
            const char* a3 = a2 + kstep; const char* b3 = b2 + kstep;
            PG8_LDB(B0, 0, 0); PG8_SCHED; PG8_LDA(At, 0, 0); PG8_STAGE(PG8_SA(1, 1), a1 + hstep, voffA);
            PG8_WAIT_L(8); PG8_BAR; PG8_WAIT_L(0); PG8_MMA(0, 0, At, B0); PG8_BAR; PG8_SCHED;
            PG8_LDB(B1, 0, 1); PG8_STAGE(PG8_SB(0, 0), b2, voffB);
            PG8_BAR; PG8_WAIT_L(0); PG8_MMA(0, 1, At, B1); PG8_BAR;
            PG8_LDA(At, 0, 1); PG8_STAGE(PG8_SA(0, 0), a2, voffA);
            PG8_BAR; PG8_WAIT_L(0); PG8_MMA(1, 0, At, B0); PG8_BAR; PG8_SCHED;
            PG8_STAGE(PG8_SB(0, 1), b2 + hstep, voffB);
            PG8_WAIT_V(6); PG8_BAR; PG8_MMA(1, 1, At, B1); PG8_BAR;
            PG8_LDB(B0, 1, 0); PG8_SCHED; PG8_LDA(At, 1, 0); PG8_STAGE(PG8_SA(0, 1), a2 + hstep, voffA);
            PG8_WAIT_L(8); PG8_BAR; PG8_WAIT_L(0); PG8_MMA(0, 0, At, B0); PG8_BAR; PG8_SCHED;
            PG8_LDB(B1, 1, 1); PG8_STAGE(PG8_SB(1, 0), b3, voffB);
            PG8_BAR; PG8_WAIT_L(0); PG8_MMA(0, 1, At, B1); PG8_BAR;
            PG8_LDA(At, 1, 1); PG8_STAGE(PG8_SA(1, 0), a3, voffA);
            PG8_BAR; PG8_WAIT_L(0); PG8_MMA(1, 0, At, B0); PG8_BAR; PG8_SCHED;
            PG8_STAGE(PG8_SB(1, 1), b3 + hstep, voffB);
            PG8_WAIT_V(6); PG8_BAR; PG8_MMA(1, 1, At, B1); PG8_BAR;
        }
        E(acc, cur, wr, wc, fr, fq);
        if (!has_next) break;
#pragma unroll
        for (int a = 0; a < 2; ++a)
#pragma unroll
            for (int b = 0; b < 2; ++b)
#pragma unroll
                for (int m = 0; m < 4; ++m)
#pragma unroll
                    for (int n = 0; n < 2; ++n) acc[a][b][m][n] = (f32x4){0.f, 0.f, 0.f, 0.f};
        cur = nxt; cA = nA; cB = nB; ++ui;
    }
    PG8_WAIT_V(0);
    if (wr == 0) PG8_BAR;
    PG8_BAR;
#undef PG8_SA
#undef PG8_SB
#undef PG8_STAGE
#undef PG8_LDA
#undef PG8_LDB
#undef PG8_MMA
#undef PG8_WAIT_V
#undef PG8_WAIT_L
#undef PG8_BAR
#undef PG8_SCHED
}
}

__device__ __forceinline__ void p0_transpose_item(const float* W, int K, int ldN, int nblk, bf16_t* WT, const float* gain, LAS float* scr, int item, int lane) {
    const int kb = item / nblk, nb = item % nblk, k0 = 64 * kb, n0 = 32 * nb;
#pragma unroll 8
    for (int i = 0; i < 32; ++i) { const int kk = 2 * i + (lane >> 5); const float gk = gain ? gain[k0 + kk] : 1.f;
        scr[kk * 33 + (lane & 31)] = W[(size_t)(k0 + kk) * ldN + n0 + (lane & 31)] * gk; }
    asm volatile("s_waitcnt lgkmcnt(0)" ::: "memory");
    const int c = lane & 7;
#pragma unroll
    for (int j = 0; j < 4; ++j) { const int n = (lane >> 3) + 8 * j; const LAS float* s = scr + (8 * c) * 33 + n;
        u32x4 o; o.x = cvt_pk_bf16(s[0 * 33], s[1 * 33]); o.y = cvt_pk_bf16(s[2 * 33], s[3 * 33]); o.z = cvt_pk_bf16(s[4 * 33], s[5 * 33]); o.w = cvt_pk_bf16(s[6 * 33], s[7 * 33]);
        *(u32x4*)(WT + (size_t)(n0 + n) * K + k0 + 8 * c) = o; }
    asm volatile("s_waitcnt lgkmcnt(0)" ::: "memory");
}
__device__ __forceinline__ void p0_fold_item(const float* Win  , const float* gpre, bf16_t* WT  , const LAS float* tab, int item, int lane) {
    const int kb = item >> 3, g = item & 7, k = kb * 64 + lane;
    const float gk = gpre[k] * 0.125f;
    const f32x4* src = (const f32x4*)(Win + (size_t)k * DIN + 1536 + g * 64);
    float row[64];
#pragma unroll
    for (int i = 0; i < 16; ++i) { const f32x4 v = src[i]; row[4 * i] = v.x * gk; row[4 * i + 1] = v.y * gk; row[4 * i + 2] = v.z * gk; row[4 * i + 3] = v.w * gk; }
    for (int j = 0; j < 64; ++j) {
        const int cj = (j == 0) ? 0 : (j == 1 ? 32 : (j >> 1)), off = (j >= 2 && (j & 1)) ? 16 : 0;
        float acc = 0.f;
#pragma unroll
        for (int d = 0; d < 64; ++d) acc += row[d] * tab[(cj * d + off) & 63];
        WT[(size_t)(1536 + g * 64 + j) * D + k] = (bf16_t)(cvt_pk_bf16(acc, 0.f) & 0xffffu);
    }
}
__device__ __forceinline__ void rms_row_to_bf16(const float* xrow, bf16_t* orow, int lane) {
    const f32x4* xr = (const f32x4*)xrow + lane;
    f32x4 v[4]; float s = 0.f;
#pragma unroll
    for (int j = 0; j < 4; ++j) { v[j] = xr[64 * j]; s += (v[j].x * v[j].x + v[j].y * v[j].y) + (v[j].z * v[j].z + v[j].w * v[j].w); }
    const float rstd = rsqrtf(wave_sum(s) * (1.f / D) + EPS);
    u32x2* o8 = (u32x2*)orow + lane;
#pragma unroll
    for (int j = 0; j < 4; ++j) { u32x2 w; w.x = cvt_pk_bf16(v[j].x * rstd, v[j].y * rstd); w.y = cvt_pk_bf16(v[j].z * rstd, v[j].w * rstd); o8[64 * j] = w; }
}

__device__ __forceinline__ void row_pass_row(const float* xrow, const bf16_t* mrow, const float* gain, float* xdst, bf16_t* hdst, bool write_h, int lane) {
    const f32x4* xr = (const f32x4*)xrow + lane; const u32x2* mr = (const u32x2*)mrow + lane; const f32x4* gr = (const f32x4*)gain + lane;
    f32x4 x[4], m[4]; float s = 0.f;
#pragma unroll
    for (int j = 0; j < 4; ++j) { x[j] = xr[64 * j]; const u32x2 w = mr[64 * j]; m[j] = (f32x4){bf_lo(w.x), bf_hi(w.x), bf_lo(w.y), bf_hi(w.y)};
        s += (m[j].x * m[j].x + m[j].y * m[j].y) + (m[j].z * m[j].z + m[j].w * m[j].w); }
    const float rm = rsqrtf(wave_sum(s) * (1.f / D) + EPS);
    float s1 = 0.f;
#pragma unroll
    for (int j = 0; j < 4; ++j) { const f32x4 gg = gr[64 * j]; x[j] = x[j] + m[j] * rm * gg; s1 += (x[j].x * x[j].x + x[j].y * x[j].y) + (x[j].z * x[j].z + x[j].w * x[j].w); }
    f32x4* xo = (f32x4*)xdst + lane;
#pragma unroll
    for (int j = 0; j < 4; ++j) xo[64 * j] = x[j];
    if (write_h) {
        const float r1 = rsqrtf(wave_sum(s1) * (1.f / D) + EPS);
        u32x2* o8 = (u32x2*)hdst + lane;
#pragma unroll
        for (int j = 0; j < 4; ++j) { u32x2 w; w.x = cvt_pk_bf16(x[j].x * r1, x[j].y * r1); w.y = cvt_pk_bf16(x[j].z * r1, x[j].w * r1); o8[64 * j] = w; }
    }
}

__device__ __forceinline__ void conv_wave_item(const bf16_t* p, const float* cw, bf16_t* Hm, int t0, int pos0, int S, int lane) {
    float w0[8], w1[8], w2[8];
    { const f32x4* a = (const f32x4*)(cw + lane * 8); const f32x4* b = (const f32x4*)(cw + 512 + lane * 8); const f32x4* c = (const f32x4*)(cw + 1024 + lane * 8);
#pragma unroll
      for (int h = 0; h < 2; ++h) { const f32x4 va = a[h], vb = b[h], vc = c[h];
#pragma unroll
        for (int k = 0; k < 4; ++k) { w0[4 * h + k] = va[k]; w1[4 * h + k] = vb[k]; w2[4 * h + k] = vc[k]; } } }
    float zp[8], zc[8], zn[8], ga[8], gb[8];
    const bf16_t* base = p + (size_t)t0 * DIN + lane * 8;
    if (pos0 == 0) {
#pragma unroll
        for (int k = 0; k < 8; ++k) zp[k] = 0.f;
    } else { load8(base - DIN + 512, ga); load8(base - DIN + 1024, gb);
#pragma unroll
        for (int k = 0; k < 8; ++k) zp[k] = ga[k] * gb[k]; }
    load8(base + 512, ga); load8(base + 1024, gb);
#pragma unroll
    for (int k = 0; k < 8; ++k) zc[k] = ga[k] * gb[k];
#pragma unroll 4
    for (int i = 0; i < 16; ++i) {
        const bf16_t* r = base + (size_t)i * DIN;
        if (pos0 + i + 1 == S) {
#pragma unroll
            for (int k = 0; k < 8; ++k) zn[k] = 0.f;
        } else { load8(r + DIN + 512, ga); load8(r + DIN + 1024, gb);
#pragma unroll
            for (int k = 0; k < 8; ++k) zn[k] = ga[k] * gb[k]; }
        load8(r, gb);
        float y[8], ss = 0.f;
#pragma unroll
        for (int k = 0; k < 8; ++k) { y[k] = gb[k] * (zp[k] * w0[k] + zc[k] * w1[k] + zn[k] * w2[k]); ss += y[k] * y[k]; }
        ss += __shfl_xor(ss, 1); ss += __shfl_xor(ss, 2); ss += __shfl_xor(ss, 4);
        const float rs = rsqrtf(ss * (1.f / 64.f) + EPS);
        u32x4 o; o.x = cvt_pk_bf16(y[0] * rs, y[1] * rs); o.y = cvt_pk_bf16(y[2] * rs, y[3] * rs); o.z = cvt_pk_bf16(y[4] * rs, y[5] * rs); o.w = cvt_pk_bf16(y[6] * rs, y[7] * rs);
        *(u32x4*)(Hm + (size_t)(t0 + i) * D + lane * 8) = o;
#pragma unroll
        for (int k = 0; k < 8; ++k) { zp[k] = zc[k]; zc[k] = zn[k]; }
    }
}

__device__ __forceinline__ LAS f32x2* fft_stages(LAS f32x2* X, LAS f32x2* Y, const LAS f32x2* tw, int ntile, int log2n, int tid) {
    const int n = 1 << log2n, half = n >> 1, twsh = 7 - log2n;
    const int total = ntile * half * 32;
    for (int st = 0; st < log2n; ++st) {
        const int s = 1 << st;
        for (int idx = tid; idx < total; idx += NTHREADS) {
            const int c = idx & 31, jj = idx >> 5, tile = jj >> (log2n - 1), j = jj & (half - 1);
            const int p = j >> st, base = tile * n * 32;
            const f32x2 a = X[base + j * 32 + c], b = X[base + (j + half) * 32 + c];
            const f32x2 w = tw[(p << st) << twsh];
            const f32x2 sm = a + b, df = a - b;
            const int o = base + (j + s * p) * 32 + c;
            Y[o] = sm;
            Y[o + s * 32] = (f32x2){df.x * w.x - df.y * w.y, df.x * w.y + df.y * w.x};
        }
        __syncthreads();
        LAS f32x2* t = X; X = Y; Y = t;
    }
    return X;
}
__device__ __forceinline__ int seq_base(int bs) { return bs < BP ? bs * SP : TP + (bs - BP) * SS; }

__device__ __forceinline__ void fft_pass1_item(const bf16_t* p, f32x2* inter, LAS unsigned char* lds, const LAS f32x2* tw, int item, int tid) {
    int bs, g, n2, S, log2N2;
    if (item < 2048) { bs = item >> 10; const int r = item & 1023; n2 = r >> 3; g = r & 7; S = SP; log2N2 = 7; }
    else { const int it = item - 2048; bs = BP + (it >> 9); const int r = it & 511; n2 = r >> 3; g = r & 7; S = SS; log2N2 = 6; }
    const int N2 = 1 << log2N2, tb = seq_base(bs);
    LAS f32x2* X = (LAS f32x2*)lds; LAS f32x2* Y = (LAS f32x2*)(lds + 65536);
#pragma unroll
    for (int i = 0; i < 2; ++i) { const int q = tid + NTHREADS * i, row = q >> 3, ch = q & 7;
        const u32x4 v = *(const u32x4*)(p + (size_t)(tb + N2 * row + n2) * DIN + 1536 + g * 64 + ch * 8);
        LAS f32x4* dst = (LAS f32x4*)(X + row * 32 + ch * 4);
        dst[0] = (f32x4){bf_lo(v.x), bf_hi(v.x), bf_lo(v.y), bf_hi(v.y)}; dst[1] = (f32x4){bf_lo(v.z), bf_hi(v.z), bf_lo(v.w), bf_hi(v.w)}; }
    __syncthreads();
    const LAS f32x2* R = fft_stages(X, Y, tw, 1, 7, tid);
    f32x2* ob = inter + (size_t)tb * 256 + (size_t)g * S * 32;
    const float invS = 1.f / (float)S;
#pragma unroll
    for (int i = 0; i < 8; ++i) { const int idx = tid + NTHREADS * i, c = idx & 31, k1 = idx >> 5;
        const f32x2 v = R[k1 * 32 + c];
        float sn, cs; sincospif(-2.0f * (float)(n2 * k1) * invS, &sn, &cs);
        ob[(size_t)(k1 * N2 + n2) * 32 + c] = (f32x2){v.x * cs - v.y * sn, v.x * sn + v.y * cs}; }
    __syncthreads();
}

__device__ __forceinline__ void fft_pass2_item(const f32x2* inter, bf16_t* Hm, LAS unsigned char* lds, const LAS f32x2* tw, int item, int tid) {
    int bs, g, ip, S, log2N2;
    if (item < 1024) { bs = item >> 9; const int r = item & 511; g = r >> 6; ip = r & 63; S = SP; log2N2 = 7; }
    else { const int it = item - 1024; bs = BP + (it >> 9); const int r = it & 511; g = r >> 6; ip = r & 63; S = SS; log2N2 = 6; }
    const int N2 = 1 << log2N2, tb = seq_base(bs);
    const int k1a = ip == 0 ? 0 : ip, k1b = ip == 0 ? 64 : 128 - ip;
    LAS f32x2* X = (LAS f32x2*)lds; LAS f32x2* Y = (LAS f32x2*)(lds + 65536);
    const f32x2* ib = inter + (size_t)tb * 256 + (size_t)g * S * 32;
    const int chunks = N2 * 16;
    for (int idx = tid; idx < 2 * chunks; idx += NTHREADS) { const int h = idx >= chunks, r = idx - h * chunks;
        const f32x4 v = ((const f32x4*)(ib + (size_t)((h ? k1b : k1a) * N2) * 32))[r];
        ((LAS f32x4*)(X + h * N2 * 32))[r] = v; }
    __syncthreads();
    const LAS f32x2* R = fft_stages(X, Y, tw, 2, log2N2, tid);
    LAS bf16_t* Ost = (LAS bf16_t*)((R == X) ? Y : X);
    const float sc = rsqrtf((float)S);
    for (int idx = tid; idx < 2 * N2 * 32; idx += NTHREADS) {
        const int c = idx & 31, tl = idx >> 5, h = tl >> log2N2, k2 = tl & (N2 - 1);
        const int ph = (ip == 0) ? h : 1 - h;
        const int k2p = (ip == 0 && h == 0) ? ((N2 - k2) & (N2 - 1)) : (N2 - 1 - k2);
        const f32x2 own = R[(h * N2 + k2) * 32 + c], par = R[(ph * N2 + k2p) * 32 + c];
        float v1 = (c == 0) ? 0.5f * (own.x + par.x) : own.x, v2 = (c == 0) ? 0.5f * (own.y + par.y) : par.x;
        v1 *= sc; v2 *= sc;
        float ss = v1 * v1 + v2 * v2;
        ss += __shfl_xor(ss, 1); ss += __shfl_xor(ss, 2); ss += __shfl_xor(ss, 4); ss += __shfl_xor(ss, 8); ss += __shfl_xor(ss, 16);
        const float rs = rsqrtf(ss * (1.f / 64.f) + EPS);
        Ost[tl * 64 + c] = (bf16_t)(cvt_pk_bf16(v1 * rs, 0.f) & 0xffffu);
        Ost[tl * 64 + (c == 0 ? 32 : 64 - c)] = (bf16_t)(cvt_pk_bf16(v2 * rs, 0.f) & 0xffffu);
    }
    __syncthreads();
    for (int idx = tid; idx < 2 * N2 * 8; idx += NTHREADS) {
        const int tl = idx >> 3, ch = idx & 7, h = tl >> log2N2, k2 = tl & (N2 - 1);
        const int tok = tb + (h ? k1b : k1a) + 128 * k2;
        *(u32x4*)(Hm + (size_t)tok * D + 512 + g * 64 + ch * 8) = ((const LAS u32x4*)Ost)[idx];
    }
    __syncthreads();
}


#define XB_TMO      128
#define XB_XCNT(j)  (256  + 64 * (j))
#define XB_XSUB(j)  (1280 + 64 * (j))
#define XB_XGEN(j)  (2304 + 64 * (j))
#define XB_TOP      3328
#define XB_TOPGEN   3392
#define XCD_BAR_WORDS 3456
#define XB_SPIN_CAP (1u << 20)
__device__ __forceinline__ unsigned xb_ld(unsigned* p)              { return __hip_atomic_load(p, __ATOMIC_RELAXED, __HIP_MEMORY_SCOPE_AGENT); }
__device__ __forceinline__ unsigned xb_add(unsigned* p, unsigned v) { return __hip_atomic_fetch_add(p, v, __ATOMIC_RELAXED, __HIP_MEMORY_SCOPE_AGENT); }
__device__ __forceinline__ unsigned xb_xcc_id() { return (unsigned)__builtin_amdgcn_s_getreg((3 << 11) | 20) & 0xFu; }
#define XB_SPIN(cond, bar) do { unsigned _sp = 0; while (cond) { __builtin_amdgcn_s_sleep(1); \
    if ((++_sp & 255u) == 0u) { if (xb_ld(&(bar)[XB_TMO])) break; if (_sp > XB_SPIN_CAP) { atomicAdd(&(bar)[XB_TMO], 1u); break; } } } } while (0)
struct XcdBarrier { unsigned* bar; unsigned x; volatile LAS unsigned* st; };
__device__ __forceinline__ XcdBarrier xcd_barrier_post(unsigned* bar, volatile LAS unsigned* st) {
    XcdBarrier b; b.bar = bar; b.x = xb_xcc_id(); b.st = st;
    if (threadIdx.x == 0) (void)xb_add(&bar[XB_XCNT(b.x)], 1u);
    return b;
}
__device__ __forceinline__ void xcd_barrier_complete(unsigned* bar, unsigned x, unsigned& nloc, unsigned& nx) {
    const unsigned G = gridDim.x * gridDim.y * gridDim.z;
    unsigned sum, cnt, mine, sp = 0u;
    for (;;) {
        sum = 0u; cnt = 0u; mine = 0u;
#pragma unroll
        for (unsigned j = 0; j < 16; ++j) { const unsigned c = xb_ld(&bar[XB_XCNT(j)]); sum += c; cnt += (c > 0u) ? 1u : 0u; mine = (j == x) ? c : mine; }
        if (sum == G) break;
        __builtin_amdgcn_s_sleep(1);
        if ((++sp & 255u) == 0u) { if (xb_ld(&bar[XB_TMO])) break; if (sp > XB_SPIN_CAP) { atomicAdd(&bar[XB_TMO], 1u); break; } }
    }
    nloc = mine > 0u ? mine : 1u; nx = cnt > 0u ? cnt : 1u;
}
__device__ __forceinline__ void xcd_barrier(const XcdBarrier& b) {
    asm volatile("s_waitcnt vmcnt(0)" ::: "memory");
    __syncthreads();
    if (threadIdx.x == 0) {
        unsigned* bar = b.bar;
        __builtin_amdgcn_s_waitcnt(0);
        unsigned nloc = b.st[0], nx = b.st[1];
        if (nloc == 0u) { xcd_barrier_complete(bar, b.x, nloc, nx); b.st[0] = nloc; b.st[1] = nx; }
        const unsigned old = xb_add(&bar[XB_XSUB(b.x)], 1u);
        const unsigned gen = old / nloc;
        if (old + 1u == (gen + 1u) * nloc) {
            __builtin_amdgcn_fence(__ATOMIC_RELEASE, "agent");
            asm volatile("s_waitcnt vmcnt(0)" ::: "memory");
            const unsigned og = xb_add(&bar[XB_TOP], 1u);
            const unsigned tg = og / nx;
            if (og + 1u == (tg + 1u) * nx) xb_add(&bar[XB_TOPGEN], 1u);
            else XB_SPIN(xb_ld(&bar[XB_TOPGEN]) == tg, bar);
            __builtin_amdgcn_fence(__ATOMIC_ACQUIRE, "agent");
            xb_add(&bar[XB_XGEN(b.x)], 1u);
            asm volatile("s_waitcnt vmcnt(0)" ::: "memory");
        } else {
            XB_SPIN(xb_ld(&bar[XB_XGEN(b.x)]) == gen, bar);
            __builtin_amdgcn_fence(__ATOMIC_ACQUIRE, "agent");
            asm volatile("s_waitcnt vmcnt(0)" ::: "memory");
        }
    }
    __syncthreads();
}

__global__ void __launch_bounds__(NTHREADS, 2) fwd_megakernel(Params P) {
    extern __shared__ __attribute__((aligned(16))) unsigned char shm[];
    cg::grid_group grid = cg::this_grid();
    LAS unsigned char* lds = (LAS unsigned char*)shm;
    const int G = gridDim.x, bid = blockIdx.x, NGW = G * NWAVES;
#define FRESH() int tid = threadIdx.x; asm volatile("" : "+v"(tid)); const int lane = tid & 63, wave = __builtin_amdgcn_readfirstlane(tid >> 6), gw = bid * NWAVES + wave; (void)lane; (void)gw
#define TAB ((LAS float*)(lds + LDS_MISC))
#define TWD ((LAS f32x2*)(lds + LDS_MISC + 512))
    { FRESH();
      if (tid < 64) { TAB[tid] = cospif((float)tid * (1.f / 32.f)); float sn, cs; sincospif((float)tid * (1.f / 64.f), &sn, &cs); TWD[tid] = (f32x2){cs, -sn}; }
      if (tid < 4) ((volatile LAS unsigned*)(lds + LDS_MISC + 1024))[tid] = 0u; }
    __syncthreads();
    const XcdBarrier xbar = xcd_barrier_post((unsigned*)P.ws, (volatile LAS unsigned*)(lds + LDS_MISC + 1024));
#define GSYNC() xcd_barrier(xbar)

    unsigned char* ws = P.ws;
#define Hb ((bf16_t*)(ws + WS_H))
#define Pb ((bf16_t*)(ws + WS_P))
#define Ib ((f32x2*)(ws + WS_INTER))
#define Mb ((bf16_t*)(ws + WS_M))
#define Ab ((bf16_t*)(ws + WS_A))
#define Fb ((bf16_t*)(ws + WS_F))

    {
        FRESH();
        LAS float* scr = (LAS float*)(lds + wave * 8704);
        constexpr int I_IN = 16 * 48, I_OUT = 16 * 32, I_UP = 16 * 128, I_DN = 64 * 32, I_F = 128, I_L = I_IN + I_OUT + I_UP + I_DN + I_F;
        for (int it = gw; it < NL * I_L; it += NGW) {
            const int l = it / I_L; int r = it % I_L;
            bf16_t* Wl = (bf16_t*)(ws + WS_W + (size_t)l * WL_SZ);
            const float* win = P.w_in + (size_t)l * D * DIN;
            if (r < I_IN) { p0_transpose_item(win, D, DIN, 48, Wl + WL_IN / 2, P.g_mix_pre + l * D, scr, r, lane); continue; } r -= I_IN;
            if (r < I_OUT) {
                const int kb = r / 32; const float* gsrc = kb < 8 ? P.g_conv_out + l * 512 : P.g_fourier_out + l * 512 - 512;
                p0_transpose_item(P.w_out + (size_t)l * D * D, D, D, 32, Wl + WL_OUT / 2, gsrc, scr, r, lane); continue; } r -= I_OUT;
            if (r < I_UP) { p0_transpose_item(P.w_up + (size_t)l * D * DFF, D, DFF, 128, Wl + WL_UP / 2, P.g_mlp_pre + l * D, scr, r, lane); continue; } r -= I_UP;
            if (r < I_DN) { p0_transpose_item(P.w_down + (size_t)l * DFF * D, DFF, D, 32, Wl + WL_DN / 2, nullptr, scr, r, lane); continue; } r -= I_DN;
            p0_fold_item(win, P.g_mix_pre + l * D, Wl + WL_IN / 2, TAB, r, lane);
        }
        for (int t = gw; t < T; t += NGW) rms_row_to_bf16(t < TP ? P.xp + (size_t)t * D : P.xs + (size_t)(t - TP) * D, Hb + (size_t)t * D, lane);
    }
    grid.sync();

    for (int l = 0; l < NL; ++l) {
        const bf16_t* Wl = (const bf16_t*)(ws + WS_W + (size_t)l * WL_SZ);
        { pg8::Gemm g{Hb, Wl + WL_IN / 2, T, DIN, D}; pg8::StaticOrder S; S.init(T, DIN, G, bid); pg8::EpiBf16 E{Pb, DIN, 0};
          pg8::gemm_phase(lds, g, S, E); }
        GSYNC();
        {
            FRESH();
            constexpr int NCONV = T / 128, NP1 = 2048 + 4096;
            for (int it = bid; it < NCONV + NP1; it += G) {
                if (it < NCONV) { const int t0 = it * 128 + wave * 16; const int S = t0 < TP ? SP : SS; const int pos0 = t0 < TP ? (t0 & (SP - 1)) : ((t0 - TP) & (SS - 1));
                    conv_wave_item(Pb, P.conv_w + (size_t)l * 3 * 512, Hb, t0, pos0, S, lane); }
                else fft_pass1_item(Pb, Ib, lds, TWD, it - NCONV, tid);
            }
        }
        GSYNC();
        { FRESH();
          for (int it = bid; it < 1024 + 4096; it += G) fft_pass2_item(Ib, Hb, lds, TWD, it, tid); }
        GSYNC();
        { pg8::Gemm g{Hb, Wl + WL_OUT / 2, T, D, D}; pg8::StaticOrder S; S.init(T, D, G, bid); pg8::EpiBf16 E{Mb, D, 0};
          pg8::gemm_phase(lds, g, S, E); }
        GSYNC();
        { FRESH();
          for (int t = gw; t < T; t += NGW) {
            const float* xr = (l == 0) ? (t < TP ? P.xp + (size_t)t * D : P.xs + (size_t)(t - TP) * D) : P.out + (size_t)t * D;
            row_pass_row(xr, Mb + (size_t)t * D, P.g_mix_post + l * D, P.out + (size_t)t * D, Hb + (size_t)t * D, true, lane);
          } }
        GSYNC();
        for (int ch = 0; ch < NCH; ++ch) {
            { pg8::Gemm g{Hb + (size_t)ch * TCH * D, Wl + WL_UP / 2, TCH, DFF, D}; pg8::StaticOrder S; S.init(TCH, DFF, G, bid); pg8::EpiBf16 E{Ab, DFF, 1};
              pg8::gemm_phase(lds, g, S, E); }
            GSYNC();
            { pg8::Gemm g{Ab, Wl + WL_DN / 2, TCH, D, DFF}; pg8::StaticOrder S; S.init(TCH, D, G, bid); pg8::EpiBf16 E{Fb + (size_t)ch * TCH * D, D, 0};
              pg8::gemm_phase(lds, g, S, E); }
            GSYNC();
        }
        { FRESH();
          for (int t = gw; t < T; t += NGW)
            row_pass_row(P.out + (size_t)t * D, Fb + (size_t)t * D, P.g_mlp_post + l * D, P.out + (size_t)t * D, Hb + (size_t)t * D, l + 1 < NL, lane); }
        if (l + 1 < NL) GSYNC();
    }
}

extern "C" void kernel_launch(void* const* d_in, const int* in_sizes, int n_in, void* d_out, int out_size, void* d_ws, size_t ws_size, hipStream_t stream) {
    static int grid_blocks = 0;
    if (grid_blocks == 0) {
        if (n_in != 13 || out_size != T * D || ws_size < WS_END) { fprintf(stderr, "kernel_launch: unexpected shapes (n_in %d, out %d, ws %zu, need %zu)\n", n_in, out_size, ws_size, (size_t)WS_END); grid_blocks = -1; return; }
        int dev = 0, cus = 0, per_cu = 0;
        hipGetDevice(&dev);
        hipDeviceGetAttribute(&cus, hipDeviceAttributeMultiprocessorCount, dev);
        if (hipFuncSetAttribute((const void*)fwd_megakernel, hipFuncAttributeMaxDynamicSharedMemorySize, LDS_BYTES) != hipSuccess) { fprintf(stderr, "kernel_launch: hipFuncSetAttribute failed\n"); grid_blocks = -1; return; }
        hipOccupancyMaxActiveBlocksPerMultiprocessor(&per_cu, (const void*)fwd_megakernel, NTHREADS, LDS_BYTES);
        if (per_cu < 1) { fprintf(stderr, "kernel_launch: occupancy query says %d blocks per CU\n", per_cu); per_cu = 1; }
        grid_blocks = cus * per_cu;
    }
    if (grid_blocks < 0) return;
    Params p{};
    p.xp = (const float*)d_in[0]; p.xs = (const float*)d_in[1]; p.g_mix_pre = (const float*)d_in[2]; p.w_in = (const float*)d_in[3]; p.conv_w = (const float*)d_in[4];
    p.g_conv_out = (const float*)d_in[5]; p.g_fourier_out = (const float*)d_in[6]; p.w_out = (const float*)d_in[7]; p.g_mix_post = (const float*)d_in[8];
    p.g_mlp_pre = (const float*)d_in[9]; p.w_up = (const float*)d_in[10]; p.w_down = (const float*)d_in[11]; p.g_mlp_post = (const float*)d_in[12];
    p.out = (float*)d_out; p.ws = (unsigned char*)d_ws;
    if (hipMemsetAsync(d_ws, 0, 16384, stream) != hipSuccess) { fprintf(stderr, "kernel_launch: memset failed\n"); return; }
    void* args[] = {&p};
    hipError_t e = hipLaunchCooperativeKernel((const void*)fwd_megakernel, dim3(grid_blocks), dim3(NTHREADS), args, LDS_BYTES, stream);
    if (e != hipSuccess) fprintf(stderr, "cooperative launch failed: %s (grid %d)\n", hipGetErrorString(e), grid_blocks);
}
```

```cpp
#include <hip/hip_runtime.h>
#include <hip/hip_cooperative_groups.h>
#include <cstdio>
namespace cg = cooperative_groups;

#define LAS __attribute__((address_space(3)))
typedef unsigned short bf16_t;
typedef short bf16x8 __attribute__((ext_vector_type(8)));
typedef float f32x4 __attribute__((ext_vector_type(4)));
typedef float f32x2 __attribute__((ext_vector_type(2)));
typedef unsigned u32x4 __attribute__((ext_vector_type(4)));
typedef unsigned u32x2 __attribute__((ext_vector_type(2)));

constexpr int D = 1024, DIN = 2048, DFF = 4096, NL = 4;
constexpr int SP = 16384, BP = 2, SS = 8192, BS = 8;
constexpr int TP = BP * SP, TS = BS * SS, T = TP + TS;
constexpr float EPS = 1e-6f;
constexpr int NCH = 2;
constexpr int TCH = T / NCH;

constexpr size_t MiB = (size_t)1 << 20;
constexpr size_t WS_W = 1 * MiB;
constexpr size_t WL_IN = 0, WL_OUT = 4 * MiB, WL_UP = 6 * MiB, WL_DN = 14 * MiB, WL_SZ = 22 * MiB;
constexpr size_t WS_X = WS_W + NL * WL_SZ;
constexpr size_t WS_H = WS_X + (size_t)T * D * 2;
constexpr size_t WS_INTER = WS_H + (size_t)T * D * 2;
constexpr size_t WS_MF = WS_INTER + (size_t)T * 256 * 8;
constexpr size_t WS_RS = WS_MF + (size_t)T * D * 2;
constexpr size_t WS_END = WS_RS + 1 * MiB;

constexpr int LDS_STAGE = 131072, LDS_MISC = LDS_STAGE, LDS_BYTES = LDS_STAGE + 4096;
constexpr int NTHREADS = 512, NWAVES = 8;

struct Params {
    const float* xp; const float* xs; const float* g_mix_pre; const float* w_in; const float* conv_w;
    const float* g_conv_out; const float* g_fourier_out; const float* w_out; const float* g_mix_post;
    const float* g_mlp_pre; const float* w_up; const float* w_down; const float* g_mlp_post;
    float* out; unsigned char* ws;
};

__device__ __forceinline__ unsigned cvt_pk_bf16(float lo, float hi) { unsigned r; asm volatile("v_cvt_pk_bf16_f32 %0, %1, %2" : "=v"(r) : "v"(lo), "v"(hi)); return r; }
__device__ __forceinline__ float bf_lo(unsigned w) { return __uint_as_float(w << 16); }
__device__ __forceinline__ float bf_hi(unsigned w) { return __uint_as_float(w & 0xffff0000u); }
__device__ __forceinline__ float wave_sum(float v) {
#pragma unroll
    for (int o = 1; o < 64; o <<= 1) v += __shfl_xor(v, o);
    return v;
}
__device__ __forceinline__ void load8(const bf16_t* ptr, float (&v)[8]) {
    const u32x4 q = *(const u32x4*)ptr;
    v[0] = bf_lo(q.x); v[1] = bf_hi(q.x); v[2] = bf_lo(q.y); v[3] = bf_hi(q.y); v[4] = bf_lo(q.z); v[5] = bf_hi(q.z); v[6] = bf_lo(q.w); v[7] = bf_hi(q.w);
}

namespace pg8 {
constexpr int BM = 256, BK = 64, HALF = 128, HTB = HALF * BK * 2, STAGE_BYTES = 8 * HTB, NXCD = 8, WGM = 8;
__device__ __forceinline__ int lds_byte(int r, int c) { const int st = (r >> 4) * 2 + (c >> 5), rr = r & 15, cc = c & 31, ob = rr * 64 + cc * 2; return st * 1024 + (ob ^ (((ob >> 9) & 1) << 5)); }
__device__ __forceinline__ void stage_rc(int b, int& R, int& C) { const int st = b / 1024, sb = b % 1024, swz = sb ^ (((sb >> 9) & 1) << 5); R = (st >> 1) * 16 + swz / 64; C = (st & 1) * 32 + (swz % 64) / 2; }
__device__ __forceinline__ int perm32(int rho) { const int n = rho >> 4, i = rho & 15; return 8 * (i >> 2) + 4 * n + (i & 3); }

struct Unit { int pm, pn; };
struct Gemm { const bf16_t* A; const bf16_t* Bt; int M, N, K; };

struct StaticOrder {
    int nM, nN, nwg, G, c;
    __device__ void init(int M, int N, int G_, int c_) { nM = M / BM; nN = N / BM; nwg = nM * nN; G = G_; c = c_; }
    __device__ bool next(int i, Unit& u) const {
        const long L = (long)i * G + c; if (L >= nwg) return false;
        int wgid = (int)L; { const int q = nwg / NXCD, r = nwg % NXCD, xcd = wgid % NXCD, off = wgid / NXCD; wgid = (xcd < r ? xcd * (q + 1) : r * (q + 1) + (xcd - r) * q) + off; }
        const int nig = WGM * nN, gid = wgid / nig, fm = gid * WGM, gsz = (nM - fm) < WGM ? (nM - fm) : WGM;
        u.pm = fm + ((wgid % nig) % gsz); u.pn = (wgid % nig) / gsz; return true;
    }
};

struct EpiBf16 {
    bf16_t* O; int ldc; int act; const float* rs;
    __device__ __forceinline__ void operator()(const f32x4 (&acc)[2][2][4][2], const Unit& u, int wr, int wc, int fr, int fq) const {
        const int row0 = u.pm * BM + wr * 64 + fr; const int col0 = u.pn * BM + wc * 32 + 8 * fq;
#pragma unroll
        for (int ai = 0; ai < 2; ++ai)
#pragma unroll
            for (int m = 0; m < 4; ++m) { bf16_t* rowp = O + (size_t)(row0 + ai * HALF + m * 16) * ldc + col0; const float sc = rs ? rs[row0 + ai * HALF + m * 16] : 1.f;
#pragma unroll
                for (int bj = 0; bj < 2; ++bj) { f32x4 v0 = acc[ai][bj][m][0] * sc, v1 = acc[ai][bj][m][1] * sc;
                    if (act) {
#pragma unroll
                        for (int j = 0; j < 4; ++j) { const float a0 = fmaxf(v0[j], 0.f), a1 = fmaxf(v1[j], 0.f); v0[j] = a0 * a0; v1[j] = a1 * a1; } }
                    u32x4 w; w.x = cvt_pk_bf16(v0[0], v0[1]); w.y = cvt_pk_bf16(v0[2], v0[3]); w.z = cvt_pk_bf16(v1[0], v1[1]); w.w = cvt_pk_bf16(v1[2], v1[3]);
                    *(u32x4*)(rowp + bj * HALF) = w; } }
    }
};

template <class Epi, class Sched>
__device__ __forceinline__ void gemm_phase(LAS unsigned char* lds, const Gemm g, const Sched& S, const Epi& E) {
    int tid_ = threadIdx.x; asm volatile("" : "+v"(tid_));
    const int tid = tid_, wid = __builtin_amdgcn_readfirstlane(tid >> 6), lane = tid & 63, wr = wid >> 2, wc = wid & 3, fr = lane & 15, fq = lane >> 4;
    const int K = g.K, nt = K / BK;
    unsigned voffA[2], voffB[2];
#pragma unroll
    for (int i = 0; i < 2; ++i) { int R, C; stage_rc(tid * 16 + i * 8192, R, C); const int Rb = (R & ~31) + perm32(R & 31);
        voffA[i] = (unsigned)(R * K + C) * 2u; voffB[i] = (unsigned)(Rb * K + C) * 2u; }
    const size_t kstep = (size_t)(BK * 2);
    const size_t hstep = (size_t)HALF * K * 2;
    const size_t tstep = 2 * hstep;
    const unsigned ldsw = (unsigned)wid * 1024u;
    const int aoff = lds_byte(wr * 64 + fr, fq * 8), boff = lds_byte(wc * 32 + fr, fq * 8);
#define PG8_SA(b, h) (((b) * 2 + (h)) * HTB)
#define PG8_SB(b, h) ((4 + (b) * 2 + (h)) * HTB)
#define PG8_STAGE(bufoff, gbase, voff) do { _Pragma("unroll") for (int _i = 0; _i < 2; ++_i) \
        __builtin_amdgcn_global_load_lds((const unsigned*)((const char*)(gbase) + (voff)[_i]), (LAS unsigned*)(lds + (bufoff) + ldsw + _i * 8192), 16, 0, 0); } while (0)
#define PG8_LDA(dst, b, h) do { _Pragma("unroll") for (int m = 0; m < 4; ++m) _Pragma("unroll") for (int k = 0; k < 2; ++k) dst[m][k] = *(const LAS bf16x8*)(lds + PG8_SA(b, h) + aoff + m * 2048 + k * 1024); } while (0)
#define PG8_LDB(dst, b, h) do { _Pragma("unroll") for (int n = 0; n < 2; ++n) _Pragma("unroll") for (int k = 0; k < 2; ++k) dst[n][k] = *(const LAS bf16x8*)(lds + PG8_SB(b, h) + boff + n * 2048 + k * 1024); } while (0)
#define PG8_MMA(ai, bj, At, Bt) do { __builtin_amdgcn_s_setprio(1); _Pragma("unroll") for (int m = 0; m < 4; ++m) _Pragma("unroll") for (int n = 0; n < 2; ++n) _Pragma("unroll") for (int k = 0; k < 2; ++k) \
        acc[ai][bj][m][n] = __builtin_amdgcn_mfma_f32_16x16x32_bf16(Bt[n][k], At[m][k], acc[ai][bj][m][n], 0, 0, 0); __builtin_amdgcn_s_setprio(0); } while (0)
#define PG8_WAIT_V(n) asm volatile("s_waitcnt vmcnt(" #n ")" ::: "memory")
#define PG8_WAIT_L(n) asm volatile("s_waitcnt lgkmcnt(" #n ")" ::: "memory")
#define PG8_BAR __builtin_amdgcn_s_barrier()
#define PG8_SCHED __builtin_amdgcn_sched_barrier(0)
    Unit cur, nxt; int ui = 0;
    if (!S.next(0, cur)) return;
    f32x4 acc[2][2][4][2];
#pragma unroll
    for (int a = 0; a < 2; ++a)
#pragma unroll
        for (int b = 0; b < 2; ++b)
#pragma unroll
            for (int m = 0; m < 4; ++m)
#pragma unroll
                for (int n = 0; n < 2; ++n) acc[a][b][m][n] = (f32x4){0.f, 0.f, 0.f, 0.f};
    bf16x8 At[4][2], B0[2][2], B1[2][2];
    const char* cA = (const char*)g.A + (size_t)cur.pm * tstep; const char* cB = (const char*)g.Bt + (size_t)cur.pn * tstep;
    PG8_STAGE(PG8_SB(0, 0), cB, voffB); PG8_STAGE(PG8_SA(0, 0), cA, voffA); PG8_STAGE(PG8_SB(0, 1), cB + hstep, voffB); PG8_STAGE(PG8_SA(0, 1), cA + hstep, voffA);
    if (wr == 1) PG8_BAR;
    PG8_WAIT_V(4); PG8_BAR;
    PG8_STAGE(PG8_SB(1, 0), cB + kstep, voffB); PG8_STAGE(PG8_SA(1, 0), cA + kstep, voffA); PG8_STAGE(PG8_SB(1, 1), cB + hstep + kstep, voffB);
    PG8_WAIT_V(6); PG8_BAR;
    for (;;) {
        const bool has_next = S.next(ui + 1, nxt);
        const char* nA = has_next ? (const char*)g.A + (size_t)nxt.pm * tstep : cA; const char* nB = has_next ? (const char*)g.Bt + (size_t)nxt.pn * tstep : cB;
        for (int t = 0; t < nt; t += 2) {
            const bool last = (t == nt - 2);
            const char* a1 = cA + (size_t)(t + 1) * kstep;
            const char* a2 = last ? nA : cA + (size_t)(t + 2) * kstep; const char* b2 = last ? nB : cB + (size_t)(t + 2) * kstep;
            const char* a3 = a2 + kstep; const char* b3 = b2 + kstep;
            PG8_LDB(B0, 0, 0); PG8_SCHED; PG8_LDA(At, 0, 0); PG8_STAGE(PG8_SA(1, 1), a1 + hstep, voffA);
            PG8_WAIT_L(8); PG8_BAR; PG8_WAIT_L(0); PG8_MMA(0, 0, At, B0); PG8_BAR; PG8_SCHED;
            PG8_LDB(B1, 0, 1); PG8_STAGE(PG8_SB(0, 0), b2, voffB);
            PG8_BAR; PG8_WAIT_L(0); PG8_MMA(0, 1, At, B1); PG8_BAR;
            PG8_LDA(At, 0, 1); PG8_STAGE(PG8_SA(0, 0), a2, voffA);
            PG8_BAR; PG8_WAIT_L(0); PG8_MMA(1, 0, At, B0); PG8_BAR; PG8_SCHED;
            PG8_STAGE(PG8_SB(0, 1), b2 + hstep, voffB);
            PG8_WAIT_V(6); PG8_BAR; PG8_MMA(1, 1, At, B1); PG8_BAR;
            PG8_LDB(B0, 1, 0); PG8_SCHED; PG8_LDA(At, 1, 0); PG8_STAGE(PG8_SA(0, 1), a2 + hstep, voffA);
            PG8_WAIT_L(8); PG8_BAR; PG8_WAIT_L(0); PG8_MMA(0, 0, At, B0); PG8_BAR; PG8_SCHED;
            PG8_LDB(B1, 1, 1); PG8_STAGE(PG8_SB(1, 0), b3, voffB);
            PG8_BAR; PG8_WAIT_L(0); PG8_MMA(0, 1, At, B1); PG8_BAR;
            PG8_LDA(At, 1, 1); PG8_STAGE(PG8_SA(1, 0), a3, voffA);
            PG8_BAR; PG8_WAIT_L(0); PG8_MMA(1, 0, At, B0); PG8_BAR; PG8_SCHED;
            PG8_STAGE(PG8_SB(1, 1), b3 + hstep, voffB);
            PG8_WAIT_V(6); PG8_BAR; PG8_MMA(1, 1, At, B1); PG8_BAR;
        }
        E(acc, cur, wr, wc, fr, fq);
        if (!has_next) break;
#pragma unroll
        for (int a = 0; a < 2; ++a)
#pragma unroll
            for (int b = 0; b < 2; ++b)
#pragma unroll
                for (int m = 0; m < 4; ++m)
#pragma unroll
                    for (int n = 0; n < 2; ++n) acc[a][b][m][n] = (f32x4){0.f, 0.f, 0.f, 0.f};
        cur = nxt; cA = nA; cB = nB; ++ui;
    }
    PG8_WAIT_V(0);
    if (wr == 0) PG8_BAR;
    PG8_BAR;
#undef PG8_SA
#undef PG8_SB
#undef PG8_STAGE
#undef PG8_LDA
#undef PG8_LDB
#undef PG8_MMA
#undef PG8_WAIT_V
#undef PG8_WAIT_L
#undef PG8_BAR
#undef PG8_SCHED
}
}

__device__ __forceinline__ void p0_transpose_item(const float* W, int K, int ldN, int nblk, bf16_t* WT, const float* gain, LAS float* scr, int item, int lane) {
    const int kb = item / nblk, nb = item % nblk, k0 = 64 * kb, n0 = 32 * nb;
#pragma unroll 8
    for (int i = 0; i < 32; ++i) { const int kk = 2 * i + (lane >> 5); const float gk = gain ? gain[k0 + kk] : 1.f;
        scr[kk * 33 + (lane & 31)] = W[(size_t)(k0 + kk) * ldN + n0 + (lane & 31)] * gk; }
    asm volatile("s_waitcnt lgkmcnt(0)" ::: "memory");
    const int c = lane & 7;
#pragma unroll
    for (int j = 0; j < 4; ++j) { const int n = (lane >> 3) + 8 * j; const LAS float* s = scr + (8 * c) * 33 + n;
        u32x4 o; o.x = cvt_pk_bf16(s[0 * 33], s[1 * 33]); o.y = cvt_pk_bf16(s[2 * 33], s[3 * 33]); o.z = cvt_pk_bf16(s[4 * 33], s[5 * 33]); o.w = cvt_pk_bf16(s[6 * 33], s[7 * 33]);
        *(u32x4*)(WT + (size_t)(n0 + n) * K + k0 + 8 * c) = o; }
    asm volatile("s_waitcnt lgkmcnt(0)" ::: "memory");
}
__device__ __forceinline__ void p0_fold_item(const float* Win  , const float* gpre, bf16_t* WT  , const LAS float* tab, int item, int lane) {
    const int kb = item >> 3, g = item & 7, k = kb * 64 + lane;
    const float gk = gpre[k] * 0.125f;
    const f32x4* src = (const f32x4*)(Win + (size_t)k * DIN + 1536 + g * 64);
    float row[64];
#pragma unroll
    for (int i = 0; i < 16; ++i) { const f32x4 v = src[i]; row[4 * i] = v.x * gk; row[4 * i + 1] = v.y * gk; row[4 * i + 2] = v.z * gk; row[4 * i + 3] = v.w * gk; }
    for (int j = 0; j < 64; ++j) {
        const int cj = (j == 0) ? 0 : (j == 1 ? 32 : (j >> 1)), off = (j >= 2 && (j & 1)) ? 16 : 0;
        float acc = 0.f;
#pragma unroll
        for (int d = 0; d < 64; ++d) acc += row[d] * tab[(cj * d + off) & 63];
        WT[(size_t)(1536 + g * 64 + j) * D + k] = (bf16_t)(cvt_pk_bf16(acc, 0.f) & 0xffffu);
    }
}
__device__ __forceinline__ void x_row_init(const float* xrow, bf16_t* orow, float* rs, int lane) {
    const f32x4* xr = (const f32x4*)xrow + lane;
    f32x4 v[4]; float s = 0.f;
#pragma unroll
    for (int j = 0; j < 4; ++j) { v[j] = xr[64 * j]; s += (v[j].x * v[j].x + v[j].y * v[j].y) + (v[j].z * v[j].z + v[j].w * v[j].w); }
    const float rstd = rsqrtf(wave_sum(s) * (1.f / D) + EPS);
    u32x2* o8 = (u32x2*)orow + lane;
#pragma unroll
    for (int j = 0; j < 4; ++j) { u32x2 w; w.x = cvt_pk_bf16(v[j].x, v[j].y); w.y = cvt_pk_bf16(v[j].z, v[j].w); o8[64 * j] = w; }
    if (lane == 0) *rs = rstd;
}

template <int NR>
__device__ __forceinline__ void row_pass_rows(bf16_t* X, const bf16_t* MF, const float* gain, float* rs, float* outf, int t0, int lane) {
    u32x4 xa[NR][2], ma[NR][2];
#pragma unroll
    for (int r = 0; r < NR; ++r) { const u32x4* xr = (const u32x4*)(X + (size_t)(t0 + r) * D); const u32x4* mr = (const u32x4*)(MF + (size_t)(t0 + r) * D);
        xa[r][0] = xr[lane]; xa[r][1] = xr[64 + lane]; ma[r][0] = mr[lane]; ma[r][1] = mr[64 + lane]; }
    float g[16];
    { const f32x4* g0 = (const f32x4*)(gain + lane * 8); const f32x4* g1 = (const f32x4*)(gain + 512 + lane * 8);
#pragma unroll
      for (int h = 0; h < 2; ++h) { const f32x4 a = g0[h], b = g1[h];
#pragma unroll
        for (int k = 0; k < 4; ++k) { g[4 * h + k] = a[k]; g[8 + 4 * h + k] = b[k]; } } }
#pragma unroll
    for (int r = 0; r < NR; ++r) {
        float x[16], m[16];
#pragma unroll
        for (int h = 0; h < 2; ++h) { const u32x4 xq = xa[r][h], mq = ma[r][h];
            x[8 * h + 0] = bf_lo(xq.x); x[8 * h + 1] = bf_hi(xq.x); x[8 * h + 2] = bf_lo(xq.y); x[8 * h + 3] = bf_hi(xq.y); x[8 * h + 4] = bf_lo(xq.z); x[8 * h + 5] = bf_hi(xq.z); x[8 * h + 6] = bf_lo(xq.w); x[8 * h + 7] = bf_hi(xq.w);
            m[8 * h + 0] = bf_lo(mq.x); m[8 * h + 1] = bf_hi(mq.x); m[8 * h + 2] = bf_lo(mq.y); m[8 * h + 3] = bf_hi(mq.y); m[8 * h + 4] = bf_lo(mq.z); m[8 * h + 5] = bf_hi(mq.z); m[8 * h + 6] = bf_lo(mq.w); m[8 * h + 7] = bf_hi(mq.w); }
        float sm = 0.f;
#pragma unroll
        for (int k = 0; k < 16; ++k) sm += m[k] * m[k];
        const float rm = rsqrtf(wave_sum(sm) * (1.f / D) + EPS);
        float s1 = 0.f;
#pragma unroll
        for (int k = 0; k < 16; ++k) { x[k] = x[k] + m[k] * rm * g[k]; s1 += x[k] * x[k]; }
        if (outf) {
            f32x4* o = (f32x4*)(outf + (size_t)(t0 + r) * D);
            o[lane * 2] = (f32x4){x[0], x[1], x[2], x[3]}; o[lane * 2 + 1] = (f32x4){x[4], x[5], x[6], x[7]};
            o[128 + lane * 2] = (f32x4){x[8], x[9], x[10], x[11]}; o[128 + lane * 2 + 1] = (f32x4){x[12], x[13], x[14], x[15]};
        } else {
            const float r1 = rsqrtf(wave_sum(s1) * (1.f / D) + EPS);
            u32x4* xo = (u32x4*)(X + (size_t)(t0 + r) * D);
            u32x4 w0, w1;
            w0.x = cvt_pk_bf16(x[0], x[1]); w0.y = cvt_pk_bf16(x[2], x[3]); w0.z = cvt_pk_bf16(x[4], x[5]); w0.w = cvt_pk_bf16(x[6], x[7]);
            w1.x = cvt_pk_bf16(x[8], x[9]); w1.y = cvt_pk_bf16(x[10], x[11]); w1.z = cvt_pk_bf16(x[12], x[13]); w1.w = cvt_pk_bf16(x[14], x[15]);
            xo[lane] = w0; xo[64 + lane] = w1;
            if (lane == 0) rs[t0 + r] = r1;
        }
    }
}

__device__ __forceinline__ void conv_wave_item(const bf16_t* p, const float* cw, bf16_t* Hm, int t0, int pos0, int S, int lane) {
    float w0[8], w1[8], w2[8];
    { const f32x4* a = (const f32x4*)(cw + lane * 8); const f32x4* b = (const f32x4*)(cw + 512 + lane * 8); const f32x4* c = (const f32x4*)(cw + 1024 + lane * 8);
#pragma unroll
      for (int h = 0; h < 2; ++h) { const f32x4 va = a[h], vb = b[h], vc = c[h];
#pragma unroll
        for (int k = 0; k < 4; ++k) { w0[4 * h + k] = va[k]; w1[4 * h + k] = vb[k]; w2[4 * h + k] = vc[k]; } } }
    float zp[8], zc[8], zn[8], ga[8], gb[8];
    const bf16_t* base = p + (size_t)t0 * DIN + lane * 8;
    if (pos0 == 0) {
#pragma unroll
        for (int k = 0; k < 8; ++k) zp[k] = 0.f;
    } else { load8(base - DIN + 512, ga); load8(base - DIN + 1024, gb);
#pragma unroll
        for (int k = 0; k < 8; ++k) zp[k] = ga[k] * gb[k]; }
    load8(base + 512, ga); load8(base + 1024, gb);
#pragma unroll
    for (int k = 0; k < 8; ++k) zc[k] = ga[k] * gb[k];
#pragma unroll 4
    for (int i = 0; i < 16; ++i) {
        const bf16_t* r = base + (size_t)i * DIN;
        if (pos0 + i + 1 == S) {
#pragma unroll
            for (int k = 0; k < 8; ++k) zn[k] = 0.f;
        } else { load8(r + DIN + 512, ga); load8(r + DIN + 1024, gb);
#pragma unroll
            for (int k = 0; k < 8; ++k) zn[k] = ga[k] * gb[k]; }
        load8(r, gb);
        float y[8], ss = 0.f;
#pragma unroll
        for (int k = 0; k < 8; ++k) { y[k] = gb[k] * (zp[k] * w0[k] + zc[k] * w1[k] + zn[k] * w2[k]); ss += y[k] * y[k]; }
        ss += __shfl_xor(ss, 1); ss += __shfl_xor(ss, 2); ss += __shfl_xor(ss, 4);
        const float rs = rsqrtf(ss * (1.f / 64.f) + EPS);
        u32x4 o; o.x = cvt_pk_bf16(y[0] * rs, y[1] * rs); o.y = cvt_pk_bf16(y[2] * rs, y[3] * rs); o.z = cvt_pk_bf16(y[4] * rs, y[5] * rs); o.w = cvt_pk_bf16(y[6] * rs, y[7] * rs);
        *(u32x4*)(Hm + (size_t)(t0 + i) * D + lane * 8) = o;
#pragma unroll
        for (int k = 0; k < 8; ++k) { zp[k] = zc[k]; zc[k] = zn[k]; }
    }
}

__device__ __forceinline__ LAS f32x2* fft_stages(LAS f32x2* X, LAS f32x2* Y, const LAS f32x2* tw, int ntile, int log2n, int tid) {
    const int n = 1 << log2n, half = n >> 1, twsh = 7 - log2n;
    const int total = ntile * half * 32;
    for (int st = 0; st < log2n; ++st) {
        const int s = 1 << st;
        for (int idx = tid; idx < total; idx += NTHREADS) {
            const int c = idx & 31, jj = idx >> 5, tile = jj >> (log2n - 1), j = jj & (half - 1);
            const int p = j >> st, base = tile * n * 32;
            const f32x2 a = X[base + j * 32 + c], b = X[base + (j + half) * 32 + c];
            const f32x2 w = tw[(p << st) << twsh];
            const f32x2 sm = a + b, df = a - b;
            const int o = base + (j + s * p) * 32 + c;
            Y[o] = sm;
            Y[o + s * 32] = (f32x2){df.x * w.x - df.y * w.y, df.x * w.y + df.y * w.x};
        }
        __syncthreads();
        LAS f32x2* t = X; X = Y; Y = t;
    }
    return X;
}
__device__ __forceinline__ int seq_base(int bs) { return bs < BP ? bs * SP : TP + (bs - BP) * SS; }

__device__ __forceinline__ void fft_pass1_item(const bf16_t* p, f32x2* inter, LAS unsigned char* lds, const LAS f32x2* tw, int item, int tid) {
    int bs, g, n2, S, log2N2;
    if (item < 2048) { bs = item >> 10; const int r = item & 1023; n2 = r >> 3; g = r & 7; S = SP; log2N2 = 7; }
    else { const int it = item - 2048; bs = BP + (it >> 9); const int r = it & 511; n2 = r >> 3; g = r & 7; S = SS; log2N2 = 6; }
    const int N2 = 1 << log2N2, tb = seq_base(bs);
    LAS f32x2* X = (LAS f32x2*)lds; LAS f32x2* Y = (LAS f32x2*)(lds + 65536);
#pragma unroll
    for (int i = 0; i < 2; ++i) { const int q = tid + NTHREADS * i, row = q >> 3, ch = q & 7;
        const u32x4 v = *(const u32x4*)(p + (size_t)(tb + N2 * row + n2) * DIN + 1536 + g * 64 + ch * 8);
        LAS f32x4* dst = (LAS f32x4*)(X + row * 32 + ch * 4);
        dst[0] = (f32x4){bf_lo(v.x), bf_hi(v.x), bf_lo(v.y), bf_hi(v.y)}; dst[1] = (f32x4){bf_lo(v.z), bf_hi(v.z), bf_lo(v.w), bf_hi(v.w)}; }
    __syncthreads();
    const LAS f32x2* R = fft_stages(X, Y, tw, 1, 7, tid);
    f32x2* ob = inter + (size_t)tb * 256 + (size_t)g * S * 32;
    const float invS = 1.f / (float)S;
#pragma unroll
    for (int i = 0; i < 8; ++i) { const int idx = tid + NTHREADS * i, c = idx & 31, k1 = idx >> 5;
        const f32x2 v = R[k1 * 32 + c];
        float sn, cs; sincospif(-2.0f * (float)(n2 * k1) * invS, &sn, &cs);
        ob[(size_t)(k1 * N2 + n2) * 32 + c] = (f32x2){v.x * cs - v.y * sn, v.x * sn + v.y * cs}; }
    __syncthreads();
}

__device__ __forceinline__ void fft_pass2_item(const f32x2* inter, bf16_t* Hm, LAS unsigned char* lds, const LAS f32x2* tw, int item, int tid) {
    int bs, g, ip, S, log2N2;
    if (item < 1024) { bs = item >> 9; const int r = item & 511; g = r >> 6; ip = r & 63; S = SP; log2N2 = 7; }
    else { const int it = item - 1024; bs = BP + (it >> 9); const int r = it & 511; g = r >> 6; ip = r & 63; S = SS; log2N2 = 6; }
    const int N2 = 1 << log2N2, tb = seq_base(bs);
    const int k1a = ip == 0 ? 0 : ip, k1b = ip == 0 ? 64 : 128 - ip;
    LAS f32x2* X = (LAS f32x2*)lds; LAS f32x2* Y = (LAS f32x2*)(lds + 65536);
    const f32x2* ib = inter + (size_t)tb * 256 + (size_t)g * S * 32;
    const int chunks = N2 * 16;
    for (int idx = tid; idx < 2 * chunks; idx += NTHREADS) { const int h = idx >= chunks, r = idx - h * chunks;
        const f32x4 v = ((const f32x4*)(ib + (size_t)((h ? k1b : k1a) * N2) * 32))[r];
        ((LAS f32x4*)(X + h * N2 * 32))[r] = v; }
    __syncthreads();
    const LAS f32x2* R = fft_stages(X, Y, tw, 2, log2N2, tid);
    LAS bf16_t* Ost = (LAS bf16_t*)((R == X) ? Y : X);
    const float sc = rsqrtf((float)S);
    for (int idx = tid; idx < 2 * N2 * 32; idx += NTHREADS) {
        const int c = idx & 31, tl = idx >> 5, h = tl >> log2N2, k2 = tl & (N2 - 1);
        const int ph = (ip == 0) ? h : 1 - h;
        const int k2p = (ip == 0 && h == 0) ? ((N2 - k2) & (N2 - 1)) : (N2 - 1 - k2);
        const f32x2 own = R[(h * N2 + k2) * 32 + c], par = R[(ph * N2 + k2p) * 32 + c];
        float v1 = (c == 0) ? 0.5f * (own.x + par.x) : own.x, v2 = (c == 0) ? 0.5f * (own.y + par.y) : par.x;
        v1 *= sc; v2 *= sc;
        float ss = v1 * v1 + v2 * v2;
        ss += __shfl_xor(ss, 1); ss += __shfl_xor(ss, 2); ss += __shfl_xor(ss, 4); ss += __shfl_xor(ss, 8); ss += __shfl_xor(ss, 16);
        const float rs = rsqrtf(ss * (1.f / 64.f) + EPS);
        Ost[tl * 64 + c] = (bf16_t)(cvt_pk_bf16(v1 * rs, 0.f) & 0xffffu);
        Ost[tl * 64 + (c == 0 ? 32 : 64 - c)] = (bf16_t)(cvt_pk_bf16(v2 * rs, 0.f) & 0xffffu);
    }
    __syncthreads();
    for (int idx = tid; idx < 2 * N2 * 8; idx += NTHREADS) {
        const int tl = idx >> 3, ch = idx & 7, h = tl >> log2N2, k2 = tl & (N2 - 1);
        const int tok = tb + (h ? k1b : k1a) + 128 * k2;
        *(u32x4*)(Hm + (size_t)tok * D + 512 + g * 64 + ch * 8) = ((const LAS u32x4*)Ost)[idx];
    }
    __syncthreads();
}


#define XB_TMO      128
#define XB_XCNT(j)  (256  + 64 * (j))
#define XB_XSUB(j)  (1280 + 64 * (j))
#define XB_XGEN(j)  (2304 + 64 * (j))
#define XB_TOP      3328
#define XB_TOPGEN   3392
#define XCD_BAR_WORDS 3456
#define XB_SPIN_CAP (1u << 20)
__device__ __forceinline__ unsigned xb_ld(unsigned* p)              { return __hip_atomic_load(p, __ATOMIC_RELAXED, __HIP_MEMORY_SCOPE_AGENT); }
__device__ __forceinline__ unsigned xb_add(unsigned* p, unsigned v) { return __hip_atomic_fetch_add(p, v, __ATOMIC_RELAXED, __HIP_MEMORY_SCOPE_AGENT); }
__device__ __forceinline__ unsigned xb_xcc_id() { return (unsigned)__builtin_amdgcn_s_getreg((3 << 11) | 20) & 0xFu; }
#define XB_SPIN(cond, bar) do { unsigned _sp = 0; while (cond) { __builtin_amdgcn_s_sleep(1); \
    if ((++_sp & 255u) == 0u) { if (xb_ld(&(bar)[XB_TMO])) break; if (_sp > XB_SPIN_CAP) { atomicAdd(&(bar)[XB_TMO], 1u); break; } } } } while (0)
struct XcdBarrier { unsigned* bar; unsigned x; volatile LAS unsigned* st; };
__device__ __forceinline__ XcdBarrier xcd_barrier_post(unsigned* bar, volatile LAS unsigned* st) {
    XcdBarrier b; b.bar = bar; b.x = xb_xcc_id(); b.st = st;
    if (threadIdx.x == 0) (void)xb_add(&bar[XB_XCNT(b.x)], 1u);
    return b;
}
__device__ __forceinline__ void xcd_barrier_complete(unsigned* bar, unsigned x, unsigned& nloc, unsigned& nx) {
    const unsigned G = gridDim.x * gridDim.y * gridDim.z;
    unsigned sum, cnt, mine, sp = 0u;
    for (;;) {
        sum = 0u; cnt = 0u; mine = 0u;
#pragma unroll
        for (unsigned j = 0; j < 16; ++j) { const unsigned c = xb_ld(&bar[XB_XCNT(j)]); sum += c; cnt += (c > 0u) ? 1u : 0u; mine = (j == x) ? c : mine; }
        if (sum == G) break;
        __builtin_amdgcn_s_sleep(1);
        if ((++sp & 255u) == 0u) { if (xb_ld(&bar[XB_TMO])) break; if (sp > XB_SPIN_CAP) { atomicAdd(&bar[XB_TMO], 1u); break; } }
    }
    nloc = mine > 0u ? mine : 1u; nx = cnt > 0u ? cnt : 1u;
}
__device__ __forceinline__ void xcd_barrier(const XcdBarrier& b) {
    asm volatile("s_waitcnt vmcnt(0)" ::: "memory");
    __syncthreads();
    if (threadIdx.x == 0) {
        unsigned* bar = b.bar;
        __builtin_amdgcn_s_waitcnt(0);
        unsigned nloc = b.st[0], nx = b.st[1];
        if (nloc == 0u) { xcd_barrier_complete(bar, b.x, nloc, nx); b.st[0] = nloc; b.st[1] = nx; }
        const unsigned old = xb_add(&bar[XB_XSUB(b.x)], 1u);
        const unsigned gen = old / nloc;
        if (old + 1u == (gen + 1u) * nloc) {
            __builtin_amdgcn_fence(__ATOMIC_RELEASE, "agent");
            asm volatile("s_waitcnt vmcnt(0)" ::: "memory");
            const unsigned og = xb_add(&bar[XB_TOP], 1u);
            const unsigned tg = og / nx;
            if (og + 1u == (tg + 1u) * nx) xb_add(&bar[XB_TOPGEN], 1u);
            else XB_SPIN(xb_ld(&bar[XB_TOPGEN]) == tg, bar);
            __builtin_amdgcn_fence(__ATOMIC_ACQUIRE, "agent");
            xb_add(&bar[XB_XGEN(b.x)], 1u);
            asm volatile("s_waitcnt vmcnt(0)" ::: "memory");
        } else {
            XB_SPIN(xb_ld(&bar[XB_XGEN(b.x)]) == gen, bar);
            __builtin_amdgcn_fence(__ATOMIC_ACQUIRE, "agent");
            asm volatile("s_waitcnt vmcnt(0)" ::: "memory");
        }
    }
    __syncthreads();
}

__global__ void __launch_bounds__(NTHREADS, 2) fwd_megakernel(Params P) {
    extern __shared__ __attribute__((aligned(16))) unsigned char shm[];
    cg::grid_group grid = cg::this_grid();
    LAS unsigned char* lds = (LAS unsigned char*)shm;
    const int G = gridDim.x, bid = blockIdx.x, NGW = G * NWAVES;
#define FRESH() int tid = threadIdx.x; asm volatile("" : "+v"(tid)); const int lane = tid & 63, wave = __builtin_amdgcn_readfirstlane(tid >> 6), gw = bid * NWAVES + wave; (void)lane; (void)gw
#define TAB ((LAS float*)(lds + LDS_MISC))
#define TWD ((LAS f32x2*)(lds + LDS_MISC + 512))
    { FRESH();
      if (tid < 64) { TAB[tid] = cospif((float)tid * (1.f / 32.f)); float sn, cs; sincospif((float)tid * (1.f / 64.f), &sn, &cs); TWD[tid] = (f32x2){cs, -sn}; }
      if (tid < 4) ((volatile LAS unsigned*)(lds + LDS_MISC + 1024))[tid] = 0u; }
    __syncthreads();
    const XcdBarrier xbar = xcd_barrier_post((unsigned*)P.ws, (volatile LAS unsigned*)(lds + LDS_MISC + 1024));
#define GSYNC() xcd_barrier(xbar)

    unsigned char* ws = P.ws;
#define Xb ((bf16_t*)(ws + WS_X))
#define Hb ((bf16_t*)(ws + WS_H))
#define Pb ((bf16_t*)P.out)
#define Ib ((f32x2*)(ws + WS_INTER))
#define MFb ((bf16_t*)(ws + WS_MF))
#define Ab ((bf16_t*)P.out)
#define RSb ((float*)(ws + WS_RS))

    {
        FRESH();
        LAS float* scr = (LAS float*)(lds + wave * 8704);
        constexpr int I_IN = 16 * 48, I_OUT = 16 * 32, I_UP = 16 * 128, I_DN = 64 * 32, I_F = 128, I_L = I_IN + I_OUT + I_UP + I_DN + I_F;
        for (int it = gw; it < NL * I_L; it += NGW) {
            const int l = it / I_L; int r = it % I_L;
            bf16_t* Wl = (bf16_t*)(ws + WS_W + (size_t)l * WL_SZ);
            const float* win = P.w_in + (size_t)l * D * DIN;
            if (r < I_IN) { p0_transpose_item(win, D, DIN, 48, Wl + WL_IN / 2, P.g_mix_pre + l * D, scr, r, lane); continue; } r -= I_IN;
            if (r < I_OUT) {
                const int kb = r / 32; const float* gsrc = kb < 8 ? P.g_conv_out + l * 512 : P.g_fourier_out + l * 512 - 512;
                p0_transpose_item(P.w_out + (size_t)l * D * D, D, D, 32, Wl + WL_OUT / 2, gsrc, scr, r, lane); continue; } r -= I_OUT;
            if (r < I_UP) { p0_transpose_item(P.w_up + (size_t)l * D * DFF, D, DFF, 128, Wl + WL_UP / 2, P.g_mlp_pre + l * D, scr, r, lane); continue; } r -= I_UP;
            if (r < I_DN) { p0_transpose_item(P.w_down + (size_t)l * DFF * D, DFF, D, 32, Wl + WL_DN / 2, nullptr, scr, r, lane); continue; } r -= I_DN;
            p0_fold_item(win, P.g_mix_pre + l * D, Wl + WL_IN / 2, TAB, r, lane);
        }
        for (int t = gw; t < T; t += NGW) x_row_init(t < TP ? P.xp + (size_t)t * D : P.xs + (size_t)(t - TP) * D, Xb + (size_t)t * D, RSb + t, lane);
    }
    grid.sync();

    for (int l = 0; l < NL; ++l) {
        const bf16_t* Wl = (const bf16_t*)(ws + WS_W + (size_t)l * WL_SZ);
        { pg8::Gemm g{Xb, Wl + WL_IN / 2, T, DIN, D}; pg8::StaticOrder S; S.init(T, DIN, G, bid); pg8::EpiBf16 E{Pb, DIN, 0, RSb};
          pg8::gemm_phase(lds, g, S, E); }
        GSYNC();
        {
            FRESH();
            constexpr int NCONV = T / 128, NP1 = 2048 + 4096;
            for (int it = bid; it < NCONV + NP1; it += G) {
                if (it < NCONV) { const int t0 = it * 128 + wave * 16; const int S = t0 < TP ? SP : SS; const int pos0 = t0 < TP ? (t0 & (SP - 1)) : ((t0 - TP) & (SS - 1));
                    conv_wave_item(Pb, P.conv_w + (size_t)l * 3 * 512, Hb, t0, pos0, S, lane); }
                else fft_pass1_item(Pb, Ib, lds, TWD, it - NCONV, tid);
            }
        }
        GSYNC();
        { FRESH();
          for (int it = bid; it < 1024 + 4096; it += G) fft_pass2_item(Ib, Hb, lds, TWD, it, tid); }
        GSYNC();
        { pg8::Gemm g{Hb, Wl + WL_OUT / 2, T, D, D}; pg8::StaticOrder S; S.init(T, D, G, bid); pg8::EpiBf16 E{MFb, D, 0, nullptr};
          pg8::gemm_phase(lds, g, S, E); }
        GSYNC();
        { FRESH();
          for (int t = gw * 4; t < T; t += NGW * 4) row_pass_rows<4>(Xb, MFb, P.g_mix_post + l * D, RSb, nullptr, t, lane); }
        GSYNC();
        for (int ch = 0; ch < NCH; ++ch) {
            { pg8::Gemm g{Xb + (size_t)ch * TCH * D, Wl + WL_UP / 2, TCH, DFF, D}; pg8::StaticOrder S; S.init(TCH, DFF, G, bid); pg8::EpiBf16 E{Ab, DFF, 1, RSb + ch * TCH};
              pg8::gemm_phase(lds, g, S, E); }
            GSYNC();
            { pg8::Gemm g{Ab, Wl + WL_DN / 2, TCH, D, DFF}; pg8::StaticOrder S; S.init(TCH, D, G, bid); pg8::EpiBf16 E{MFb + (size_t)ch * TCH * D, D, 0, nullptr};
              pg8::gemm_phase(lds, g, S, E); }
            GSYNC();
        }
        { FRESH();
          float* outf = (l + 1 < NL) ? nullptr : P.out;
          for (int t = gw * 4; t < T; t += NGW * 4) row_pass_rows<4>(Xb, MFb, P.g_mlp_post + l * D, RSb, outf, t, lane); }
        if (l + 1 < NL) GSYNC();
    }
}

extern "C" void kernel_launch(void* const* d_in, const int* in_sizes, int n_in, void* d_out, int out_size, void* d_ws, size_t ws_size, hipStream_t stream) {
    static int grid_blocks = 0;
    if (grid_blocks == 0) {
        if (n_in != 13 || out_size != T * D || ws_size < WS_END) { fprintf(stderr, "kernel_launch: unexpected shapes (n_in %d, out %d, ws %zu, need %zu)\n", n_in, out_size, ws_size, (size_t)WS_END); grid_blocks = -1; return; }
        int dev = 0, cus = 0, per_cu = 0;
        hipGetDevice(&dev);
        hipDeviceGetAttribute(&cus, hipDeviceAttributeMultiprocessorCount, dev);
        if (hipFuncSetAttribute((const void*)fwd_megakernel, hipFuncAttributeMaxDynamicSharedMemorySize, LDS_BYTES) != hipSuccess) { fprintf(stderr, "kernel_launch: hipFuncSetAttribute failed\n"); grid_blocks = -1; return; }
        hipOccupancyMaxActiveBlocksPerMultiprocessor(&per_cu, (const void*)fwd_megakernel, NTHREADS, LDS_BYTES);
        if (per_cu < 1) { fprintf(stderr, "kernel_launch: occupancy query says %d blocks per CU\n", per_cu); per_cu = 1; }
        grid_blocks = cus * per_cu;
    }
    if (grid_blocks < 0) return;
    Params p{};
    p.xp = (const float*)d_in[0]; p.xs = (const float*)d_in[1]; p.g_mix_pre = (const float*)d_in[2]; p.w_in = (const float*)d_in[3]; p.conv_w = (const float*)d_in[4];
    p.g_conv_out = (const float*)d_in[5]; p.g_fourier_out = (const float*)d_in[6]; p.w_out = (const float*)d_in[7]; p.g_mix_post = (const float*)d_in[8];
    p.g_mlp_pre = (const float*)d_in[9]; p.w_up = (const float*)d_in[10]; p.w_down = (const float*)d_in[11]; p.g_mlp_post = (const float*)d_in[12];
    p.out = (float*)d_out; p.ws = (unsigned char*)d_ws;
    if (hipMemsetAsync(d_ws, 0, 16384, stream) != hipSuccess) { fprintf(stderr, "kernel_launch: memset failed\n"); return; }
    void* args[] = {&p};
    hipError_t e = hipLaunchCooperativeKernel((const void*)fwd_megakernel, dim3(grid_blocks), dim3(NTHREADS), args, LDS_BYTES, stream);
    if (e != hipSuccess) fprintf(stderr, "cooperative launch failed: %s (grid %d)\n", hipGetErrorString(e), grid_blocks);
}
```

```cpp
#include <hip/hip_runtime.h>
#include <hip/hip_cooperative_groups.h>
#include <cstdio>
namespace cg = cooperative_groups;

#define LAS __attribute__((address_space(3)))
typedef unsigned short bf16_t;
typedef short bf16x8 __attribute__((ext_vector_type(8)));
typedef float f32x4 __attribute__((ext_vector_type(4)));
typedef float f32x2 __attribute__((ext_vector_type(2)));
typedef unsigned u32x4 __attribute__((ext_vector_type(4)));
typedef unsigned u32x2 __attribute__((ext_vector_type(2)));

constexpr int D = 1024, DIN = 2048, DFF = 4096, NL = 4;
constexpr int SP = 16384, BP = 2, SS = 8192, BS = 8;
constexpr int TP = BP * SP, TS = BS * SS, T = TP + TS;
constexpr float EPS = 1e-6f;
constexpr int NCH = 2;
constexpr int TCH = T / NCH;

constexpr size_t MiB = (size_t)1 << 20;
constexpr size_t WS_W = 1 * MiB;
constexpr size_t WL_IN = 0, WL_OUT = 4 * MiB, WL_UP = 6 * MiB, WL_DN = 14 * MiB, WL_SZ = 22 * MiB;
constexpr size_t WS_X = WS_W + NL * WL_SZ;
constexpr size_t WS_H = WS_X + (size_t)T * D * 2;
constexpr size_t WS_INTER = WS_H + (size_t)T * D * 2;
constexpr size_t WS_MF = WS_INTER + (size_t)T * 256 * 8;
constexpr size_t WS_RS = WS_MF + (size_t)T * D * 2;
constexpr size_t WS_END = WS_RS + 1 * MiB;

constexpr int LDS_STAGE = 131072, LDS_MISC = 139264, LDS_BYTES = LDS_MISC + 4096;
constexpr int NTHREADS = 512, NWAVES = 8;

struct Params {
    const float* xp; const float* xs; const float* g_mix_pre; const float* w_in; const float* conv_w;
    const float* g_conv_out; const float* g_fourier_out; const float* w_out; const float* g_mix_post;
    const float* g_mlp_pre; const float* w_up; const float* w_down; const float* g_mlp_post;
    float* out; unsigned char* ws;
};

__device__ __forceinline__ unsigned cvt_pk_bf16(float lo, float hi) { unsigned r; asm volatile("v_cvt_pk_bf16_f32 %0, %1, %2" : "=v"(r) : "v"(lo), "v"(hi)); return r; }
__device__ __forceinline__ float bf_lo(unsigned w) { return __uint_as_float(w << 16); }
__device__ __forceinline__ float bf_hi(unsigned w) { return __uint_as_float(w & 0xffff0000u); }
__device__ __forceinline__ float wave_sum(float v) {
#pragma unroll
    for (int o = 1; o < 64; o <<= 1) v += __shfl_xor(v, o);
    return v;
}
__device__ __forceinline__ void load8(const bf16_t* ptr, float (&v)[8]) {
    const u32x4 q = *(const u32x4*)ptr;
    v[0] = bf_lo(q.x); v[1] = bf_hi(q.x); v[2] = bf_lo(q.y); v[3] = bf_hi(q.y); v[4] = bf_lo(q.z); v[5] = bf_hi(q.z); v[6] = bf_lo(q.w); v[7] = bf_hi(q.w);
}

namespace pg8 {
constexpr int BM = 256, BK = 64, HALF = 128, HTB = HALF * BK * 2, STAGE_BYTES = 8 * HTB, NXCD = 8, WGM = 8;
__device__ __forceinline__ int lds_byte(int r, int c) { const int st = (r >> 4) * 2 + (c >> 5), rr = r & 15, cc = c & 31, ob = rr * 64 + cc * 2; return st * 1024 + (ob ^ (((ob >> 9) & 1) << 5)); }
__device__ __forceinline__ void stage_rc(int b, int& R, int& C) { const int st = b / 1024, sb = b % 1024, swz = sb ^ (((sb >> 9) & 1) << 5); R = (st >> 1) * 16 + swz / 64; C = (st & 1) * 32 + (swz % 64) / 2; }
__device__ __forceinline__ int perm32(int rho) { const int n = rho >> 4, i = rho & 15; return 8 * (i >> 2) + 4 * n + (i & 3); }

struct Unit { int pm, pn; };
struct Gemm { const bf16_t* A; const bf16_t* Bt; int M, N, K; };

struct StaticOrder {
    int nM, nN, nwg, G, c;
    __device__ void init(int M, int N, int G_, int c_) { nM = M / BM; nN = N / BM; nwg = nM * nN; G = G_; c = c_; }
    __device__ bool next(int i, Unit& u) const {
        const long L = (long)i * G + c; if (L >= nwg) return false;
        int wgid = (int)L; { const int q = nwg / NXCD, r = nwg % NXCD, xcd = wgid % NXCD, off = wgid / NXCD; wgid = (xcd < r ? xcd * (q + 1) : r * (q + 1) + (xcd - r) * q) + off; }
        const int nig = WGM * nN, gid = wgid / nig, fm = gid * WGM, gsz = (nM - fm) < WGM ? (nM - fm) : WGM;
        u.pm = fm + ((wgid % nig) % gsz); u.pn = (wgid % nig) / gsz; return true;
    }
};

struct EpiBf16 {
    bf16_t* O; int ldc; int act; const float* rs;
    __device__ __forceinline__ void operator()(const f32x4 (&acc)[2][2][4][2], const Unit& u, int wr, int wc, int fr, int fq) const {
        const int row0 = u.pm * BM + wr * 64 + fr; const int col0 = u.pn * BM + wc * 32 + 8 * fq;
#pragma unroll
        for (int ai = 0; ai < 2; ++ai)
#pragma unroll
            for (int m = 0; m < 4; ++m) { bf16_t* rowp = O + (size_t)(row0 + ai * HALF + m * 16) * ldc + col0; const float sc = rs ? rs[row0 + ai * HALF + m * 16] : 1.f;
#pragma unroll
                for (int bj = 0; bj < 2; ++bj) { f32x4 v0 = acc[ai][bj][m][0] * sc, v1 = acc[ai][bj][m][1] * sc;
                    if (act) {
#pragma unroll
                        for (int j = 0; j < 4; ++j) { const float a0 = fmaxf(v0[j], 0.f), a1 = fmaxf(v1[j], 0.f); v0[j] = a0 * a0; v1[j] = a1 * a1; } }
                    u32x4 w; w.x = cvt_pk_bf16(v0[0], v0[1]); w.y = cvt_pk_bf16(v0[2], v0[3]); w.z = cvt_pk_bf16(v1[0], v1[1]); w.w = cvt_pk_bf16(v1[2], v1[3]);
                    *(u32x4*)(rowp + bj * HALF) = w; } }
    }
};

template <class Epi, class Sched>
__device__ __forceinline__ void gemm_phase(LAS unsigned char* lds, const Gemm g, const Sched& S, const Epi& E) {
    int tid_ = threadIdx.x; asm volatile("" : "+v"(tid_));
    const int tid = tid_, wid = __builtin_amdgcn_readfirstlane(tid >> 6), lane = tid & 63, wr = wid >> 2, wc = wid & 3, fr = lane & 15, fq = lane >> 4;
    const int K = g.K, nt = K / BK;
    unsigned voffA[2], voffB[2];
#pragma unroll
    for (int i = 0; i < 2; ++i) { int R, C; stage_rc(tid * 16 + i * 8192, R, C); const int Rb = (R & ~31) + perm32(R & 31);
        voffA[i] = (unsigned)(R * K + C) * 2u; voffB[i] = (unsigned)(Rb * K + C) * 2u; }
    const size_t kstep = (size_t)(BK * 2);
    const size_t hstep = (size_t)HALF * K * 2;
    const size_t tstep = 2 * hstep;
    const unsigned ldsw = (unsigned)wid * 1024u;
    const int aoff = lds_byte(wr * 64 + fr, fq * 8), boff = lds_byte(wc * 32 + fr, fq * 8);
#define PG8_SA(b, h) (((b) * 2 + (h)) * HTB)
#define PG8_SB(b, h) ((4 + (b) * 2 + (h)) * HTB)
#define PG8_STAGE(bufoff, gbase, voff) do { _Pragma("unroll") for (int _i = 0; _i < 2; ++_i) \
        __builtin_amdgcn_global_load_lds((const unsigned*)((const char*)(gbase) + (voff)[_i]), (LAS unsigned*)(lds + (bufoff) + ldsw + _i * 8192), 16, 0, 0); } while (0)
#define PG8_LDA(dst, b, h) do { _Pragma("unroll") for (int m = 0; m < 4; ++m) _Pragma("unroll") for (int k = 0; k < 2; ++k) dst[m][k] = *(const LAS bf16x8*)(lds + PG8_SA(b, h) + aoff + m * 2048 + k * 1024); } while (0)
#define PG8_LDB(dst, b, h) do { _Pragma("unroll") for (int n = 0; n < 2; ++n) _Pragma("unroll") for (int k = 0; k < 2; ++k) dst[n][k] = *(const LAS bf16x8*)(lds + PG8_SB(b, h) + boff + n * 2048 + k * 1024); } while (0)
#define PG8_MMA(ai, bj, At, Bt) do { __builtin_amdgcn_s_setprio(1); _Pragma("unroll") for (int m = 0; m < 4; ++m) _Pragma("unroll") for (int n = 0; n < 2; ++n) _Pragma("unroll") for (int k = 0; k < 2; ++k) \
        acc[ai][bj][m][n] = __builtin_amdgcn_mfma_f32_16x16x32_bf16(Bt[n][k], At[m][k], acc[ai][bj][m][n], 0, 0, 0); __builtin_amdgcn_s_setprio(0); } while (0)
#define PG8_WAIT_V(n) asm volatile("s_waitcnt vmcnt(" #n ")" ::: "memory")
#define PG8_WAIT_L(n) asm volatile("s_waitcnt lgkmcnt(" #n ")" ::: "memory")
#define PG8_BAR __builtin_amdgcn_s_barrier()
#define PG8_SCHED __builtin_amdgcn_sched_barrier(0)
    Unit cur, nxt; int ui = 0;
    if (!S.next(0, cur)) return;
    f32x4 acc[2][2][4][2];
#pragma unroll
    for (int a = 0; a < 2; ++a)
#pragma unroll
        for (int b = 0; b < 2; ++b)
#pragma unroll
            for (int m = 0; m < 4; ++m)
#pragma unroll
                for (int n = 0; n < 2; ++n) acc[a][b][m][n] = (f32x4){0.f, 0.f, 0.f, 0.f};
    bf16x8 At[4][2], B0[2][2], B1[2][2];
    const char* cA = (const char*)g.A + (size_t)cur.pm * tstep; const char* cB = (const char*)g.Bt + (size_t)cur.pn * tstep;
    PG8_STAGE(PG8_SB(0, 0), cB, voffB); PG8_STAGE(PG8_SA(0, 0), cA, voffA); PG8_STAGE(PG8_SB(0, 1), cB + hstep, voffB); PG8_STAGE(PG8_SA(0, 1), cA + hstep, voffA);
    if (wr == 1) PG8_BAR;
    PG8_WAIT_V(4); PG8_BAR;
    PG8_STAGE(PG8_SB(1, 0), cB + kstep, voffB); PG8_STAGE(PG8_SA(1, 0), cA + kstep, voffA); PG8_STAGE(PG8_SB(1, 1), cB + hstep + kstep, voffB);
    PG8_WAIT_V(6); PG8_BAR;
    for (;;) {
        const bool has_next = S.next(ui + 1, nxt);
        const char* nA = has_next ? (const char*)g.A + (size_t)nxt.pm * tstep : cA; const char* nB = has_next ? (const char*)g.Bt + (size_t)nxt.pn * tstep : cB;
        for (int t = 0; t < nt; t += 2) {
            const bool last = (t == nt - 2);
            const char* a1 = cA + (size_t)(t + 1) * kstep;
            const char* a2 = last ? nA : cA + (size_t)(t + 2) * kstep; const char* b2 = last ? nB : cB + (size_t)(t + 2) * kstep;
            const char* a3 = a2 + kstep; const char* b3 = b2 + kstep;
            PG8_LDB(B0, 0, 0); PG8_SCHED; PG8_LDA(At, 0, 0); PG8_STAGE(PG8_SA(1, 1), a1 + hstep, voffA);
            PG8_WAIT_L(8); PG8_BAR; PG8_WAIT_L(0); PG8_MMA(0, 0, At, B0); PG8_BAR; PG8_SCHED;
            PG8_LDB(B1, 0, 1); PG8_STAGE(PG8_SB(0, 0), b2, voffB);
            PG8_BAR; PG8_WAIT_L(0); PG8_MMA(0, 1, At, B1); PG8_BAR;
            PG8_LDA(At, 0, 1); PG8_STAGE(PG8_SA(0, 0), a2, voffA);
            PG8_BAR; PG8_WAIT_L(0); PG8_MMA(1, 0, At, B0); PG8_BAR; PG8_SCHED;
            PG8_STAGE(PG8_SB(0, 1), b2 + hstep, voffB);
            PG8_WAIT_V(6); PG8_BAR; PG8_MMA(1, 1, At, B1); PG8_BAR;
            PG8_LDB(B0, 1, 0); PG8_SCHED; PG8_LDA(At, 1, 0); PG8_STAGE(PG8_SA(0, 1), a2 + hstep, voffA);
            PG8_WAIT_L(8); PG8_BAR; PG8_WAIT_L(0); PG8_MMA(0, 0, At, B0); PG8_BAR; PG8_SCHED;
            PG8_LDB(B1, 1, 1); PG8_STAGE(PG8_SB(1, 0), b3, voffB);
            PG8_BAR; PG8_WAIT_L(0); PG8_MMA(0, 1, At, B1); PG8_BAR;
            PG8_LDA(At, 1, 1); PG8_STAGE(PG8_SA(1, 0), a3, voffA);
            PG8_BAR; PG8_WAIT_L(0); PG8_MMA(1, 0, At, B0); PG8_BAR; PG8_SCHED;
            PG8_STAGE(PG8_SB(1, 1), b3 + hstep, voffB);
            PG8_WAIT_V(6); PG8_BAR; PG8_MMA(1, 1, At, B1); PG8_BAR;
        }
        E(acc, cur, wr, wc, fr, fq);
        if (!has_next) break;
#pragma unroll
        for (int a = 0; a < 2; ++a)
#pragma unroll
            for (int b = 0; b < 2; ++b)
#pragma unroll
                for (int m = 0; m < 4; ++m)
#pragma unroll
                    for (int n = 0; n < 2; ++n) acc[a][b][m][n] = (f32x4){0.f, 0.f, 0.f, 0.f};
        cur = nxt; cA = nA; cB = nB; ++ui;
    }
    PG8_WAIT_V(0);
    if (wr == 0) PG8_BAR;
    PG8_BAR;
#undef PG8_SA
#undef PG8_SB
#undef PG8_STAGE
#undef PG8_LDA
#undef PG8_LDB
#undef PG8_MMA
#undef PG8_WAIT_V
#undef PG8_WAIT_L
#undef PG8_BAR
#undef PG8_SCHED
}
}

__device__ __forceinline__ void p0_transpose_item(const float* W, int K, int ldN, int nblk, bf16_t* WT, const float* gain, LAS float* scr, int item, int lane) {
    const int kb = item / nblk, nb = item % nblk, k0 = 64 * kb, n0 = 32 * nb;
#pragma unroll 8
    for (int i = 0; i < 32; ++i) { const int kk = 2 * i + (lane >> 5); const float gk = gain ? gain[k0 + kk] : 1.f;
        scr[kk * 33 + (lane & 31)] = W[(size_t)(k0 + kk) * ldN + n0 + (lane & 31)] * gk; }
    asm volatile("s_waitcnt lgkmcnt(0)" ::: "memory");
    const int c = lane & 7;
#pragma unroll
    for (int j = 0; j < 4; ++j) { const int n = (lane >> 3) + 8 * j; const LAS float* s = scr + (8 * c) * 33 + n;
        u32x4 o; o.x = cvt_pk_bf16(s[0 * 33], s[1 * 33]); o.y = cvt_pk_bf16(s[2 * 33], s[3 * 33]); o.z = cvt_pk_bf16(s[4 * 33], s[5 * 33]); o.w = cvt_pk_bf16(s[6 * 33], s[7 * 33]);
        *(u32x4*)(WT + (size_t)(n0 + n) * K + k0 + 8 * c) = o; }
    asm volatile("s_waitcnt lgkmcnt(0)" ::: "memory");
}
__device__ __forceinline__ void p0_fold_item(const float* Win  , const float* gpre, bf16_t* WT  , const LAS float* tab, int item, int lane) {
    const int kb = item >> 3, g = item & 7, k = kb * 64 + lane;
    const float gk = gpre[k] * 0.125f;
    const f32x4* src = (const f32x4*)(Win + (size_t)k * DIN + 1536 + g * 64);
    float row[64];
#pragma unroll
    for (int i = 0; i < 16; ++i) { const f32x4 v = src[i]; row[4 * i] = v.x * gk; row[4 * i + 1] = v.y * gk; row[4 * i + 2] = v.z * gk; row[4 * i + 3] = v.w * gk; }
    for (int j = 0; j < 64; ++j) {
        const int cj = (j == 0) ? 0 : (j == 1 ? 32 : (j >> 1)), off = (j >= 2 && (j & 1)) ? 16 : 0;
        float acc = 0.f;
#pragma unroll
        for (int d = 0; d < 64; ++d) acc += row[d] * tab[(cj * d + off) & 63];
        WT[(size_t)(1536 + g * 64 + j) * D + k] = (bf16_t)(cvt_pk_bf16(acc, 0.f) & 0xffffu);
    }
}
__device__ __forceinline__ void x_row_init(const float* xrow, bf16_t* orow, float* rs, int lane) {
    const f32x4* xr = (const f32x4*)xrow + lane;
    f32x4 v[4]; float s = 0.f;
#pragma unroll
    for (int j = 0; j < 4; ++j) { v[j] = xr[64 * j]; s += (v[j].x * v[j].x + v[j].y * v[j].y) + (v[j].z * v[j].z + v[j].w * v[j].w); }
    const float rstd = rsqrtf(wave_sum(s) * (1.f / D) + EPS);
    u32x2* o8 = (u32x2*)orow + lane;
#pragma unroll
    for (int j = 0; j < 4; ++j) { u32x2 w; w.x = cvt_pk_bf16(v[j].x, v[j].y); w.y = cvt_pk_bf16(v[j].z, v[j].w); o8[64 * j] = w; }
    if (lane == 0) *rs = rstd;
}

template <int NR>
__device__ __forceinline__ void row_pass_rows(bf16_t* X, const bf16_t* MF, const float* gain, float* rs, float* outf, int t0, int lane) {
    u32x4 xa[NR][2], ma[NR][2];
#pragma unroll
    for (int r = 0; r < NR; ++r) { const u32x4* xr = (const u32x4*)(X + (size_t)(t0 + r) * D); const u32x4* mr = (const u32x4*)(MF + (size_t)(t0 + r) * D);
        xa[r][0] = xr[lane]; xa[r][1] = xr[64 + lane]; ma[r][0] = mr[lane]; ma[r][1] = mr[64 + lane]; }
    float g[16];
    { const f32x4* g0 = (const f32x4*)(gain + lane * 8); const f32x4* g1 = (const f32x4*)(gain + 512 + lane * 8);
#pragma unroll
      for (int h = 0; h < 2; ++h) { const f32x4 a = g0[h], b = g1[h];
#pragma unroll
        for (int k = 0; k < 4; ++k) { g[4 * h + k] = a[k]; g[8 + 4 * h + k] = b[k]; } } }
#pragma unroll
    for (int r = 0; r < NR; ++r) {
        float x[16], m[16];
#pragma unroll
        for (int h = 0; h < 2; ++h) { const u32x4 xq = xa[r][h], mq = ma[r][h];
            x[8 * h + 0] = bf_lo(xq.x); x[8 * h + 1] = bf_hi(xq.x); x[8 * h + 2] = bf_lo(xq.y); x[8 * h + 3] = bf_hi(xq.y); x[8 * h + 4] = bf_lo(xq.z); x[8 * h + 5] = bf_hi(xq.z); x[8 * h + 6] = bf_lo(xq.w); x[8 * h + 7] = bf_hi(xq.w);
            m[8 * h + 0] = bf_lo(mq.x); m[8 * h + 1] = bf_hi(mq.x); m[8 * h + 2] = bf_lo(mq.y); m[8 * h + 3] = bf_hi(mq.y); m[8 * h + 4] = bf_lo(mq.z); m[8 * h + 5] = bf_hi(mq.z); m[8 * h + 6] = bf_lo(mq.w); m[8 * h + 7] = bf_hi(mq.w); }
        float sm = 0.f;
#pragma unroll
        for (int k = 0; k < 16; ++k) sm += m[k] * m[k];
        const float rm = rsqrtf(wave_sum(sm) * (1.f / D) + EPS);
        float s1 = 0.f;
#pragma unroll
        for (int k = 0; k < 16; ++k) { x[k] = x[k] + m[k] * rm * g[k]; s1 += x[k] * x[k]; }
        if (outf) {
            f32x4* o = (f32x4*)(outf + (size_t)(t0 + r) * D);
            o[lane * 2] = (f32x4){x[0], x[1], x[2], x[3]}; o[lane * 2 + 1] = (f32x4){x[4], x[5], x[6], x[7]};
            o[128 + lane * 2] = (f32x4){x[8], x[9], x[10], x[11]}; o[128 + lane * 2 + 1] = (f32x4){x[12], x[13], x[14], x[15]};
        } else {
            const float r1 = rsqrtf(wave_sum(s1) * (1.f / D) + EPS);
            u32x4* xo = (u32x4*)(X + (size_t)(t0 + r) * D);
            u32x4 w0, w1;
            w0.x = cvt_pk_bf16(x[0], x[1]); w0.y = cvt_pk_bf16(x[2], x[3]); w0.z = cvt_pk_bf16(x[4], x[5]); w0.w = cvt_pk_bf16(x[6], x[7]);
            w1.x = cvt_pk_bf16(x[8], x[9]); w1.y = cvt_pk_bf16(x[10], x[11]); w1.z = cvt_pk_bf16(x[12], x[13]); w1.w = cvt_pk_bf16(x[14], x[15]);
            xo[lane] = w0; xo[64 + lane] = w1;
            if (lane == 0) rs[t0 + r] = r1;
        }
    }
}

__device__ __forceinline__ void conv_wave_item(const bf16_t* p, const float* cw, bf16_t* Hm, int t0, int pos0, int S, int lane) {
    float w0[8], w1[8], w2[8];
    { const f32x4* a = (const f32x4*)(cw + lane * 8); const f32x4* b = (const f32x4*)(cw + 512 + lane * 8); const f32x4* c = (const f32x4*)(cw + 1024 + lane * 8);
#pragma unroll
      for (int h = 0; h < 2; ++h) { const f32x4 va = a[h], vb = b[h], vc = c[h];
#pragma unroll
        for (int k = 0; k < 4; ++k) { w0[4 * h + k] = va[k]; w1[4 * h + k] = vb[k]; w2[4 * h + k] = vc[k]; } } }
    float zp[8], zc[8], zn[8], ga[8], gb[8];
    const bf16_t* base = p + (size_t)t0 * DIN + lane * 8;
    if (pos0 == 0) {
#pragma unroll
        for (int k = 0; k < 8; ++k) zp[k] = 0.f;
    } else { load8(base - DIN + 512, ga); load8(base - DIN + 1024, gb);
#pragma unroll
        for (int k = 0; k < 8; ++k) zp[k] = ga[k] * gb[k]; }
    load8(base + 512, ga); load8(base + 1024, gb);
#pragma unroll
    for (int k = 0; k < 8; ++k) zc[k] = ga[k] * gb[k];
#pragma unroll 4
    for (int i = 0; i < 16; ++i) {
        const bf16_t* r = base + (size_t)i * DIN;
        if (pos0 + i + 1 == S) {
#pragma unroll
            for (int k = 0; k < 8; ++k) zn[k] = 0.f;
        } else { load8(r + DIN + 512, ga); load8(r + DIN + 1024, gb);
#pragma unroll
            for (int k = 0; k < 8; ++k) zn[k] = ga[k] * gb[k]; }
        load8(r, gb);
        float y[8], ss = 0.f;
#pragma unroll
        for (int k = 0; k < 8; ++k) { y[k] = gb[k] * (zp[k] * w0[k] + zc[k] * w1[k] + zn[k] * w2[k]); ss += y[k] * y[k]; }
        ss += __shfl_xor(ss, 1); ss += __shfl_xor(ss, 2); ss += __shfl_xor(ss, 4);
        const float rs = rsqrtf(ss * (1.f / 64.f) + EPS);
        u32x4 o; o.x = cvt_pk_bf16(y[0] * rs, y[1] * rs); o.y = cvt_pk_bf16(y[2] * rs, y[3] * rs); o.z = cvt_pk_bf16(y[4] * rs, y[5] * rs); o.w = cvt_pk_bf16(y[6] * rs, y[7] * rs);
        *(u32x4*)(Hm + (size_t)(t0 + i) * D + lane * 8) = o;
#pragma unroll
        for (int k = 0; k < 8; ++k) { zp[k] = zc[k]; zc[k] = zn[k]; }
    }
}

constexpr int XSTR = 272;
constexpr int RSTR = 34;
constexpr int LDS_XT = 0, LDS_R = 36864, LDS_OST = 106496;
#define LBAR() do { asm volatile("s_waitcnt lgkmcnt(0)" ::: "memory"); __builtin_amdgcn_s_barrier(); asm volatile("" ::: "memory"); } while (0)
__device__ __forceinline__ int seq_base(int bs) { return bs < BP ? bs * SP : TP + (bs - BP) * SS; }

__device__ __forceinline__ void dft_frags(bf16x8 (&Br)[4], bf16x8 (&Bi)[4], int log2n, int kt, int lane) {
    const int N = 1 << log2n, k = 16 * kt + (lane & 15); const float sc = 2.f / (float)N;
#pragma unroll
    for (int ks = 0; ks < 4; ++ks) { u32x4 wr, wi;
#pragma unroll
        for (int e2 = 0; e2 < 4; ++e2) { float c0, s0, c1, s1; const int n0 = 32 * ks + 8 * (lane >> 4) + 2 * e2;
            sincospif(-(float)((n0 * k) & (N - 1)) * sc, &s0, &c0); sincospif(-(float)(((n0 + 1) * k) & (N - 1)) * sc, &s1, &c1);
            wr[e2] = cvt_pk_bf16(c0, c1); wi[e2] = cvt_pk_bf16(s0, s1); }
        Br[ks] = __builtin_bit_cast(bf16x8, wr); Bi[ks] = __builtin_bit_cast(bf16x8, wi); }
}
__device__ __forceinline__ void xt_write(LAS unsigned char* xt, int rp, int ch, const u32x4 va, const u32x4 vb) {
    LAS unsigned char* base = xt + (8 * ch) * XSTR + ((((rp >> 2) ^ ch) << 4) + (rp & 3) * 4);
#pragma unroll
    for (int e2 = 0; e2 < 4; ++e2) {
        *(LAS unsigned*)(base + (2 * e2) * XSTR) = (va[e2] & 0xffffu) | (vb[e2] << 16);
        *(LAS unsigned*)(base + (2 * e2 + 1) * XSTR) = (va[e2] >> 16) | (vb[e2] & 0xffff0000u); }
}
__device__ __forceinline__ void dft_mfma(const LAS unsigned char* xt, int log2n, const bf16x8 (&Br)[4], const bf16x8 (&Bi)[4], f32x4 (&Pa)[4], f32x4 (&Qa)[4], int lane) {
#pragma unroll
    for (int it = 0; it < 4; ++it) { Pa[it] = (f32x4){0.f, 0.f, 0.f, 0.f}; Qa[it] = (f32x4){0.f, 0.f, 0.f, 0.f}; }
#pragma unroll
    for (int ks = 0; ks < 4; ++ks) if (ks < (1 << (log2n - 5))) {
#pragma unroll
        for (int it = 0; it < 4; ++it) { const int col = 16 * it + (lane & 15), gr = 4 * ks + (lane >> 4);
            const bf16x8 a = *(const LAS bf16x8*)(xt + col * XSTR + ((gr ^ (col >> 3)) << 4));
            Pa[it] = __builtin_amdgcn_mfma_f32_16x16x32_bf16(a, Br[ks], Pa[it], 0, 0, 0);
            Qa[it] = __builtin_amdgcn_mfma_f32_16x16x32_bf16(a, Bi[ks], Qa[it], 0, 0, 0); } }
}

__device__ __forceinline__ void p1_decode(int item, int& bs, int& g, int& n2, int& S, int& log2N2) {
    if (item < 2048) { bs = item >> 10; const int r = item & 1023; n2 = r >> 3; g = r & 7; S = SP; log2N2 = 7; }
    else { const int it = item - 2048; bs = BP + (it >> 9); const int r = it & 511; n2 = r >> 3; g = r & 7; S = SS; log2N2 = 6; }
}
__device__ __forceinline__ void p1_load(const bf16_t* p, int item, int rp, int ch, u32x4& va, u32x4& vb) {
    int bs, g, n2, S, l2; p1_decode(item, bs, g, n2, S, l2);
    const bf16_t* src = p + (size_t)(seq_base(bs) + ((2 * rp) << l2) + n2) * DIN + 1536 + g * 64 + ch * 8;
    va = *(const u32x4*)src; vb = *(const u32x4*)(src + ((size_t)DIN << l2));
}
__device__ __forceinline__ void fft_pass1(const bf16_t* p, bf16_t* inter, LAS unsigned char* lds, int bid, int G, int tid) {
    constexpr int NP1 = 2048 + 4096;
    const int lane = tid & 63, wave = __builtin_amdgcn_readfirstlane(tid >> 6), rp = tid >> 3, ch = tid & 7;
    bf16x8 Br[4], Bi[4]; dft_frags(Br, Bi, 7, wave, lane);
    u32x4 va, vb;
    if (bid < NP1) p1_load(p, bid, rp, ch, va, vb);
    int par = 0;
    for (int item = bid; item < NP1; item += G, par ^= 1) {
        LAS unsigned char* xt = lds + LDS_XT + par * (64 * XSTR);
        xt_write(xt, rp, ch, va, vb);
        if (item + G < NP1) p1_load(p, item + G, rp, ch, va, vb);
        LBAR();
        f32x4 Pa[4], Qa[4]; dft_mfma(xt, 7, Br, Bi, Pa, Qa, lane);
        int bs, g, n2, S, l2; p1_decode(item, bs, g, n2, S, l2);
        const int k1 = 16 * wave + (lane & 15), quad = lane >> 4;
        float sn, cs; sincospif(-2.0f * (float)(n2 * k1) / (float)S, &sn, &cs);
        bf16_t* dst = inter + ((size_t)seq_base(bs) * 8 + (size_t)g * S + ((size_t)k1 << l2) + n2) * 64 + 4 * quad;
#pragma unroll
        for (int it = 0; it < 4; ++it) {
            const float r0 = Pa[it][0] - Qa[it][1], i0 = Pa[it][1] + Qa[it][0], r1 = Pa[it][2] - Qa[it][3], i1 = Pa[it][3] + Qa[it][2];
            u32x2 w; w.x = cvt_pk_bf16(r0 * cs - i0 * sn, r0 * sn + i0 * cs); w.y = cvt_pk_bf16(r1 * cs - i1 * sn, r1 * sn + i1 * cs);
            *(u32x2*)(dst + 16 * it) = w; }
    }
    LBAR();
}

__device__ __forceinline__ void p2_decode(int item, int& bs, int& g, int& k1a, int& k1b, int& ip) {
    int r;
    if (item < 1024) { bs = item >> 9; r = item & 511; } else { const int it = item - 1024; bs = BP + (it >> 9); r = it & 511; }
    g = r >> 6; ip = r & 63; k1a = ip; k1b = ip == 0 ? 64 : 128 - ip;
}
template <int LOG2N>
__device__ __forceinline__ void fft_pass2(const bf16_t* inter, bf16_t* Hm, LAS unsigned char* lds, int item0, int item_end, int G, int tid) {
    constexpr int N2 = 1 << LOG2N, NTASK = N2 / 64, S = (LOG2N == 7) ? SP : SS;
    const int lane = tid & 63, wave = __builtin_amdgcn_readfirstlane(tid >> 6);
    bf16x8 Br[4], Bi[4]; dft_frags(Br, Bi, LOG2N, LOG2N == 7 ? wave : (wave & 3), lane);
    u32x4 va[NTASK], vb[NTASK];
#define P2_LOAD(item_) do { int bs_, g_, ka_, kb_, ip_; p2_decode(item_, bs_, g_, ka_, kb_, ip_); \
        const bf16_t* ib_ = inter + ((size_t)seq_base(bs_) * 8 + (size_t)g_ * S) * 64; \
        _Pragma("unroll") for (int j = 0; j < NTASK; ++j) { const int q = tid + NTHREADS * j, h = q / (4 * N2), r = q % (4 * N2), rp = r >> 3, ch = r & 7; \
            const bf16_t* src = ib_ + ((size_t)((h ? kb_ : ka_) * N2 + 2 * rp)) * 64 + ch * 8; va[j] = *(const u32x4*)src; vb[j] = *(const u32x4*)(src + 64); } } while (0)
    if (item0 < item_end) P2_LOAD(item0);
    LAS f32x2* R = (LAS f32x2*)(lds + LDS_R);
    LAS bf16_t* Ost = (LAS bf16_t*)(lds + LDS_OST);
    const float sc = rsqrtf((float)S);
    for (int item = item0; item < item_end; item += G) {
#pragma unroll
        for (int j = 0; j < NTASK; ++j) { const int q = tid + NTHREADS * j, h = q / (4 * N2), r = q % (4 * N2);
            xt_write(lds + LDS_XT + h * (64 * XSTR), r >> 3, r & 7, va[j], vb[j]); }
        if (item + G < item_end) P2_LOAD(item + G);
        LBAR();
        {
            f32x4 Pa[4], Qa[4]; const int quad = lane >> 4;
#pragma unroll
            for (int hh = 0; hh < (LOG2N == 7 ? 2 : 1); ++hh) {
                const int h = (LOG2N == 7) ? hh : (wave >> 2), kt = (LOG2N == 7) ? wave : (wave & 3);
                dft_mfma(lds + LDS_XT + h * (64 * XSTR), LOG2N, Br, Bi, Pa, Qa, lane);
                LAS f32x2* Rr = R + (h * N2 + 16 * kt + (lane & 15)) * RSTR + 2 * quad;
#pragma unroll
                for (int it = 0; it < 4; ++it)
                    *(LAS f32x4*)(Rr + 8 * it) = (f32x4){Pa[it][0] - Qa[it][1], Pa[it][1] + Qa[it][0], Pa[it][2] - Qa[it][3], Pa[it][3] + Qa[it][2]};
            }
        }
        LBAR();
        int bs, g, k1a, k1b, ip; p2_decode(item, bs, g, k1a, k1b, ip);
        const int tb = seq_base(bs);
        for (int idx = tid; idx < 2 * N2 * 32; idx += NTHREADS) {
            const int c = idx & 31, tl = idx >> 5, h = tl >> LOG2N, k2 = tl & (N2 - 1);
            const int ph = (ip == 0) ? h : 1 - h;
            const int k2p = (ip == 0 && h == 0) ? ((N2 - k2) & (N2 - 1)) : (N2 - 1 - k2);
            const f32x2 own = R[(h * N2 + k2) * RSTR + c], par = R[(ph * N2 + k2p) * RSTR + c];
            float v1 = (c == 0) ? 0.5f * (own.x + par.x) : own.x, v2 = (c == 0) ? 0.5f * (own.y + par.y) : par.x;
            v1 *= sc; v2 *= sc;
            float ss = v1 * v1 + v2 * v2;
            ss += __shfl_xor(ss, 1); ss += __shfl_xor(ss, 2); ss += __shfl_xor(ss, 4); ss += __shfl_xor(ss, 8); ss += __shfl_xor(ss, 16);
            const float rs = rsqrtf(ss * (1.f / 64.f) + EPS);
            Ost[tl * 64 + c] = (bf16_t)(cvt_pk_bf16(v1 * rs, 0.f) & 0xffffu);
            Ost[tl * 64 + (c == 0 ? 32 : 64 - c)] = (bf16_t)(cvt_pk_bf16(v2 * rs, 0.f) & 0xffffu);
        }
        LBAR();
        for (int idx = tid; idx < 2 * N2 * 8; idx += NTHREADS) {
            const int tl = idx >> 3, ch = idx & 7, h = tl >> LOG2N, k2 = tl & (N2 - 1);
            const int tok = tb + (h ? k1b : k1a) + 128 * k2;
            *(u32x4*)(Hm + (size_t)tok * D + 512 + g * 64 + ch * 8) = ((const LAS u32x4*)Ost)[idx];
        }
    }
    LBAR();
#undef P2_LOAD
}

#define XB_TMO      128
#define XB_XCNT(j)  (256  + 64 * (j))
#define XB_XSUB(j)  (1280 + 64 * (j))
#define XB_XGEN(j)  (2304 + 64 * (j))
#define XB_TOP      3328
#define XB_TOPGEN   3392
#define XCD_BAR_WORDS 3456
#define XB_SPIN_CAP (1u << 20)
__device__ __forceinline__ unsigned xb_ld(unsigned* p)              { return __hip_atomic_load(p, __ATOMIC_RELAXED, __HIP_MEMORY_SCOPE_AGENT); }
__device__ __forceinline__ unsigned xb_add(unsigned* p, unsigned v) { return __hip_atomic_fetch_add(p, v, __ATOMIC_RELAXED, __HIP_MEMORY_SCOPE_AGENT); }
__device__ __forceinline__ unsigned xb_xcc_id() { return (unsigned)__builtin_amdgcn_s_getreg((3 << 11) | 20) & 0xFu; }
#define XB_SPIN(cond, bar) do { unsigned _sp = 0; while (cond) { __builtin_amdgcn_s_sleep(1); \
    if ((++_sp & 255u) == 0u) { if (xb_ld(&(bar)[XB_TMO])) break; if (_sp > XB_SPIN_CAP) { atomicAdd(&(bar)[XB_TMO], 1u); break; } } } } while (0)
struct XcdBarrier { unsigned* bar; unsigned x; volatile LAS unsigned* st; };
__device__ __forceinline__ XcdBarrier xcd_barrier_post(unsigned* bar, volatile LAS unsigned* st) {
    XcdBarrier b; b.bar = bar; b.x = xb_xcc_id(); b.st = st;
    if (threadIdx.x == 0) (void)xb_add(&bar[XB_XCNT(b.x)], 1u);
    return b;
}
__device__ __forceinline__ void xcd_barrier_complete(unsigned* bar, unsigned x, unsigned& nloc, unsigned& nx) {
    const unsigned G = gridDim.x * gridDim.y * gridDim.z;
    unsigned sum, cnt, mine, sp = 0u;
    for (;;) {
        sum = 0u; cnt = 0u; mine = 0u;
#pragma unroll
        for (unsigned j = 0; j < 16; ++j) { const unsigned c = xb_ld(&bar[XB_XCNT(j)]); sum += c; cnt += (c > 0u) ? 1u : 0u; mine = (j == x) ? c : mine; }
        if (sum == G) break;
        __builtin_amdgcn_s_sleep(1);
        if ((++sp & 255u) == 0u) { if (xb_ld(&bar[XB_TMO])) break; if (sp > XB_SPIN_CAP) { atomicAdd(&bar[XB_TMO], 1u); break; } }
    }
    nloc = mine > 0u ? mine : 1u; nx = cnt > 0u ? cnt : 1u;
}
__device__ __forceinline__ void xcd_barrier(const XcdBarrier& b) {
    asm volatile("s_waitcnt vmcnt(0)" ::: "memory");
    __syncthreads();
    if (threadIdx.x == 0) {
        unsigned* bar = b.bar;
        __builtin_amdgcn_s_waitcnt(0);
        unsigned nloc = b.st[0], nx = b.st[1];
        if (nloc == 0u) { xcd_barrier_complete(bar, b.x, nloc, nx); b.st[0] = nloc; b.st[1] = nx; }
        const unsigned old = xb_add(&bar[XB_XSUB(b.x)], 1u);
        const unsigned gen = old / nloc;
        if (old + 1u == (gen + 1u) * nloc) {
            __builtin_amdgcn_fence(__ATOMIC_RELEASE, "agent");
            asm volatile("s_waitcnt vmcnt(0)" ::: "memory");
            const unsigned og = xb_add(&bar[XB_TOP], 1u);
            const unsigned tg = og / nx;
            if (og + 1u == (tg + 1u) * nx) xb_add(&bar[XB_TOPGEN], 1u);
            else XB_SPIN(xb_ld(&bar[XB_TOPGEN]) == tg, bar);
            __builtin_amdgcn_fence(__ATOMIC_ACQUIRE, "agent");
            xb_add(&bar[XB_XGEN(b.x)], 1u);
            asm volatile("s_waitcnt vmcnt(0)" ::: "memory");
        } else {
            XB_SPIN(xb_ld(&bar[XB_XGEN(b.x)]) == gen, bar);
            __builtin_amdgcn_fence(__ATOMIC_ACQUIRE, "agent");
            asm volatile("s_waitcnt vmcnt(0)" ::: "memory");
        }
    }
    __syncthreads();
}

__global__ void __launch_bounds__(NTHREADS, 2) fwd_megakernel(Params P) {
    extern __shared__ __attribute__((aligned(16))) unsigned char shm[];
    cg::grid_group grid = cg::this_grid();
    LAS unsigned char* lds = (LAS unsigned char*)shm;
    const int G = gridDim.x, bid = blockIdx.x, NGW = G * NWAVES;
#define FRESH() int tid = threadIdx.x; asm volatile("" : "+v"(tid)); const int lane = tid & 63, wave = __builtin_amdgcn_readfirstlane(tid >> 6), gw = bid * NWAVES + wave; (void)lane; (void)gw
#define TAB ((LAS float*)(lds + LDS_MISC))
    { FRESH();
      if (tid < 64) TAB[tid] = cospif((float)tid * (1.f / 32.f));
      if (tid < 4) ((volatile LAS unsigned*)(lds + LDS_MISC + 1024))[tid] = 0u; }
    __syncthreads();
    const XcdBarrier xbar = xcd_barrier_post((unsigned*)P.ws, (volatile LAS unsigned*)(lds + LDS_MISC + 1024));
#define GSYNC() xcd_barrier(xbar)

    unsigned char* ws = P.ws;
#define Xb ((bf16_t*)(ws + WS_X))
#define Hb ((bf16_t*)(ws + WS_H))
#define Pb ((bf16_t*)P.out)
#define Ib ((bf16_t*)(ws + WS_INTER))
#define MFb ((bf16_t*)(ws + WS_MF))
#define Ab ((bf16_t*)P.out)
#define RSb ((float*)(ws + WS_RS))

    {
        FRESH();
        LAS float* scr = (LAS float*)(lds + wave * 8704);
        constexpr int I_IN = 16 * 48, I_OUT = 16 * 32, I_UP = 16 * 128, I_DN = 64 * 32, I_F = 128, I_L = I_IN + I_OUT + I_UP + I_DN + I_F;
        for (int it = gw; it < NL * I_L; it += NGW) {
            const int l = it / I_L; int r = it % I_L;
            bf16_t* Wl = (bf16_t*)(ws + WS_W + (size_t)l * WL_SZ);
            const float* win = P.w_in + (size_t)l * D * DIN;
            if (r < I_IN) { p0_transpose_item(win, D, DIN, 48, Wl + WL_IN / 2, P.g_mix_pre + l * D, scr, r, lane); continue; } r -= I_IN;
            if (r < I_OUT) {
                const int kb = r / 32; const float* gsrc = kb < 8 ? P.g_conv_out + l * 512 : P.g_fourier_out + l * 512 - 512;
                p0_transpose_item(P.w_out + (size_t)l * D * D, D, D, 32, Wl + WL_OUT / 2, gsrc, scr, r, lane); continue; } r -= I_OUT;
            if (r < I_UP) { p0_transpose_item(P.w_up + (size_t)l * D * DFF, D, DFF, 128, Wl + WL_UP / 2, P.g_mlp_pre + l * D, scr, r, lane); continue; } r -= I_UP;
            if (r < I_DN) { p0_transpose_item(P.w_down + (size_t)l * DFF * D, DFF, D, 32, Wl + WL_DN / 2, nullptr, scr, r, lane); continue; } r -= I_DN;
            p0_fold_item(win, P.g_mix_pre + l * D, Wl + WL_IN / 2, TAB, r, lane);
        }
        for (int t = gw; t < T; t += NGW) x_row_init(t < TP ? P.xp + (size_t)t * D : P.xs + (size_t)(t - TP) * D, Xb + (size_t)t * D, RSb + t, lane);
    }
    grid.sync();

    for (int l = 0; l < NL; ++l) {
        const bf16_t* Wl = (const bf16_t*)(ws + WS_W + (size_t)l * WL_SZ);
        { pg8::Gemm g{Xb, Wl + WL_IN / 2, T, DIN, D}; pg8::StaticOrder S; S.init(T, DIN, G, bid); pg8::EpiBf16 E{Pb, DIN, 0, RSb};
          pg8::gemm_phase(lds, g, S, E); }
        GSYNC();
        {
            FRESH();
            constexpr int NCONV = T / 128;
            for (int it = bid; it < NCONV; it += G) { const int t0 = it * 128 + wave * 16; const int S = t0 < TP ? SP : SS; const int pos0 = t0 < TP ? (t0 & (SP - 1)) : ((t0 - TP) & (SS - 1));
                conv_wave_item(Pb, P.conv_w + (size_t)l * 3 * 512, Hb, t0, pos0, S, lane); }
            fft_pass1(Pb, Ib, lds, bid, G, tid);
        }
        GSYNC();
        { FRESH(); fft_pass2<7>(Ib, Hb, lds, bid, 1024, G, tid); }
        { FRESH(); fft_pass2<6>(Ib, Hb, lds, 1024 + bid, 1024 + 4096, G, tid); }
        GSYNC();
        { pg8::Gemm g{Hb, Wl + WL_OUT / 2, T, D, D}; pg8::StaticOrder S; S.init(T, D, G, bid); pg8::EpiBf16 E{MFb, D, 0, nullptr};
          pg8::gemm_phase(lds, g, S, E); }
        GSYNC();
        { FRESH();
          for (int t = gw * 4; t < T; t += NGW * 4) row_pass_rows<4>(Xb, MFb, P.g_mix_post + l * D, RSb, nullptr, t, lane); }
        GSYNC();
        for (int ch = 0; ch < NCH; ++ch) {
            { pg8::Gemm g{Xb + (size_t)ch * TCH * D, Wl + WL_UP / 2, TCH, DFF, D}; pg8::StaticOrder S; S.init(TCH, DFF, G, bid); pg8::EpiBf16 E{Ab, DFF, 1, RSb + ch * TCH};
              pg8::gemm_phase(lds, g, S, E); }
            GSYNC();
            { pg8::Gemm g{Ab, Wl + WL_DN / 2, TCH, D, DFF}; pg8::StaticOrder S; S.init(TCH, D, G, bid); pg8::EpiBf16 E{MFb + (size_t)ch * TCH * D, D, 0, nullptr};
              pg8::gemm_phase(lds, g, S, E); }
            GSYNC();
        }
        { FRESH();
          float* outf = (l + 1 < NL) ? nullptr : P.out;
          for (int t = gw * 4; t < T; t += NGW * 4) row_pass_rows<4>(Xb, MFb, P.g_mlp_post + l * D, RSb, outf, t, lane); }
        if (l + 1 < NL) GSYNC();
    }
}

extern "C" void kernel_launch(void* const* d_in, const int* in_sizes, int n_in, void* d_out, int out_size, void* d_ws, size_t ws_size, hipStream_t stream) {
    static int grid_blocks = 0;
    if (grid_blocks == 0) {
        if (n_in != 13 || out_size != T * D || ws_size < WS_END) { fprintf(stderr, "kernel_launch: unexpected shapes (n_in %d, out %d, ws %zu, need %zu)\n", n_in, out_size, ws_size, (size_t)WS_END); grid_blocks = -1; return; }
        int dev = 0, cus = 0, per_cu = 0;
        hipGetDevice(&dev);
        hipDeviceGetAttribute(&cus, hipDeviceAttributeMultiprocessorCount, dev);
        if (hipFuncSetAttribute((const void*)fwd_megakernel, hipFuncAttributeMaxDynamicSharedMemorySize, LDS_BYTES) != hipSuccess) { fprintf(stderr, "kernel_launch: hipFuncSetAttribute failed\n"); grid_blocks = -1; return; }
        hipOccupancyMaxActiveBlocksPerMultiprocessor(&per_cu, (const void*)fwd_megakernel, NTHREADS, LDS_BYTES);
        if (per_cu < 1) { fprintf(stderr, "kernel_launch: occupancy query says %d blocks per CU\n", per_cu); per_cu = 1; }
        grid_blocks = cus * per_cu;
    }
    if (grid_blocks < 0) return;
    Params p{};
    p.xp = (const float*)d_in[0]; p.xs = (const float*)d_in[1]; p.g_mix_pre = (const float*)d_in[2]; p.w_in = (const float*)d_in[3]; p.conv_w = (const float*)d_in[4];
    p.g_conv_out = (const float*)d_in[5]; p.g_fourier_out = (const float*)d_in[6]; p.w_out = (const float*)d_in[7]; p.g_mix_post = (const float*)d_in[8];
    p.g_mlp_pre = (const float*)d_in[9]; p.w_up = (const float*)d_in[10]; p.w_down = (const float*)d_in[11]; p.g_mlp_post = (const float*)d_in[12];
    p.out = (float*)d_out; p.ws = (unsigned char*)d_ws;
    if (hipMemsetAsync(d_ws, 0, 16384, stream) != hipSuccess) { fprintf(stderr, "kernel_launch: memset failed\n"); return; }
    void* args[] = {&p};
    hipError_t e = hipLaunchCooperativeKernel((const void*)fwd_megakernel, dim3(grid_blocks), dim3(NTHREADS), args, LDS_BYTES, stream);
    if (e != hipSuccess) fprintf(stderr, "cooperative launch failed: %s (grid %d)\n", hipGetErrorString(e), grid_blocks);
}
```

```cpp
#include <hip/hip_runtime.h>
#include <hip/hip_cooperative_groups.h>
#include <cstdio>
namespace cg = cooperative_groups;

#define LAS __attribute__((address_space(3)))
typedef unsigned short bf16_t;
typedef short bf16x8 __attribute__((ext_vector_type(8)));
typedef float f32x4 __attribute__((ext_vector_type(4)));
typedef float f32x2 __attribute__((ext_vector_type(2)));
typedef unsigned u32x4 __attribute__((ext_vector_type(4)));
typedef unsigned u32x2 __attribute__((ext_vector_type(2)));

constexpr int D = 1024, DIN = 2048, DFF = 4096, NL = 4;
constexpr int SP = 16384, BP = 2, SS = 8192, BS = 8;
constexpr int TP = BP * SP, TS = BS * SS, T = TP + TS;
constexpr float EPS = 1e-6f;
constexpr int NCH = 2;
constexpr int TCH = T / NCH;

constexpr size_t MiB = (size_t)1 << 20;
constexpr size_t WS_W = 1 * MiB;
constexpr size_t WL_IN = 0, WL_OUT = 4 * MiB, WL_UP = 6 * MiB, WL_DN = 14 * MiB, WL_SZ = 22 * MiB;
constexpr size_t WS_X = WS_W + NL * WL_SZ;
constexpr size_t WS_H = WS_X + (size_t)T * D * 2;
constexpr size_t WS_INTER = WS_H + (size_t)T * D * 2;
constexpr size_t WS_MF = WS_INTER + (size_t)T * 256 * 8;
constexpr size_t WS_RS = WS_MF + (size_t)T * D * 2;
constexpr size_t WS_END = WS_RS + 1 * MiB;

constexpr int LDS_STAGE = 131072, LDS_MISC = 139264, LDS_BYTES = LDS_MISC + 4096;
constexpr int NTHREADS = 512, NWAVES = 8;

struct Params {
    const float* xp; const float* xs; const float* g_mix_pre; const float* w_in; const float* conv_w;
    const float* g_conv_out; const float* g_fourier_out; const float* w_out; const float* g_mix_post;
    const float* g_mlp_pre; const float* w_up; const float* w_down; const float* g_mlp_post;
    float* out; unsigned char* ws;
};

__device__ __forceinline__ unsigned cvt_pk_bf16(float lo, float hi) { unsigned r; asm volatile("v_cvt_pk_bf16_f32 %0, %1, %2" : "=v"(r) : "v"(lo), "v"(hi)); return r; }
__device__ __forceinline__ float bf_lo(unsigned w) { return __uint_as_float(w << 16); }
__device__ __forceinline__ float bf_hi(unsigned w) { return __uint_as_float(w & 0xffff0000u); }
__device__ __forceinline__ float wave_sum(float v) {
#pragma unroll
    for (int o = 1; o < 64; o <<= 1) v += __shfl_xor(v, o);
    return v;
}
__device__ __forceinline__ void load8(const bf16_t* ptr, float (&v)[8]) {
    const u32x4 q = *(const u32x4*)ptr;
    v[0] = bf_lo(q.x); v[1] = bf_hi(q.x); v[2] = bf_lo(q.y); v[3] = bf_hi(q.y); v[4] = bf_lo(q.z); v[5] = bf_hi(q.z); v[6] = bf_lo(q.w); v[7] = bf_hi(q.w);
}

namespace pg8 {
constexpr int BM = 256, BK = 64, HALF = 128, HTB = HALF * BK * 2, STAGE_BYTES = 8 * HTB, NXCD = 8, WGM = 8;
__device__ __forceinline__ int lds_byte(int r, int c) { const int st = (r >> 4) * 2 + (c >> 5), rr = r & 15, cc = c & 31, ob = rr * 64 + cc * 2; return st * 1024 + (ob ^ (((ob >> 9) & 1) << 5)); }
__device__ __forceinline__ void stage_rc(int b, int& R, int& C) { const int st = b / 1024, sb = b % 1024, swz = sb ^ (((sb >> 9) & 1) << 5); R = (st >> 1) * 16 + swz / 64; C = (st & 1) * 32 + (swz % 64) / 2; }
__device__ __forceinline__ int perm32(int rho) { const int n = rho >> 4, i = rho & 15; return 8 * (i >> 2) + 4 * n + (i & 3); }

struct Unit { int pm, pn; };
struct Gemm { const bf16_t* A; const bf16_t* Bt; int M, N, K; const bf16_t* A2; int split; };

struct StaticOrder {
    int nM, nN, nwg, G, c;
    __device__ void init(int M, int N, int G_, int c_) { nM = M / BM; nN = N / BM; nwg = nM * nN; G = G_; c = c_; }
    __device__ bool next(int i, Unit& u) const {
        const long L = (long)i * G + c; if (L >= nwg) return false;
        int wgid = (int)L; { const int q = nwg / NXCD, r = nwg % NXCD, xcd = wgid % NXCD, off = wgid / NXCD; wgid = (xcd < r ? xcd * (q + 1) : r * (q + 1) + (xcd - r) * q) + off; }
        const int nig = WGM * nN, gid = wgid / nig, fm = gid * WGM, gsz = (nM - fm) < WGM ? (nM - fm) : WGM;
        u.pm = fm + ((wgid % nig) % gsz); u.pn = (wgid % nig) / gsz; return true;
    }
};

struct EpiBf16 {
    bf16_t* O; int ldc; int act; const float* rs; bf16_t* O2; int split;
    __device__ __forceinline__ void operator()(const f32x4 (&acc)[2][2][4][2], const Unit& u, int wr, int wc, int fr, int fq) const {
        const bool lo = u.pm < split; bf16_t* Ob = lo ? O : O2;
        const int grow0 = u.pm * BM + wr * 64 + fr, row0 = grow0 - (lo ? 0 : split * BM); const int col0 = u.pn * BM + wc * 32 + 8 * fq;
#pragma unroll
        for (int ai = 0; ai < 2; ++ai)
#pragma unroll
            for (int m = 0; m < 4; ++m) { bf16_t* rowp = Ob + (size_t)(row0 + ai * HALF + m * 16) * ldc + col0; const float sc = rs ? rs[grow0 + ai * HALF + m * 16] : 1.f;
#pragma unroll
                for (int bj = 0; bj < 2; ++bj) { f32x4 v0 = acc[ai][bj][m][0] * sc, v1 = acc[ai][bj][m][1] * sc;
                    if (act) {
#pragma unroll
                        for (int j = 0; j < 4; ++j) { const float a0 = fmaxf(v0[j], 0.f), a1 = fmaxf(v1[j], 0.f); v0[j] = a0 * a0; v1[j] = a1 * a1; } }
                    u32x4 w; w.x = cvt_pk_bf16(v0[0], v0[1]); w.y = cvt_pk_bf16(v0[2], v0[3]); w.z = cvt_pk_bf16(v1[0], v1[1]); w.w = cvt_pk_bf16(v1[2], v1[3]);
                    *(u32x4*)(rowp + bj * HALF) = w; } }
    }
};

template <class Epi, class Sched>
__device__ __forceinline__ void gemm_phase(LAS unsigned char* lds, const Gemm g, const Sched& S, const Epi& E) {
    int tid_ = threadIdx.x; asm volatile("" : "+v"(tid_));
    const int tid = tid_, wid = __builtin_amdgcn_readfirstlane(tid >> 6), lane = tid & 63, wr = wid >> 2, wc = wid & 3, fr = lane & 15, fq = lane >> 4;
    const int K = g.K, nt = K / BK;
    unsigned voffA[2], voffB[2];
#pragma unroll
    for (int i = 0; i < 2; ++i) { int R, C; stage_rc(tid * 16 + i * 8192, R, C); const int Rb = (R & ~31) + perm32(R & 31);
        voffA[i] = (unsigned)(R * K + C) * 2u; voffB[i] = (unsigned)(Rb * K + C) * 2u; }
    const size_t kstep = (size_t)(BK * 2);
    const size_t hstep = (size_t)HALF * K * 2;
    const size_t tstep = 2 * hstep;
    const unsigned ldsw = (unsigned)wid * 1024u;
    const int aoff = lds_byte(wr * 64 + fr, fq * 8), boff = lds_byte(wc * 32 + fr, fq * 8);
#define PG8_SA(b, h) (((b) * 2 + (h)) * HTB)
#define PG8_SB(b, h) ((4 + (b) * 2 + (h)) * HTB)
#define PG8_STAGE(bufoff, gbase, voff) do { _Pragma("unroll") for (int _i = 0; _i < 2; ++_i) \
        __builtin_amdgcn_global_load_lds((const unsigned*)((const char*)(gbase) + (voff)[_i]), (LAS unsigned*)(lds + (bufoff) + ldsw + _i * 8192), 16, 0, 0); } while (0)
#define PG8_LDA(dst, b, h) do { _Pragma("unroll") for (int m = 0; m < 4; ++m) _Pragma("unroll") for (int k = 0; k < 2; ++k) dst[m][k] = *(const LAS bf16x8*)(lds + PG8_SA(b, h) + aoff + m * 2048 + k * 1024); } while (0)
#define PG8_LDB(dst, b, h) do { _Pragma("unroll") for (int n = 0; n < 2; ++n) _Pragma("unroll") for (int k = 0; k < 2; ++k) dst[n][k] = *(const LAS bf16x8*)(lds + PG8_SB(b, h) + boff + n * 2048 + k * 1024); } while (0)
#define PG8_MMA(ai, bj, At, Bt) do { __builtin_amdgcn_s_setprio(1); _Pragma("unroll") for (int m = 0; m < 4; ++m) _Pragma("unroll") for (int n = 0; n < 2; ++n) _Pragma("unroll") for (int k = 0; k < 2; ++k) \
        acc[ai][bj][m][n] = __builtin_amdgcn_mfma_f32_16x16x32_bf16(Bt[n][k], At[m][k], acc[ai][bj][m][n], 0, 0, 0); __builtin_amdgcn_s_setprio(0); } while (0)
#define PG8_WAIT_V(n) asm volatile("s_waitcnt vmcnt(" #n ")" ::: "memory")
#define PG8_WAIT_L(n) asm volatile("s_waitcnt lgkmcnt(" #n ")" ::: "memory")
#define PG8_BAR __builtin_amdgcn_s_barrier()
#define PG8_SCHED __builtin_amdgcn_sched_barrier(0)
    Unit cur, nxt; int ui = 0;
    if (!S.next(0, cur)) return;
    f32x4 acc[2][2][4][2];
#pragma unroll
    for (int a = 0; a < 2; ++a)
#pragma unroll
        for (int b = 0; b < 2; ++b)
#pragma unroll
            for (int m = 0; m < 4; ++m)
#pragma unroll
                for (int n = 0; n < 2; ++n) acc[a][b][m][n] = (f32x4){0.f, 0.f, 0.f, 0.f};
    bf16x8 At[4][2], B0[2][2], B1[2][2];
#define PG8_APANEL(pm_) ((const char*)(((pm_) < g.split ? (unsigned long long)g.A : (unsigned long long)g.A2 - (unsigned long long)g.split * tstep) + (unsigned long long)(pm_) * tstep))
    const char* cA = PG8_APANEL(cur.pm); const char* cB = (const char*)g.Bt + (size_t)cur.pn * tstep;
    PG8_STAGE(PG8_SB(0, 0), cB, voffB); PG8_STAGE(PG8_SA(0, 0), cA, voffA); PG8_STAGE(PG8_SB(0, 1), cB + hstep, voffB); PG8_STAGE(PG8_SA(0, 1), cA + hstep, voffA);
    if (wr == 1) PG8_BAR;
    PG8_WAIT_V(4); PG8_BAR;
    PG8_STAGE(PG8_SB(1, 0), cB + kstep, voffB); PG8_STAGE(PG8_SA(1, 0), cA + kstep, voffA); PG8_STAGE(PG8_SB(1, 1), cB + hstep + kstep, voffB);
    PG8_WAIT_V(6); PG8_BAR;
    for (;;) {
        const bool has_next = S.next(ui + 1, nxt);
        const char* nA = has_next ? PG8_APANEL(nxt.pm) : cA; const char* nB = has_next ? (const char*)g.Bt + (size_t)nxt.pn * tstep : cB;
        for (int t = 0; t < nt; t += 2) {
            const bool last = (t == nt - 2);
            const char* a1 = cA + (size_t)(t + 1) * kstep;
            const char* a2 = last ? nA : cA + (size_t)(t + 2) * kstep; const char* b2 = last ? nB : cB + (size_t)(t + 2) * kstep;
            const char* a3 = a2 + kstep; const char* b3 = b2 + kstep;
            PG8_LDB(B0, 0, 0); PG8_SCHED; PG8_LDA(At, 0, 0); PG8_STAGE(PG8_SA(1, 1), a1 + hstep, voffA);
            PG8_WAIT_L(8); PG8_BAR; PG8_WAIT_L(0); PG8_MMA(0, 0, At, B0); PG8_BAR; PG8_SCHED;
            PG8_LDB(B1, 0, 1); PG8_STAGE(PG8_SB(0, 0), b2, voffB);
            PG8_BAR; PG8_WAIT_L(0); PG8_MMA(0, 1, At, B1); PG8_BAR;
            PG8_LDA(At, 0, 1); PG8_STAGE(PG8_SA(0, 0), a2, voffA);
            PG8_BAR; PG8_WAIT_L(0); PG8_MMA(1, 0, At, B0); PG8_BAR; PG8_SCHED;
            PG8_STAGE(PG8_SB(0, 1), b2 + hstep, voffB);
            PG8_WAIT_V(6); PG8_BAR; PG8_MMA(1, 1, At, B1); PG8_BAR;
            PG8_LDB(B0, 1, 0); PG8_SCHED; PG8_LDA(At, 1, 0); PG8_STAGE(PG8_SA(0, 1), a2 + hstep, voffA);
            PG8_WAIT_L(8); PG8_BAR; PG8_WAIT_L(0); PG8_MMA(0, 0, At, B0); PG8_BAR; PG8_SCHED;
            PG8_LDB(B1, 1, 1); PG8_STAGE(PG8_SB(1, 0), b3, voffB);
            PG8_BAR; PG8_WAIT_L(0); PG8_MMA(0, 1, At, B1); PG8_BAR;
            PG8_LDA(At, 1, 1); PG8_STAGE(PG8_SA(1, 0), a3, voffA);
            PG8_BAR; PG8_WAIT_L(0); PG8_MMA(1, 0, At, B0); PG8_BAR; PG8_SCHED;
            PG8_STAGE(PG8_SB(1, 1), b3 + hstep, voffB);
            PG8_WAIT_V(6); PG8_BAR; PG8_MMA(1, 1, At, B1); PG8_BAR;
        }
        E(acc, cur, wr, wc, fr, fq);
        if (!has_next) break;
#pragma unroll
        for (int a = 0; a < 2; ++a)
#pragma unroll
            for (int b = 0; b < 2; ++b)
#pragma unroll
                for (int m = 0; m < 4; ++m)
#pragma unroll
                    for (int n = 0; n < 2; ++n) acc[a][b][m][n] = (f32x4){0.f, 0.f, 0.f, 0.f};
        cur = nxt; cA = nA; cB = nB; ++ui;
    }
    PG8_WAIT_V(0);
    if (wr == 0) PG8_BAR;
    PG8_BAR;
#undef PG8_APANEL
#undef PG8_SA
#undef PG8_SB
#undef PG8_STAGE
#undef PG8_LDA
#undef PG8_LDB
#undef PG8_MMA
#undef PG8_WAIT_V
#undef PG8_WAIT_L
#undef PG8_BAR
#undef PG8_SCHED
}
}

__device__ __forceinline__ void p0_transpose_item(const float* W, int K, int ldN, int nblk, bf16_t* WT, const float* gain, LAS float* scr, int item, int lane) {
    const int kb = item / nblk, nb = item % nblk, k0 = 64 * kb, n0 = 32 * nb;
#pragma unroll 8
    for (int i = 0; i < 32; ++i) { const int kk = 2 * i + (lane >> 5); const float gk = gain ? gain[k0 + kk] : 1.f;
        scr[kk * 33 + (lane & 31)] = W[(size_t)(k0 + kk) * ldN + n0 + (lane & 31)] * gk; }
    asm volatile("s_waitcnt lgkmcnt(0)" ::: "memory");
    const int c = lane & 7;
#pragma unroll
    for (int j = 0; j < 4; ++j) { const int n = (lane >> 3) + 8 * j; const LAS float* s = scr + (8 * c) * 33 + n;
        u32x4 o; o.x = cvt_pk_bf16(s[0 * 33], s[1 * 33]); o.y = cvt_pk_bf16(s[2 * 33], s[3 * 33]); o.z = cvt_pk_bf16(s[4 * 33], s[5 * 33]); o.w = cvt_pk_bf16(s[6 * 33], s[7 * 33]);
        *(u32x4*)(WT + (size_t)(n0 + n) * K + k0 + 8 * c) = o; }
    asm volatile("s_waitcnt lgkmcnt(0)" ::: "memory");
}
__device__ __forceinline__ void p0_fold_item(const float* Win  , const float* gpre, bf16_t* WT  , const LAS float* tab, int item, int lane) {
    const int kb = item >> 3, g = item & 7, k = kb * 64 + lane;
    const float gk = gpre[k] * 0.125f;
    const f32x4* src = (const f32x4*)(Win + (size_t)k * DIN + 1536 + g * 64);
    float row[64];
#pragma unroll
    for (int i = 0; i < 16; ++i) { const f32x4 v = src[i]; row[4 * i] = v.x * gk; row[4 * i + 1] = v.y * gk; row[4 * i + 2] = v.z * gk; row[4 * i + 3] = v.w * gk; }
    for (int j = 0; j < 64; ++j) {
        const int cj = (j == 0) ? 0 : (j == 1 ? 32 : (j >> 1)), off = (j >= 2 && (j & 1)) ? 16 : 0;
        float acc = 0.f;
#pragma unroll
        for (int d = 0; d < 64; ++d) acc += row[d] * tab[(cj * d + off) & 63];
        WT[(size_t)(1536 + g * 64 + j) * D + k] = (bf16_t)(cvt_pk_bf16(acc, 0.f) & 0xffffu);
    }
}
__device__ __forceinline__ void x_row_init(const float* xrow, bf16_t* orow, float* rs, int lane) {
    const f32x4* xr = (const f32x4*)xrow + lane;
    f32x4 v[4]; float s = 0.f;
#pragma unroll
    for (int j = 0; j < 4; ++j) { v[j] = xr[64 * j]; s += (v[j].x * v[j].x + v[j].y * v[j].y) + (v[j].z * v[j].z + v[j].w * v[j].w); }
    const float rstd = rsqrtf(wave_sum(s) * (1.f / D) + EPS);
    u32x2* o8 = (u32x2*)orow + lane;
#pragma unroll
    for (int j = 0; j < 4; ++j) { u32x2 w; w.x = cvt_pk_bf16(v[j].x, v[j].y); w.y = cvt_pk_bf16(v[j].z, v[j].w); o8[64 * j] = w; }
    if (lane == 0) *rs = rstd;
}

template <int NR>
__device__ __forceinline__ void row_pass_rows(bf16_t* X, const bf16_t* MF, const float* gain, float* rs, float* outf, bool unscaled, int t0, int lane) {
    u32x4 xa[NR][2], ma[NR][2];
#pragma unroll
    for (int r = 0; r < NR; ++r) { const u32x4* xr = (const u32x4*)(X + (size_t)(t0 + r) * D); const u32x4* mr = (const u32x4*)(MF + (size_t)(t0 + r) * D);
        xa[r][0] = xr[lane]; xa[r][1] = xr[64 + lane]; ma[r][0] = mr[lane]; ma[r][1] = mr[64 + lane]; }
    float g[16];
    { const f32x4* g0 = (const f32x4*)(gain + lane * 8); const f32x4* g1 = (const f32x4*)(gain + 512 + lane * 8);
#pragma unroll
      for (int h = 0; h < 2; ++h) { const f32x4 a = g0[h], b = g1[h];
#pragma unroll
        for (int k = 0; k < 4; ++k) { g[4 * h + k] = a[k]; g[8 + 4 * h + k] = b[k]; } } }
#pragma unroll
    for (int r = 0; r < NR; ++r) {
        float x[16], m[16];
#pragma unroll
        for (int h = 0; h < 2; ++h) { const u32x4 xq = xa[r][h], mq = ma[r][h];
            x[8 * h + 0] = bf_lo(xq.x); x[8 * h + 1] = bf_hi(xq.x); x[8 * h + 2] = bf_lo(xq.y); x[8 * h + 3] = bf_hi(xq.y); x[8 * h + 4] = bf_lo(xq.z); x[8 * h + 5] = bf_hi(xq.z); x[8 * h + 6] = bf_lo(xq.w); x[8 * h + 7] = bf_hi(xq.w);
            m[8 * h + 0] = bf_lo(mq.x); m[8 * h + 1] = bf_hi(mq.x); m[8 * h + 2] = bf_lo(mq.y); m[8 * h + 3] = bf_hi(mq.y); m[8 * h + 4] = bf_lo(mq.z); m[8 * h + 5] = bf_hi(mq.z); m[8 * h + 6] = bf_lo(mq.w); m[8 * h + 7] = bf_hi(mq.w); }
        float sm = 0.f;
#pragma unroll
        for (int k = 0; k < 16; ++k) sm += m[k] * m[k];
        float eps_eff = EPS; if (unscaled) { const float rr = rs[t0 + r], r2 = rr * rr; eps_eff = EPS / (r2 * r2); }
        const float rm = rsqrtf(wave_sum(sm) * (1.f / D) + eps_eff);
        float s1 = 0.f;
#pragma unroll
        for (int k = 0; k < 16; ++k) { x[k] = x[k] + m[k] * rm * g[k]; s1 += x[k] * x[k]; }
        if (outf) {
            f32x4* o = (f32x4*)(outf + (size_t)(t0 + r) * D);
            o[lane * 2] = (f32x4){x[0], x[1], x[2], x[3]}; o[lane * 2 + 1] = (f32x4){x[4], x[5], x[6], x[7]};
            o[128 + lane * 2] = (f32x4){x[8], x[9], x[10], x[11]}; o[128 + lane * 2 + 1] = (f32x4){x[12], x[13], x[14], x[15]};
        } else {
            const float r1 = rsqrtf(wave_sum(s1) * (1.f / D) + EPS);
            u32x4* xo = (u32x4*)(X + (size_t)(t0 + r) * D);
            u32x4 w0, w1;
            w0.x = cvt_pk_bf16(x[0], x[1]); w0.y = cvt_pk_bf16(x[2], x[3]); w0.z = cvt_pk_bf16(x[4], x[5]); w0.w = cvt_pk_bf16(x[6], x[7]);
            w1.x = cvt_pk_bf16(x[8], x[9]); w1.y = cvt_pk_bf16(x[10], x[11]); w1.z = cvt_pk_bf16(x[12], x[13]); w1.w = cvt_pk_bf16(x[14], x[15]);
            xo[lane] = w0; xo[64 + lane] = w1;
            if (lane == 0) rs[t0 + r] = r1;
        }
    }
}

__device__ __forceinline__ void conv_wave_item(const bf16_t* p, const float* cw, bf16_t* Hm, int t0, int pos0, int S, int lane) {
    float w0[8], w1[8], w2[8];
    { const f32x4* a = (const f32x4*)(cw + lane * 8); const f32x4* b = (const f32x4*)(cw + 512 + lane * 8); const f32x4* c = (const f32x4*)(cw + 1024 + lane * 8);
#pragma unroll
      for (int h = 0; h < 2; ++h) { const f32x4 va = a[h], vb = b[h], vc = c[h];
#pragma unroll
        for (int k = 0; k < 4; ++k) { w0[4 * h + k] = va[k]; w1[4 * h + k] = vb[k]; w2[4 * h + k] = vc[k]; } } }
    float zp[8], zc[8], zn[8], ga[8], gb[8];
    const bf16_t* base = p + (size_t)t0 * DIN + lane * 8;
    if (pos0 == 0) {
#pragma unroll
        for (int k = 0; k < 8; ++k) zp[k] = 0.f;
    } else { load8(base - DIN + 512, ga); load8(base - DIN + 1024, gb);
#pragma unroll
        for (int k = 0; k < 8; ++k) zp[k] = ga[k] * gb[k]; }
    load8(base + 512, ga); load8(base + 1024, gb);
#pragma unroll
    for (int k = 0; k < 8; ++k) zc[k] = ga[k] * gb[k];
#pragma unroll 4
    for (int i = 0; i < 16; ++i) {
        const bf16_t* r = base + (size_t)i * DIN;
        if (pos0 + i + 1 == S) {
#pragma unroll
            for (int k = 0; k < 8; ++k) zn[k] = 0.f;
        } else { load8(r + DIN + 512, ga); load8(r + DIN + 1024, gb);
#pragma unroll
            for (int k = 0; k < 8; ++k) zn[k] = ga[k] * gb[k]; }
        load8(r, gb);
        float y[8], ss = 0.f;
#pragma unroll
        for (int k = 0; k < 8; ++k) { y[k] = gb[k] * (zp[k] * w0[k] + zc[k] * w1[k] + zn[k] * w2[k]); ss += y[k] * y[k]; }
        ss += __shfl_xor(ss, 1); ss += __shfl_xor(ss, 2); ss += __shfl_xor(ss, 4);
        const float rs = rsqrtf(ss * (1.f / 64.f) + EPS);
        u32x4 o; o.x = cvt_pk_bf16(y[0] * rs, y[1] * rs); o.y = cvt_pk_bf16(y[2] * rs, y[3] * rs); o.z = cvt_pk_bf16(y[4] * rs, y[5] * rs); o.w = cvt_pk_bf16(y[6] * rs, y[7] * rs);
        *(u32x4*)(Hm + (size_t)(t0 + i) * D + lane * 8) = o;
#pragma unroll
        for (int k = 0; k < 8; ++k) { zp[k] = zc[k]; zc[k] = zn[k]; }
    }
}

constexpr int XSTR = 272;
constexpr int RSTR = 34;
constexpr int LDS_XT = 0, LDS_R = 36864, LDS_OST = 106496;
#define LBAR() do { asm volatile("s_waitcnt lgkmcnt(0)" ::: "memory"); __builtin_amdgcn_s_barrier(); asm volatile("" ::: "memory"); } while (0)
__device__ __forceinline__ int seq_base(int bs) { return bs < BP ? bs * SP : TP + (bs - BP) * SS; }

__device__ __forceinline__ void dft_frags(bf16x8 (&Br)[4], bf16x8 (&Bi)[4], int log2n, int kt, int lane) {
    const int N = 1 << log2n, k = 16 * kt + (lane & 15); const float sc = 2.f / (float)N;
#pragma unroll
    for (int ks = 0; ks < 4; ++ks) { u32x4 wr, wi;
#pragma unroll
        for (int e2 = 0; e2 < 4; ++e2) { float c0, s0, c1, s1; const int n0 = 32 * ks + 8 * (lane >> 4) + 2 * e2;
            sincospif(-(float)((n0 * k) & (N - 1)) * sc, &s0, &c0); sincospif(-(float)(((n0 + 1) * k) & (N - 1)) * sc, &s1, &c1);
            wr[e2] = cvt_pk_bf16(c0, c1); wi[e2] = cvt_pk_bf16(s0, s1); }
        Br[ks] = __builtin_bit_cast(bf16x8, wr); Bi[ks] = __builtin_bit_cast(bf16x8, wi); }
}
__device__ __forceinline__ void xt_write(LAS unsigned char* xt, int rp, int ch, const u32x4 va, const u32x4 vb) {
    LAS unsigned char* base = xt + (8 * ch) * XSTR + ((((rp >> 2) ^ ch) << 4) + (rp & 3) * 4);
#pragma unroll
    for (int e2 = 0; e2 < 4; ++e2) {
        *(LAS unsigned*)(base + (2 * e2) * XSTR) = (va[e2] & 0xffffu) | (vb[e2] << 16);
        *(LAS unsigned*)(base + (2 * e2 + 1) * XSTR) = (va[e2] >> 16) | (vb[e2] & 0xffff0000u); }
}
__device__ __forceinline__ void dft_mfma(const LAS unsigned char* xt, int log2n, const bf16x8 (&Br)[4], const bf16x8 (&Bi)[4], f32x4 (&Pa)[4], f32x4 (&Qa)[4], int lane) {
#pragma unroll
    for (int it = 0; it < 4; ++it) { Pa[it] = (f32x4){0.f, 0.f, 0.f, 0.f}; Qa[it] = (f32x4){0.f, 0.f, 0.f, 0.f}; }
#pragma unroll
    for (int ks = 0; ks < 4; ++ks) if (ks < (1 << (log2n - 5))) {
#pragma unroll
        for (int it = 0; it < 4; ++it) { const int col = 16 * it + (lane & 15), gr = 4 * ks + (lane >> 4);
            const bf16x8 a = *(const LAS bf16x8*)(xt + col * XSTR + ((gr ^ (col >> 3)) << 4));
            Pa[it] = __builtin_amdgcn_mfma_f32_16x16x32_bf16(a, Br[ks], Pa[it], 0, 0, 0);
            Qa[it] = __builtin_amdgcn_mfma_f32_16x16x32_bf16(a, Bi[ks], Qa[it], 0, 0, 0); } }
}

__device__ __forceinline__ void p1_decode(int item, int& bs, int& g, int& n2, int& S, int& log2N2) {
    if (item < 2048) { bs = item >> 10; const int r = item & 1023; n2 = r >> 3; g = r & 7; S = SP; log2N2 = 7; }
    else { const int it = item - 2048; bs = BP + (it >> 9); const int r = it & 511; n2 = r >> 3; g = r & 7; S = SS; log2N2 = 6; }
}
__device__ __forceinline__ void p1_load(const bf16_t* p, int item, int rp, int ch, u32x4& va, u32x4& vb) {
    int bs, g, n2, S, l2; p1_decode(item, bs, g, n2, S, l2);
    const bf16_t* src = p + (size_t)(seq_base(bs) + ((2 * rp) << l2) + n2) * DIN + 1536 + g * 64 + ch * 8;
    va = *(const u32x4*)src; vb = *(const u32x4*)(src + ((size_t)DIN << l2));
}
__device__ __forceinline__ void fft_pass1(const bf16_t* p, bf16_t* inter, LAS unsigned char* lds, int bid, int G, int tid) {
    constexpr int NP1 = 2048 + 4096;
    const int lane = tid & 63, wave = __builtin_amdgcn_readfirstlane(tid >> 6), rp = tid >> 3, ch = tid & 7;
    bf16x8 Br[4], Bi[4]; dft_frags(Br, Bi, 7, wave, lane);
    u32x4 va, vb;
    if (bid < NP1) p1_load(p, bid, rp, ch, va, vb);
    int par = 0;
    for (int item = bid; item < NP1; item += G, par ^= 1) {
        LAS unsigned char* xt = lds + LDS_XT + par * (64 * XSTR);
        xt_write(xt, rp, ch, va, vb);
        if (item + G < NP1) p1_load(p, item + G, rp, ch, va, vb);
        LBAR();
        f32x4 Pa[4], Qa[4]; dft_mfma(xt, 7, Br, Bi, Pa, Qa, lane);
        int bs, g, n2, S, l2; p1_decode(item, bs, g, n2, S, l2);
        const int k1 = 16 * wave + (lane & 15), quad = lane >> 4;
        float sn, cs; sincospif(-2.0f * (float)(n2 * k1) / (float)S, &sn, &cs);
        bf16_t* dst = inter + ((size_t)seq_base(bs) * 8 + (size_t)g * S + ((size_t)k1 << l2) + n2) * 64 + 4 * quad;
#pragma unroll
        for (int it = 0; it < 4; ++it) {
            const float r0 = Pa[it][0] - Qa[it][1], i0 = Pa[it][1] + Qa[it][0], r1 = Pa[it][2] - Qa[it][3], i1 = Pa[it][3] + Qa[it][2];
            u32x2 w; w.x = cvt_pk_bf16(r0 * cs - i0 * sn, r0 * sn + i0 * cs); w.y = cvt_pk_bf16(r1 * cs - i1 * sn, r1 * sn + i1 * cs);
            *(u32x2*)(dst + 16 * it) = w; }
    }
    LBAR();
}

__device__ __forceinline__ void p2_decode(int item, int& bs, int& g, int& k1a, int& k1b, int& ip) {
    int r;
    if (item < 1024) { bs = item >> 9; r = item & 511; } else { const int it = item - 1024; bs = BP + (it >> 9); r = it & 511; }
    g = r >> 6; ip = r & 63; k1a = ip; k1b = ip == 0 ? 64 : 128 - ip;
}
template <int LOG2N>
__device__ __forceinline__ void fft_pass2(const bf16_t* inter, bf16_t* Hm, LAS unsigned char* lds, int item0, int item_end, int G, int tid) {
    constexpr int N2 = 1 << LOG2N, NTASK = N2 / 64, S = (LOG2N == 7) ? SP : SS;
    const int lane = tid & 63, wave = __builtin_amdgcn_readfirstlane(tid >> 6);
    bf16x8 Br[4], Bi[4]; dft_frags(Br, Bi, LOG2N, LOG2N == 7 ? wave : (wave & 3), lane);
    u32x4 va[NTASK], vb[NTASK];
#define P2_LOAD(item_) do { int bs_, g_, ka_, kb_, ip_; p2_decode(item_, bs_, g_, ka_, kb_, ip_); \
        const bf16_t* ib_ = inter + ((size_t)seq_base(bs_) * 8 + (size_t)g_ * S) * 64; \
        _Pragma("unroll") for (int j = 0; j < NTASK; ++j) { const int q = tid + NTHREADS * j, h = q / (4 * N2), r = q % (4 * N2), rp = r >> 3, ch = r & 7; \
            const bf16_t* src = ib_ + ((size_t)((h ? kb_ : ka_) * N2 + 2 * rp)) * 64 + ch * 8; va[j] = *(const u32x4*)src; vb[j] = *(const u32x4*)(src + 64); } } while (0)
    if (item0 < item_end) P2_LOAD(item0);
    LAS f32x2* R = (LAS f32x2*)(lds + LDS_R);
    LAS bf16_t* Ost = (LAS bf16_t*)(lds + LDS_OST);
    const float sc = rsqrtf((float)S);
    for (int item = item0; item < item_end; item += G) {
#pragma unroll
        for (int j = 0; j < NTASK; ++j) { const int q = tid + NTHREADS * j, h = q / (4 * N2), r = q % (4 * N2);
            xt_write(lds + LDS_XT + h * (64 * XSTR), r >> 3, r & 7, va[j], vb[j]); }
        if (item + G < item_end) P2_LOAD(item + G);
        LBAR();
        {
            f32x4 Pa[4], Qa[4]; const int quad = lane >> 4;
#pragma unroll
            for (int hh = 0; hh < (LOG2N == 7 ? 2 : 1); ++hh) {
                const int h = (LOG2N == 7) ? hh : (wave >> 2), kt = (LOG2N == 7) ? wave : (wave & 3);
                dft_mfma(lds + LDS_XT + h * (64 * XSTR), LOG2N, Br, Bi, Pa, Qa, lane);
                LAS f32x2* Rr = R + (h * N2 + 16 * kt + (lane & 15)) * RSTR + 2 * quad;
#pragma unroll
                for (int it = 0; it < 4; ++it)
                    *(LAS f32x4*)(Rr + 8 * it) = (f32x4){Pa[it][0] - Qa[it][1], Pa[it][1] + Qa[it][0], Pa[it][2] - Qa[it][3], Pa[it][3] + Qa[it][2]};
            }
        }
        LBAR();
        int bs, g, k1a, k1b, ip; p2_decode(item, bs, g, k1a, k1b, ip);
        const int tb = seq_base(bs);
        for (int idx = tid; idx < 2 * N2 * 32; idx += NTHREADS) {
            const int c = idx & 31, tl = idx >> 5, h = tl >> LOG2N, k2 = tl & (N2 - 1);
            const int ph = (ip == 0) ? h : 1 - h;
            const int k2p = (ip == 0 && h == 0) ? ((N2 - k2) & (N2 - 1)) : (N2 - 1 - k2);
            const f32x2 own = R[(h * N2 + k2) * RSTR + c], par = R[(ph * N2 + k2p) * RSTR + c];
            float v1 = (c == 0) ? 0.5f * (own.x + par.x) : own.x, v2 = (c == 0) ? 0.5f * (own.y + par.y) : par.x;
            v1 *= sc; v2 *= sc;
            float ss = v1 * v1 + v2 * v2;
            ss += __shfl_xor(ss, 1); ss += __shfl_xor(ss, 2); ss += __shfl_xor(ss, 4); ss += __shfl_xor(ss, 8); ss += __shfl_xor(ss, 16);
            const float rs = rsqrtf(ss * (1.f / 64.f) + EPS);
            Ost[tl * 64 + c] = (bf16_t)(cvt_pk_bf16(v1 * rs, 0.f) & 0xffffu);
            Ost[tl * 64 + (c == 0 ? 32 : 64 - c)] = (bf16_t)(cvt_pk_bf16(v2 * rs, 0.f) & 0xffffu);
        }
        LBAR();
        for (int idx = tid; idx < 2 * N2 * 8; idx += NTHREADS) {
            const int tl = idx >> 3, ch = idx & 7, h = tl >> LOG2N, k2 = tl & (N2 - 1);
            const int tok = tb + (h ? k1b : k1a) + 128 * k2;
            *(u32x4*)(Hm + (size_t)tok * D + 512 + g * 64 + ch * 8) = ((const LAS u32x4*)Ost)[idx];
        }
    }
    LBAR();
#undef P2_LOAD
}

#define XB_TMO      128
#define XB_XCNT(j)  (256  + 64 * (j))
#define XB_XSUB(j)  (1280 + 64 * (j))
#define XB_XGEN(j)  (2304 + 64 * (j))
#define XB_TOP      3328
#define XB_TOPGEN   3392
#define XCD_BAR_WORDS 3456
#define XB_SPIN_CAP (1u << 20)
__device__ __forceinline__ unsigned xb_ld(unsigned* p)              { return __hip_atomic_load(p, __ATOMIC_RELAXED, __HIP_MEMORY_SCOPE_AGENT); }
__device__ __forceinline__ unsigned xb_add(unsigned* p, unsigned v) { return __hip_atomic_fetch_add(p, v, __ATOMIC_RELAXED, __HIP_MEMORY_SCOPE_AGENT); }
__device__ __forceinline__ unsigned xb_xcc_id() { return (unsigned)__builtin_amdgcn_s_getreg((3 << 11) | 20) & 0xFu; }
#define XB_SPIN(cond, bar) do { unsigned _sp = 0; while (cond) { __builtin_amdgcn_s_sleep(1); \
    if ((++_sp & 255u) == 0u) { if (xb_ld(&(bar)[XB_TMO])) break; if (_sp > XB_SPIN_CAP) { atomicAdd(&(bar)[XB_TMO], 1u); break; } } } } while (0)
struct XcdBarrier { unsigned* bar; unsigned x; volatile LAS unsigned* st; };
__device__ __forceinline__ XcdBarrier xcd_barrier_post(unsigned* bar, volatile LAS unsigned* st) {
    XcdBarrier b; b.bar = bar; b.x = xb_xcc_id(); b.st = st;
    if (threadIdx.x == 0) (void)xb_add(&bar[XB_XCNT(b.x)], 1u);
    return b;
}
__device__ __forceinline__ void xcd_barrier_complete(unsigned* bar, unsigned x, unsigned& nloc, unsigned& nx) {
    const unsigned G = gridDim.x * gridDim.y * gridDim.z;
    unsigned sum, cnt, mine, sp = 0u;
    for (;;) {
        sum = 0u; cnt = 0u; mine = 0u;
#pragma unroll
        for (unsigned j = 0; j < 16; ++j) { const unsigned c = xb_ld(&bar[XB_XCNT(j)]); sum += c; cnt += (c > 0u) ? 1u : 0u; mine = (j == x) ? c : mine; }
        if (sum == G) break;
        __builtin_amdgcn_s_sleep(1);
        if ((++sp & 255u) == 0u) { if (xb_ld(&bar[XB_TMO])) break; if (sp > XB_SPIN_CAP) { atomicAdd(&bar[XB_TMO], 1u); break; } }
    }
    nloc = mine > 0u ? mine : 1u; nx = cnt > 0u ? cnt : 1u;
}
__device__ __forceinline__ void xcd_barrier(const XcdBarrier& b) {
    asm volatile("s_waitcnt vmcnt(0)" ::: "memory");
    __syncthreads();
    if (threadIdx.x == 0) {
        unsigned* bar = b.bar;
        __builtin_amdgcn_s_waitcnt(0);
        unsigned nloc = b.st[0], nx = b.st[1];
        if (nloc == 0u) { xcd_barrier_complete(bar, b.x, nloc, nx); b.st[0] = nloc; b.st[1] = nx; }
        const unsigned old = xb_add(&bar[XB_XSUB(b.x)], 1u);
        const unsigned gen = old / nloc;
        if (old + 1u == (gen + 1u) * nloc) {
            __builtin_amdgcn_fence(__ATOMIC_RELEASE, "agent");
            asm volatile("s_waitcnt vmcnt(0)" ::: "memory");
            const unsigned og = xb_add(&bar[XB_TOP], 1u);
            const unsigned tg = og / nx;
            if (og + 1u == (tg + 1u) * nx) xb_add(&bar[XB_TOPGEN], 1u);
            else XB_SPIN(xb_ld(&bar[XB_TOPGEN]) == tg, bar);
            __builtin_amdgcn_fence(__ATOMIC_ACQUIRE, "agent");
            xb_add(&bar[XB_XGEN(b.x)], 1u);
            asm volatile("s_waitcnt vmcnt(0)" ::: "memory");
        } else {
            XB_SPIN(xb_ld(&bar[XB_XGEN(b.x)]) == gen, bar);
            __builtin_amdgcn_fence(__ATOMIC_ACQUIRE, "agent");
            asm volatile("s_waitcnt vmcnt(0)" ::: "memory");
        }
    }
    __syncthreads();
}

__global__ void __launch_bounds__(NTHREADS, 2) fwd_megakernel(Params P) {
    extern __shared__ __attribute__((aligned(16))) unsigned char shm[];
    cg::grid_group grid = cg::this_grid();
    LAS unsigned char* lds = (LAS unsigned char*)shm;
    const int G = gridDim.x, bid = blockIdx.x, NGW = G * NWAVES;
#define FRESH() int tid = threadIdx.x; asm volatile("" : "+v"(tid)); const int lane = tid & 63, wave = __builtin_amdgcn_readfirstlane(tid >> 6), gw = bid * NWAVES + wave; (void)lane; (void)gw
#define TAB ((LAS float*)(lds + LDS_MISC))
    { FRESH();
      if (tid < 64) TAB[tid] = cospif((float)tid * (1.f / 32.f));
      if (tid < 4) ((volatile LAS unsigned*)(lds + LDS_MISC + 1024))[tid] = 0u; }
    __syncthreads();
    const XcdBarrier xbar = xcd_barrier_post((unsigned*)P.ws, (volatile LAS unsigned*)(lds + LDS_MISC + 1024));
#define GSYNC() xcd_barrier(xbar)

    unsigned char* ws = P.ws;
#define Xb ((bf16_t*)(ws + WS_X))
#define Hb ((bf16_t*)(ws + WS_H))
#define Pb ((bf16_t*)P.out)
#define Ib ((bf16_t*)(ws + WS_INTER))
#define MFb ((bf16_t*)(ws + WS_MF))
#define A0b ((bf16_t*)(ws + WS_H))
#define A1b ((bf16_t*)P.out)
#define RSb ((float*)(ws + WS_RS))

    {
        FRESH();
        LAS float* scr = (LAS float*)(lds + wave * 8704);
        constexpr int I_IN = 16 * 48, I_OUT = 16 * 32, I_UP = 16 * 128, I_DN = 64 * 32, I_F = 128, I_L = I_IN + I_OUT + I_UP + I_DN + I_F;
        for (int it = gw; it < NL * I_L; it += NGW) {
            const int l = it / I_L; int r = it % I_L;
            bf16_t* Wl = (bf16_t*)(ws + WS_W + (size_t)l * WL_SZ);
            const float* win = P.w_in + (size_t)l * D * DIN;
            if (r < I_IN) { p0_transpose_item(win, D, DIN, 48, Wl + WL_IN / 2, P.g_mix_pre + l * D, scr, r, lane); continue; } r -= I_IN;
            if (r < I_OUT) {
                const int kb = r / 32; const float* gsrc = kb < 8 ? P.g_conv_out + l * 512 : P.g_fourier_out + l * 512 - 512;
                p0_transpose_item(P.w_out + (size_t)l * D * D, D, D, 32, Wl + WL_OUT / 2, gsrc, scr, r, lane); continue; } r -= I_OUT;
            if (r < I_UP) { p0_transpose_item(P.w_up + (size_t)l * D * DFF, D, DFF, 128, Wl + WL_UP / 2, P.g_mlp_pre + l * D, scr, r, lane); continue; } r -= I_UP;
            if (r < I_DN) { p0_transpose_item(P.w_down + (size_t)l * DFF * D, DFF, D, 32, Wl + WL_DN / 2, nullptr, scr, r, lane); continue; } r -= I_DN;
            p0_fold_item(win, P.g_mix_pre + l * D, Wl + WL_IN / 2, TAB, r, lane);
        }
        for (int t = gw; t < T; t += NGW) x_row_init(t < TP ? P.xp + (size_t)t * D : P.xs + (size_t)(t - TP) * D, Xb + (size_t)t * D, RSb + t, lane);
    }
    grid.sync();

    for (int l = 0; l < NL; ++l) {
        const bf16_t* Wl = (const bf16_t*)(ws + WS_W + (size_t)l * WL_SZ);
        { pg8::Gemm g{Xb, Wl + WL_IN / 2, T, DIN, D, nullptr, 1 << 20}; pg8::StaticOrder S; S.init(T, DIN, G, bid); pg8::EpiBf16 E{Pb, DIN, 0, RSb, nullptr, 1 << 20};
          pg8::gemm_phase(lds, g, S, E); }
        GSYNC();
        {
            FRESH();
            constexpr int NCONV = T / 128;
            for (int it = bid; it < NCONV; it += G) { const int t0 = it * 128 + wave * 16; const int S = t0 < TP ? SP : SS; const int pos0 = t0 < TP ? (t0 & (SP - 1)) : ((t0 - TP) & (SS - 1));
                conv_wave_item(Pb, P.conv_w + (size_t)l * 3 * 512, Hb, t0, pos0, S, lane); }
            fft_pass1(Pb, Ib, lds, bid, G, tid);
        }
        GSYNC();
        { FRESH(); fft_pass2<7>(Ib, Hb, lds, bid, 1024, G, tid); }
        { FRESH(); fft_pass2<6>(Ib, Hb, lds, 1024 + bid, 1024 + 4096, G, tid); }
        GSYNC();
        { pg8::Gemm g{Hb, Wl + WL_OUT / 2, T, D, D, nullptr, 1 << 20}; pg8::StaticOrder S; S.init(T, D, G, bid); pg8::EpiBf16 E{MFb, D, 0, nullptr, nullptr, 1 << 20};
          pg8::gemm_phase(lds, g, S, E); }
        GSYNC();
        { FRESH();
          for (int t = gw * 4; t < T; t += NGW * 4) row_pass_rows<4>(Xb, MFb, P.g_mix_post + l * D, RSb, nullptr, false, t, lane); }
        GSYNC();
        { pg8::Gemm g{Xb, Wl + WL_UP / 2, T, DFF, D, nullptr, 1 << 20}; pg8::StaticOrder S; S.init(T, DFF, G, bid); pg8::EpiBf16 E{A0b, DFF, 1, nullptr, A1b, TCH / 256};
          pg8::gemm_phase(lds, g, S, E); }
        GSYNC();
        { pg8::Gemm g{A0b, Wl + WL_DN / 2, T, D, DFF, A1b, TCH / 256}; pg8::StaticOrder S; S.init(T, D, G, bid); pg8::EpiBf16 E{MFb, D, 0, nullptr, nullptr, 1 << 20};
          pg8::gemm_phase(lds, g, S, E); }
        GSYNC();
        { FRESH();
          float* outf = (l + 1 < NL) ? nullptr : P.out;
          for (int t = gw * 4; t < T; t += NGW * 4) row_pass_rows<4>(Xb, MFb, P.g_mlp_post + l * D, RSb, outf, true, t, lane); }
        if (l + 1 < NL) GSYNC();
    }
}

extern "C" void kernel_launch(void* const* d_in, const int* in_sizes, int n_in, void* d_out, int out_size, void* d_ws, size_t ws_size, hipStream_t stream) {
    static int grid_blocks = 0;
    if (grid_blocks == 0) {
        if (n_in != 13 || out_size != T * D || ws_size < WS_END) { fprintf(stderr, "kernel_launch: unexpected shapes (n_in %d, out %d, ws %zu, need %zu)\n", n_in, out_size, ws_size, (size_t)WS_END); grid_blocks = -1; return; }
        int dev = 0, cus = 0, per_cu = 0;
        hipGetDevice(&dev);
        hipDeviceGetAttribute(&cus, hipDeviceAttributeMultiprocessorCount, dev);
        if (hipFuncSetAttribute((const void*)fwd_megakernel, hipFuncAttributeMaxDynamicSharedMemorySize, LDS_BYTES) != hipSuccess) { fprintf(stderr, "kernel_launch: hipFuncSetAttribute failed\n"); grid_blocks = -1; return; }
        hipOccupancyMaxActiveBlocksPerMultiprocessor(&per_cu, (const void*)fwd_megakernel, NTHREADS, LDS_BYTES);
        if (per_cu < 1) { fprintf(stderr, "kernel_launch: occupancy query says %d blocks per CU\n", per_cu); per_cu = 1; }
        grid_blocks = cus * per_cu;
    }
    if (grid_blocks < 0) return;
    Params p{};
    p.xp = (const float*)d_in[0]; p.xs = (const float*)d_in[1]; p.g_mix_pre = (const float*)d_in[2]; p.w_in = (const float*)d_in[3]; p.conv_w = (const float*)d_in[4];
    p.g_conv_out = (const float*)d_in[5]; p.g_fourier_out = (const float*)d_in[6]; p.w_out = (const float*)d_in[7]; p.g_mix_post = (const float*)d_in[8];
    p.g_mlp_pre = (const float*)d_in[9]; p.w_up = (const float*)d_in[10]; p.w_down = (const float*)d_in[11]; p.g_mlp_post = (const float*)d_in[12];
    p.out = (float*)d_out; p.ws = (unsigned char*)d_ws;
    if (hipMemsetAsync(d_ws, 0, 16384, stream) != hipSuccess) { fprintf(stderr, "kernel_launch: memset failed\n"); return; }
    void* args[] = {&p};
    hipError_t e = hipLaunchCooperativeKernel((const void*)fwd_megakernel, dim3(grid_blocks), dim3(NTHREADS), args, LDS_BYTES, stream);
    if (e != hipSuccess) fprintf(stderr, "cooperative launch failed: %s (grid %d)\n", hipGetErrorString(e), grid_blocks);
}
```

```cpp
#include <hip/hip_runtime.h>
#include <hip/hip_cooperative_groups.h>
#include <cstdio>
namespace cg = cooperative_groups;

#define LAS __attribute__((address_space(3)))
typedef unsigned short bf16_t;
typedef short bf16x8 __attribute__((ext_vector_type(8)));
typedef float f32x4 __attribute__((ext_vector_type(4)));
typedef float f32x2 __attribute__((ext_vector_type(2)));
typedef unsigned u32x4 __attribute__((ext_vector_type(4)));
typedef unsigned u32x2 __attribute__((ext_vector_type(2)));

constexpr int D = 1024, DIN = 2048, DFF = 4096, NL = 4;
constexpr int PLD = 1536;
constexpr int SP = 16384, BP = 2, SS = 8192, BS = 8;
constexpr int TP = BP * SP, TS = BS * SS, T = TP + TS;
constexpr float EPS = 1e-6f;
constexpr int NCH = 2;
constexpr int TCH = T / NCH;

constexpr size_t MiB = (size_t)1 << 20;
constexpr size_t WS_W = 1 * MiB;
constexpr size_t WL_IN = 0, WL_OUT = 4 * MiB, WL_UP = 6 * MiB, WL_DN = 14 * MiB, WL_SZ = 22 * MiB;
constexpr size_t WS_X = WS_W + NL * WL_SZ;
constexpr size_t WS_H = WS_X + (size_t)T * D * 2;
constexpr size_t WS_INTER = WS_H + (size_t)T * D * 2;
constexpr size_t WS_MF = WS_INTER + (size_t)T * 256 * 8;
constexpr size_t WS_RS = WS_MF + (size_t)T * D * 2;
constexpr size_t WS_END = WS_RS + 1 * MiB;

constexpr int LDS_STAGE = 131072, LDS_MISC = 139264, LDS_BYTES = LDS_MISC + 4096;
constexpr int NTHREADS = 512, NWAVES = 8;

struct Params {
    const float* xp; const float* xs; const float* g_mix_pre; const float* w_in; const float* conv_w;
    const float* g_conv_out; const float* g_fourier_out; const float* w_out; const float* g_mix_post;
    const float* g_mlp_pre; const float* w_up; const float* w_down; const float* g_mlp_post;
    float* out; unsigned char* ws;
};

__device__ __forceinline__ unsigned cvt_pk_bf16(float lo, float hi) { unsigned r; asm volatile("v_cvt_pk_bf16_f32 %0, %1, %2" : "=v"(r) : "v"(lo), "v"(hi)); return r; }
__device__ __forceinline__ float bf_lo(unsigned w) { return __uint_as_float(w << 16); }
__device__ __forceinline__ float bf_hi(unsigned w) { return __uint_as_float(w & 0xffff0000u); }
__device__ __forceinline__ float wave_sum(float v) {
#pragma unroll
    for (int o = 1; o < 64; o <<= 1) v += __shfl_xor(v, o);
    return v;
}
__device__ __forceinline__ void load8(const bf16_t* ptr, float (&v)[8]) {
    const u32x4 q = *(const u32x4*)ptr;
    v[0] = bf_lo(q.x); v[1] = bf_hi(q.x); v[2] = bf_lo(q.y); v[3] = bf_hi(q.y); v[4] = bf_lo(q.z); v[5] = bf_hi(q.z); v[6] = bf_lo(q.w); v[7] = bf_hi(q.w);
}

namespace pg8 {
constexpr int BM = 256, BK = 64, HALF = 128, HTB = HALF * BK * 2, STAGE_BYTES = 8 * HTB, NXCD = 8, WGM = 8;
__device__ __forceinline__ int lds_byte(int r, int c) { const int st = (r >> 4) * 2 + (c >> 5), rr = r & 15, cc = c & 31, ob = rr * 64 + cc * 2; return st * 1024 + (ob ^ (((ob >> 9) & 1) << 5)); }
__device__ __forceinline__ void stage_rc(int b, int& R, int& C) { const int st = b / 1024, sb = b % 1024, swz = sb ^ (((sb >> 9) & 1) << 5); R = (st >> 1) * 16 + swz / 64; C = (st & 1) * 32 + (swz % 64) / 2; }
__device__ __forceinline__ int perm32(int rho) { const int n = rho >> 4, i = rho & 15; return 8 * (i >> 2) + 4 * n + (i & 3); }

struct Unit { int pm, pn; };
struct Gemm { const bf16_t* A; const bf16_t* Bt; int M, N, K; const bf16_t* A2; int split; };

struct StaticOrder {
    int nM, nN, nwg, G, c;
    __device__ void init(int M, int N, int G_, int c_) { nM = M / BM; nN = N / BM; nwg = nM * nN; G = G_; c = c_; }
    __device__ bool next(int i, Unit& u) const {
        const long L = (long)i * G + c; if (L >= nwg) return false;
        int wgid = (int)L; { const int q = nwg / NXCD, r = nwg % NXCD, xcd = wgid % NXCD, off = wgid / NXCD; wgid = (xcd < r ? xcd * (q + 1) : r * (q + 1) + (xcd - r) * q) + off; }
        const int nig = WGM * nN, gid = wgid / nig, fm = gid * WGM, gsz = (nM - fm) < WGM ? (nM - fm) : WGM;
        u.pm = fm + ((wgid % nig) % gsz); u.pn = (wgid % nig) / gsz; return true;
    }
};

struct EpiBf16 {
    static constexpr bool FUSED = false;
    bf16_t* O; int ldc; int act; const float* rs; bf16_t* O2; int split;
    __device__ __forceinline__ void operator()(const f32x4 (&acc)[2][2][4][2], const Unit& u, int wr, int wc, int fr, int fq) const {
        const bool lo = u.pm < split; bf16_t* Ob = lo ? O : O2;
        const int grow0 = u.pm * BM + wr * 64 + fr, row0 = grow0 - (lo ? 0 : split * BM); const int col0 = u.pn * BM + wc * 32 + 8 * fq;
#pragma unroll
        for (int ai = 0; ai < 2; ++ai)
#pragma unroll
            for (int m = 0; m < 4; ++m) { bf16_t* rowp = Ob + (size_t)(row0 + ai * HALF + m * 16) * ldc + col0; const float sc = rs ? rs[grow0 + ai * HALF + m * 16] : 1.f;
#pragma unroll
                for (int bj = 0; bj < 2; ++bj) { f32x4 v0 = acc[ai][bj][m][0] * sc, v1 = acc[ai][bj][m][1] * sc;
                    if (act) {
#pragma unroll
                        for (int j = 0; j < 4; ++j) { const float a0 = fmaxf(v0[j], 0.f), a1 = fmaxf(v1[j], 0.f); v0[j] = a0 * a0; v1[j] = a1 * a1; } }
                    u32x4 w; w.x = cvt_pk_bf16(v0[0], v0[1]); w.y = cvt_pk_bf16(v0[2], v0[3]); w.z = cvt_pk_bf16(v1[0], v1[1]); w.w = cvt_pk_bf16(v1[2], v1[3]);
                    *(u32x4*)(rowp + bj * HALF) = w; } }
    }
};


struct EpiInProj {
    static constexpr bool FUSED = false;
    bf16_t* O; const float* rs;
    __device__ __forceinline__ void operator()(const f32x4 (&acc)[2][2][4][2], const Unit& u, int wr, int wc, int fr, int fq) const {
        const int row0 = u.pm * BM + wr * 64 + fr, sub = wc * 32 + 8 * fq;
        const bool isz = (u.pn >= 2 && u.pn < 6);
        const int cbase = isz ? 512 + (u.pn - 2) * 128 + sub : (u.pn < 2 ? u.pn * BM + sub : 1024 + (u.pn - 6) * BM + sub);
#pragma unroll
        for (int ai = 0; ai < 2; ++ai)
#pragma unroll
            for (int m = 0; m < 4; ++m) { const int row = row0 + ai * HALF + m * 16; bf16_t* rowp = O + (size_t)row * PLD + cbase; const float sc = rs[row];
                if (isz) { const float s2 = sc * sc; const f32x4 z0 = acc[ai][0][m][0] * acc[ai][1][m][0] * s2, z1 = acc[ai][0][m][1] * acc[ai][1][m][1] * s2;
                    u32x4 w; w.x = cvt_pk_bf16(z0[0], z0[1]); w.y = cvt_pk_bf16(z0[2], z0[3]); w.z = cvt_pk_bf16(z1[0], z1[1]); w.w = cvt_pk_bf16(z1[2], z1[3]);
                    *(u32x4*)rowp = w; }
                else {
#pragma unroll
                    for (int bj = 0; bj < 2; ++bj) { const f32x4 v0 = acc[ai][bj][m][0] * sc, v1 = acc[ai][bj][m][1] * sc;
                        u32x4 w; w.x = cvt_pk_bf16(v0[0], v0[1]); w.y = cvt_pk_bf16(v0[2], v0[3]); w.z = cvt_pk_bf16(v1[0], v1[1]); w.w = cvt_pk_bf16(v1[2], v1[3]);
                        *(u32x4*)(rowp + bj * HALF) = w; } } }
    }
};

template <class Epi, class Sched>
__device__ __forceinline__ void gemm_phase(LAS unsigned char* lds, const Gemm g, const Sched& S, const Epi& E) {
    int tid_ = threadIdx.x; asm volatile("" : "+v"(tid_));
    const int tid = tid_, wid = __builtin_amdgcn_readfirstlane(tid >> 6), lane = tid & 63, wr = wid >> 2, wc = wid & 3, fr = lane & 15, fq = lane >> 4;
    const int K = g.K, nt = K / BK;
    unsigned voffA[2], voffB[2];
#pragma unroll
    for (int i = 0; i < 2; ++i) { int R, C; stage_rc(tid * 16 + i * 8192, R, C); const int Rb = (R & ~31) + perm32(R & 31);
        voffA[i] = (unsigned)(R * K + C) * 2u; voffB[i] = (unsigned)(Rb * K + C) * 2u; }
    const size_t kstep = (size_t)(BK * 2);
    const size_t hstep = (size_t)HALF * K * 2;
    const size_t tstep = 2 * hstep;
    const unsigned ldsw = (unsigned)wid * 1024u;
    const int aoff = lds_byte(wr * 64 + fr, fq * 8), boff = lds_byte(wc * 32 + fr, fq * 8);
#define PG8_SA(b, h) (((b) * 2 + (h)) * HTB)
#define PG8_SB(b, h) ((4 + (b) * 2 + (h)) * HTB)
#define PG8_STAGE(bufoff, gbase, voff) do { _Pragma("unroll") for (int _i = 0; _i < 2; ++_i) \
        __builtin_amdgcn_global_load_lds((const unsigned*)((const char*)(gbase) + (voff)[_i]), (LAS unsigned*)(lds + (bufoff) + ldsw + _i * 8192), 16, 0, 0); } while (0)
#define PG8_LDA(dst, b, h) do { _Pragma("unroll") for (int m = 0; m < 4; ++m) _Pragma("unroll") for (int k = 0; k < 2; ++k) dst[m][k] = *(const LAS bf16x8*)(lds + PG8_SA(b, h) + aoff + m * 2048 + k * 1024); } while (0)
#define PG8_LDB(dst, b, h) do { _Pragma("unroll") for (int n = 0; n < 2; ++n) _Pragma("unroll") for (int k = 0; k < 2; ++k) dst[n][k] = *(const LAS bf16x8*)(lds + PG8_SB(b, h) + boff + n * 2048 + k * 1024); } while (0)
#define PG8_MMA(ai, bj, At, Bt) do { __builtin_amdgcn_s_setprio(1); _Pragma("unroll") for (int m = 0; m < 4; ++m) _Pragma("unroll") for (int n = 0; n < 2; ++n) _Pragma("unroll") for (int k = 0; k < 2; ++k) \
        acc[ai][bj][m][n] = __builtin_amdgcn_mfma_f32_16x16x32_bf16(Bt[n][k], At[m][k], acc[ai][bj][m][n], 0, 0, 0); __builtin_amdgcn_s_setprio(0); } while (0)
#define PG8_WAIT_V(n) asm volatile("s_waitcnt vmcnt(" #n ")" ::: "memory")
#define PG8_WAIT_L(n) asm volatile("s_waitcnt lgkmcnt(" #n ")" ::: "memory")
#define PG8_BAR __builtin_amdgcn_s_barrier()
#define PG8_SCHED __builtin_amdgcn_sched_barrier(0)
    Unit cur, nxt; int ui = 0;
    if (!S.next(0, cur)) return;
    f32x4 acc[2][2][4][2];
#pragma unroll
    for (int a = 0; a < 2; ++a)
#pragma unroll
        for (int b = 0; b < 2; ++b)
#pragma unroll
            for (int m = 0; m < 4; ++m)
#pragma unroll
                for (int n = 0; n < 2; ++n) acc[a][b][m][n] = (f32x4){0.f, 0.f, 0.f, 0.f};
    bf16x8 At[4][2], B0[2][2], B1[2][2];
#define PG8_APANEL(pm_) ((const char*)(((pm_) < g.split ? (unsigned long long)g.A : (unsigned long long)g.A2 - (unsigned long long)g.split * tstep) + (unsigned long long)(pm_) * tstep))
    const char* cA = PG8_APANEL(cur.pm); const char* cB = (const char*)g.Bt + (size_t)cur.pn * tstep;
    PG8_STAGE(PG8_SB(0, 0), cB, voffB); PG8_STAGE(PG8_SA(0, 0), cA, voffA); PG8_STAGE(PG8_SB(0, 1), cB + hstep, voffB); PG8_STAGE(PG8_SA(0, 1), cA + hstep, voffA);
    if (wr == 1) PG8_BAR;
    PG8_WAIT_V(4); PG8_BAR;
    PG8_STAGE(PG8_SB(1, 0), cB + kstep, voffB); PG8_STAGE(PG8_SA(1, 0), cA + kstep, voffA); PG8_STAGE(PG8_SB(1, 1), cB + hstep + kstep, voffB);
    PG8_WAIT_V(6); PG8_BAR;
    for (;;) {
        const bool has_next = S.next(ui + 1, nxt);
        const char* nA = has_next ? PG8_APANEL(nxt.pm) : cA; const char* nB = has_next ? (const char*)g.Bt + (size_t)nxt.pn * tstep : cB;
        for (int t = 0; t < nt; t += 2) {
            const bool last = (t == nt - 2);
            const char* a1 = cA + (size_t)(t + 1) * kstep;
            const char* a2 = last ? nA : cA + (size_t)(t + 2) * kstep; const char* b2 = last ? nB : cB + (size_t)(t + 2) * kstep;
            const char* a3 = a2 + kstep; const char* b3 = b2 + kstep;
            PG8_LDB(B0, 0, 0); PG8_SCHED; PG8_LDA(At, 0, 0); PG8_STAGE(PG8_SA(1, 1), a1 + hstep, voffA);
            PG8_WAIT_L(8); PG8_BAR; PG8_WAIT_L(0); PG8_MMA(0, 0, At, B0); PG8_BAR; PG8_SCHED;
            PG8_LDB(B1, 0, 1); PG8_STAGE(PG8_SB(0, 0), b2, voffB);
            PG8_BAR; PG8_WAIT_L(0); PG8_MMA(0, 1, At, B1); PG8_BAR;
            PG8_LDA(At, 0, 1); PG8_STAGE(PG8_SA(0, 0), a2, voffA);
            PG8_BAR; PG8_WAIT_L(0); PG8_MMA(1, 0, At, B0); PG8_BAR; PG8_SCHED;
            PG8_STAGE(PG8_SB(0, 1), b2 + hstep, voffB);
            PG8_WAIT_V(6); PG8_BAR; PG8_MMA(1, 1, At, B1); PG8_BAR;
            PG8_LDB(B0, 1, 0); PG8_SCHED; PG8_LDA(At, 1, 0); PG8_STAGE(PG8_SA(0, 1), a2 + hstep, voffA);
            PG8_WAIT_L(8); PG8_BAR; PG8_WAIT_L(0); PG8_MMA(0, 0, At, B0); PG8_BAR; PG8_SCHED;
            PG8_LDB(B1, 1, 1); PG8_STAGE(PG8_SB(1, 0), b3, voffB);
            PG8_BAR; PG8_WAIT_L(0); PG8_MMA(0, 1, At, B1); PG8_BAR;
            PG8_LDA(At, 1, 1); PG8_STAGE(PG8_SA(1, 0), a3, voffA);
            PG8_BAR; PG8_WAIT_L(0); PG8_MMA(1, 0, At, B0); PG8_BAR; PG8_SCHED;
            PG8_STAGE(PG8_SB(1, 1), b3 + hstep, voffB);
            PG8_WAIT_V(6); PG8_BAR; PG8_MMA(1, 1, At, B1); PG8_BAR;
        }
        E(acc, cur, wr, wc, fr, fq);
        if (!has_next) break;
#pragma unroll
        for (int a = 0; a < 2; ++a)
#pragma unroll
            for (int b = 0; b < 2; ++b)
#pragma unroll
                for (int m = 0; m < 4; ++m)
#pragma unroll
                    for (int n = 0; n < 2; ++n) acc[a][b][m][n] = (f32x4){0.f, 0.f, 0.f, 0.f};
        cur = nxt; cA = nA; cB = nB; ++ui;
    }
    PG8_WAIT_V(0);
    if (wr == 0) PG8_BAR;
    PG8_BAR;
#undef PG8_APANEL
#undef PG8_SA
#undef PG8_SB
#undef PG8_STAGE
#undef PG8_LDA
#undef PG8_LDB
#undef PG8_MMA
#undef PG8_WAIT_V
#undef PG8_WAIT_L
#undef PG8_BAR
#undef PG8_SCHED
}
}

template <bool INPROJ = false>
__device__ __forceinline__ void p0_transpose_item(const float* W, int K, int ldN, int nblk, bf16_t* WT, const float* gain, LAS float* scr, int item, int lane) {
    const int kb = item / nblk, nb = item % nblk, k0 = 64 * kb, n0 = 32 * nb;
    const int dn0 = !INPROJ || n0 < 512 ? n0 : (n0 < 1024 ? 512 + ((n0 - 512) >> 7) * 256 + ((n0 - 512) & 127) : 512 + ((n0 - 1024) >> 7) * 256 + 128 + ((n0 - 1024) & 127));
#pragma unroll 8
    for (int i = 0; i < 32; ++i) { const int kk = 2 * i + (lane >> 5); const float gk = gain ? gain[k0 + kk] : 1.f;
        scr[kk * 33 + (lane & 31)] = W[(size_t)(k0 + kk) * ldN + n0 + (lane & 31)] * gk; }
    asm volatile("s_waitcnt lgkmcnt(0)" ::: "memory");
    const int c = lane & 7;
#pragma unroll
    for (int j = 0; j < 4; ++j) { const int n = (lane >> 3) + 8 * j; const LAS float* s = scr + (8 * c) * 33 + n;
        u32x4 o; o.x = cvt_pk_bf16(s[0 * 33], s[1 * 33]); o.y = cvt_pk_bf16(s[2 * 33], s[3 * 33]); o.z = cvt_pk_bf16(s[4 * 33], s[5 * 33]); o.w = cvt_pk_bf16(s[6 * 33], s[7 * 33]);
        *(u32x4*)(WT + (size_t)(dn0 + n) * K + k0 + 8 * c) = o; }
    asm volatile("s_waitcnt lgkmcnt(0)" ::: "memory");
}
__device__ __forceinline__ void p0_fold_item(const float* Win  , const float* gpre, bf16_t* WT  , const LAS float* tab, int item, int lane) {
    const int kb = item >> 3, g = item & 7, k = kb * 64 + lane;
    const float gk = gpre[k] * 0.125f;
    const f32x4* src = (const f32x4*)(Win + (size_t)k * DIN + 1536 + g * 64);
    float row[64];
#pragma unroll
    for (int i = 0; i < 16; ++i) { const f32x4 v = src[i]; row[4 * i] = v.x * gk; row[4 * i + 1] = v.y * gk; row[4 * i + 2] = v.z * gk; row[4 * i + 3] = v.w * gk; }
    for (int j = 0; j < 64; ++j) {
        const int cj = (j == 0) ? 0 : (j == 1 ? 32 : (j >> 1)), off = (j >= 2 && (j & 1)) ? 16 : 0;
        float acc = 0.f;
#pragma unroll
        for (int d = 0; d < 64; ++d) acc += row[d] * tab[(cj * d + off) & 63];
        WT[(size_t)(1536 + g * 64 + j) * D + k] = (bf16_t)(cvt_pk_bf16(acc, 0.f) & 0xffffu);
    }
}
__device__ __forceinline__ void x_row_init(const float* xrow, bf16_t* orow, float* rs, int lane) {
    const f32x4* xr = (const f32x4*)xrow + lane;
    f32x4 v[4]; float s = 0.f;
#pragma unroll
    for (int j = 0; j < 4; ++j) { v[j] = xr[64 * j]; s += (v[j].x * v[j].x + v[j].y * v[j].y) + (v[j].z * v[j].z + v[j].w * v[j].w); }
    const float rstd = rsqrtf(wave_sum(s) * (1.f / D) + EPS);
    u32x2* o8 = (u32x2*)orow + lane;
#pragma unroll
    for (int j = 0; j < 4; ++j) { u32x2 w; w.x = cvt_pk_bf16(v[j].x, v[j].y); w.y = cvt_pk_bf16(v[j].z, v[j].w); o8[64 * j] = w; }
    if (lane == 0) *rs = rstd;
}

template <int NR>
__device__ __forceinline__ void row_pass_rows(bf16_t* X, const bf16_t* MF, const float* gain, float* rs, float* outf, bool unscaled, int t0, int lane) {
    u32x4 xa[NR][2], ma[NR][2];
#pragma unroll
    for (int r = 0; r < NR; ++r) { const u32x4* xr = (const u32x4*)(X + (size_t)(t0 + r) * D); const u32x4* mr = (const u32x4*)(MF + (size_t)(t0 + r) * D);
        xa[r][0] = xr[lane]; xa[r][1] = xr[64 + lane]; ma[r][0] = mr[lane]; ma[r][1] = mr[64 + lane]; }
    float g[16];
    { const f32x4* g0 = (const f32x4*)(gain + lane * 8); const f32x4* g1 = (const f32x4*)(gain + 512 + lane * 8);
#pragma unroll
      for (int h = 0; h < 2; ++h) { const f32x4 a = g0[h], b = g1[h];
#pragma unroll
        for (int k = 0; k < 4; ++k) { g[4 * h + k] = a[k]; g[8 + 4 * h + k] = b[k]; } } }
#pragma unroll
    for (int r = 0; r < NR; ++r) {
        float x[16], m[16];
#pragma unroll
        for (int h = 0; h < 2; ++h) { const u32x4 xq = xa[r][h], mq = ma[r][h];
            x[8 * h + 0] = bf_lo(xq.x); x[8 * h + 1] = bf_hi(xq.x); x[8 * h + 2] = bf_lo(xq.y); x[8 * h + 3] = bf_hi(xq.y); x[8 * h + 4] = bf_lo(xq.z); x[8 * h + 5] = bf_hi(xq.z); x[8 * h + 6] = bf_lo(xq.w); x[8 * h + 7] = bf_hi(xq.w);
            m[8 * h + 0] = bf_lo(mq.x); m[8 * h + 1] = bf_hi(mq.x); m[8 * h + 2] = bf_lo(mq.y); m[8 * h + 3] = bf_hi(mq.y); m[8 * h + 4] = bf_lo(mq.z); m[8 * h + 5] = bf_hi(mq.z); m[8 * h + 6] = bf_lo(mq.w); m[8 * h + 7] = bf_hi(mq.w); }
        float sm = 0.f;
#pragma unroll
        for (int k = 0; k < 16; ++k) sm += m[k] * m[k];
        float eps_eff = EPS; if (unscaled) { const float rr = rs[t0 + r], r2 = rr * rr; eps_eff = EPS / (r2 * r2); }
        const float rm = rsqrtf(wave_sum(sm) * (1.f / D) + eps_eff);
        float s1 = 0.f;
#pragma unroll
        for (int k = 0; k < 16; ++k) { x[k] = x[k] + m[k] * rm * g[k]; s1 += x[k] * x[k]; }
        if (outf) {
            f32x4* o = (f32x4*)(outf + (size_t)(t0 + r) * D);
            o[lane * 2] = (f32x4){x[0], x[1], x[2], x[3]}; o[lane * 2 + 1] = (f32x4){x[4], x[5], x[6], x[7]};
            o[128 + lane * 2] = (f32x4){x[8], x[9], x[10], x[11]}; o[128 + lane * 2 + 1] = (f32x4){x[12], x[13], x[14], x[15]};
        } else {
            const float r1 = rsqrtf(wave_sum(s1) * (1.f / D) + EPS);
            u32x4* xo = (u32x4*)(X + (size_t)(t0 + r) * D);
            u32x4 w0, w1;
            w0.x = cvt_pk_bf16(x[0], x[1]); w0.y = cvt_pk_bf16(x[2], x[3]); w0.z = cvt_pk_bf16(x[4], x[5]); w0.w = cvt_pk_bf16(x[6], x[7]);
            w1.x = cvt_pk_bf16(x[8], x[9]); w1.y = cvt_pk_bf16(x[10], x[11]); w1.z = cvt_pk_bf16(x[12], x[13]); w1.w = cvt_pk_bf16(x[14], x[15]);
            xo[lane] = w0; xo[64 + lane] = w1;
            if (lane == 0) rs[t0 + r] = r1;
        }
    }
}

__device__ __forceinline__ void conv_wave_item(const bf16_t* p, const float* cw, bf16_t* Hm, int t0, int pos0, int S, int lane) {
    float w0[8], w1[8], w2[8];
    { const f32x4* a = (const f32x4*)(cw + lane * 8); const f32x4* b = (const f32x4*)(cw + 512 + lane * 8); const f32x4* c = (const f32x4*)(cw + 1024 + lane * 8);
#pragma unroll
      for (int h = 0; h < 2; ++h) { const f32x4 va = a[h], vb = b[h], vc = c[h];
#pragma unroll
        for (int k = 0; k < 4; ++k) { w0[4 * h + k] = va[k]; w1[4 * h + k] = vb[k]; w2[4 * h + k] = vc[k]; } } }
    float zp[8], zc[8], zn[8], gb[8];
    const bf16_t* base = p + (size_t)t0 * PLD + lane * 8;
    if (pos0 == 0) {
#pragma unroll
        for (int k = 0; k < 8; ++k) zp[k] = 0.f;
    } else load8(base - PLD + 512, zp);
    load8(base + 512, zc);
#pragma unroll 4
    for (int i = 0; i < 16; ++i) {
        const bf16_t* r = base + (size_t)i * PLD;
        if (pos0 + i + 1 == S) {
#pragma unroll
            for (int k = 0; k < 8; ++k) zn[k] = 0.f;
        } else load8(r + PLD + 512, zn);
        load8(r, gb);
        float y[8], ss = 0.f;
#pragma unroll
        for (int k = 0; k < 8; ++k) { y[k] = gb[k] * (zp[k] * w0[k] + zc[k] * w1[k] + zn[k] * w2[k]); ss += y[k] * y[k]; }
        ss += __shfl_xor(ss, 1); ss += __shfl_xor(ss, 2); ss += __shfl_xor(ss, 4);
        const float rs = rsqrtf(ss * (1.f / 64.f) + EPS);
        u32x4 o; o.x = cvt_pk_bf16(y[0] * rs, y[1] * rs); o.y = cvt_pk_bf16(y[2] * rs, y[3] * rs); o.z = cvt_pk_bf16(y[4] * rs, y[5] * rs); o.w = cvt_pk_bf16(y[6] * rs, y[7] * rs);
        *(u32x4*)(Hm + (size_t)(t0 + i) * D + lane * 8) = o;
#pragma unroll
        for (int k = 0; k < 8; ++k) { zp[k] = zc[k]; zc[k] = zn[k]; }
    }
}

constexpr int XSTR = 272;
constexpr int RSTR = 34;
constexpr int LDS_XT = 0, LDS_R = 36864, LDS_OST = 106496;
#define LBAR() do { asm volatile("s_waitcnt lgkmcnt(0)" ::: "memory"); __builtin_amdgcn_s_barrier(); asm volatile("" ::: "memory"); } while (0)
__device__ __forceinline__ int seq_base(int bs) { return bs < BP ? bs * SP : TP + (bs - BP) * SS; }

__device__ __forceinline__ void dft_frags(bf16x8 (&Br)[4], bf16x8 (&Bi)[4], int log2n, int kt, int lane) {
    const int N = 1 << log2n, k = 16 * kt + (lane & 15); const float sc = 2.f / (float)N;
#pragma unroll
    for (int ks = 0; ks < 4; ++ks) { u32x4 wr, wi;
#pragma unroll
        for (int e2 = 0; e2 < 4; ++e2) { float c0, s0, c1, s1; const int n0 = 32 * ks + 8 * (lane >> 4) + 2 * e2;
            sincospif(-(float)((n0 * k) & (N - 1)) * sc, &s0, &c0); sincospif(-(float)(((n0 + 1) * k) & (N - 1)) * sc, &s1, &c1);
            wr[e2] = cvt_pk_bf16(c0, c1); wi[e2] = cvt_pk_bf16(s0, s1); }
        Br[ks] = __builtin_bit_cast(bf16x8, wr); Bi[ks] = __builtin_bit_cast(bf16x8, wi); }
}
__device__ __forceinline__ void xt_write(LAS unsigned char* xt, int rp, int ch, const u32x4 va, const u32x4 vb) {
    LAS unsigned char* base = xt + (8 * ch) * XSTR + ((((rp >> 2) ^ ch) << 4) + (rp & 3) * 4);
#pragma unroll
    for (int e2 = 0; e2 < 4; ++e2) {
        *(LAS unsigned*)(base + (2 * e2) * XSTR) = (va[e2] & 0xffffu) | (vb[e2] << 16);
        *(LAS unsigned*)(base + (2 * e2 + 1) * XSTR) = (va[e2] >> 16) | (vb[e2] & 0xffff0000u); }
}
__device__ __forceinline__ void dft_mfma(const LAS unsigned char* xt, int log2n, const bf16x8 (&Br)[4], const bf16x8 (&Bi)[4], f32x4 (&Pa)[4], f32x4 (&Qa)[4], int lane) {
#pragma unroll
    for (int it = 0; it < 4; ++it) { Pa[it] = (f32x4){0.f, 0.f, 0.f, 0.f}; Qa[it] = (f32x4){0.f, 0.f, 0.f, 0.f}; }
#pragma unroll
    for (int ks = 0; ks < 4; ++ks) if (ks < (1 << (log2n - 5))) {
#pragma unroll
        for (int it = 0; it < 4; ++it) { const int col = 16 * it + (lane & 15), gr = 4 * ks + (lane >> 4);
            const bf16x8 a = *(const LAS bf16x8*)(xt + col * XSTR + ((gr ^ (col >> 3)) << 4));
            Pa[it] = __builtin_amdgcn_mfma_f32_16x16x32_bf16(a, Br[ks], Pa[it], 0, 0, 0);
            Qa[it] = __builtin_amdgcn_mfma_f32_16x16x32_bf16(a, Bi[ks], Qa[it], 0, 0, 0); } }
}

__device__ __forceinline__ void p1_decode(int item, int& bs, int& g, int& n2, int& S, int& log2N2) {
    if (item < 2048) { bs = item >> 10; const int r = item & 1023; n2 = r >> 3; g = r & 7; S = SP; log2N2 = 7; }
    else { const int it = item - 2048; bs = BP + (it >> 9); const int r = it & 511; n2 = r >> 3; g = r & 7; S = SS; log2N2 = 6; }
}
__device__ __forceinline__ void p1_load(const bf16_t* p, int item, int rp, int ch, u32x4& va, u32x4& vb) {
    int bs, g, n2, S, l2; p1_decode(item, bs, g, n2, S, l2);
    const bf16_t* src = p + (size_t)(seq_base(bs) + ((2 * rp) << l2) + n2) * PLD + 1024 + g * 64 + ch * 8;
    va = *(const u32x4*)src; vb = *(const u32x4*)(src + ((size_t)PLD << l2));
}
__device__ __forceinline__ void fft_pass1(const bf16_t* p, bf16_t* inter, LAS unsigned char* lds, int bid, int G, int tid) {
    constexpr int NP1 = 2048 + 4096;
    const int lane = tid & 63, wave = __builtin_amdgcn_readfirstlane(tid >> 6), rp = tid >> 3, ch = tid & 7;
    bf16x8 Br[4], Bi[4]; dft_frags(Br, Bi, 7, wave, lane);
    u32x4 va, vb;
    if (bid < NP1) p1_load(p, bid, rp, ch, va, vb);
    int par = 0;
    for (int item = bid; item < NP1; item += G, par ^= 1) {
        LAS unsigned char* xt = lds + LDS_XT + par * (64 * XSTR);
        xt_write(xt, rp, ch, va, vb);
        if (item + G < NP1) p1_load(p, item + G, rp, ch, va, vb);
        LBAR();
        f32x4 Pa[4], Qa[4]; dft_mfma(xt, 7, Br, Bi, Pa, Qa, lane);
        int bs, g, n2, S, l2; p1_decode(item, bs, g, n2, S, l2);
        const int k1 = 16 * wave + (lane & 15), quad = lane >> 4;
        float sn, cs; sincospif(-2.0f * (float)(n2 * k1) / (float)S, &sn, &cs);
        bf16_t* dst = inter + ((size_t)seq_base(bs) * 8 + (size_t)g * S + ((size_t)k1 << l2) + n2) * 64 + 4 * quad;
#pragma unroll
        for (int it = 0; it < 4; ++it) {
            const float r0 = Pa[it][0] - Qa[it][1], i0 = Pa[it][1] + Qa[it][0], r1 = Pa[it][2] - Qa[it][3], i1 = Pa[it][3] + Qa[it][2];
            u32x2 w; w.x = cvt_pk_bf16(r0 * cs - i0 * sn, r0 * sn + i0 * cs); w.y = cvt_pk_bf16(r1 * cs - i1 * sn, r1 * sn + i1 * cs);
            *(u32x2*)(dst + 16 * it) = w; }
    }
    LBAR();
}

__device__ __forceinline__ void p2_decode(int item, int& bs, int& g, int& k1a, int& k1b, int& ip) {
    int r;
    if (item < 1024) { bs = item >> 9; r = item & 511; } else { const int it = item - 1024; bs = BP + (it >> 9); r = it & 511; }
    g = r >> 6; ip = r & 63; k1a = ip; k1b = ip == 0 ? 64 : 128 - ip;
}
template <int LOG2N>
__device__ __forceinline__ void fft_pass2(const bf16_t* inter, bf16_t* Hm, LAS unsigned char* lds, int item0, int item_end, int G, int tid) {
    constexpr int N2 = 1 << LOG2N, NTASK = N2 / 64, S = (LOG2N == 7) ? SP : SS;
    const int lane = tid & 63, wave = __builtin_amdgcn_readfirstlane(tid >> 6);
    bf16x8 Br[4], Bi[4]; dft_frags(Br, Bi, LOG2N, LOG2N == 7 ? wave : (wave & 3), lane);
    u32x4 va[NTASK], vb[NTASK];
#define P2_LOAD(item_) do { int bs_, g_, ka_, kb_, ip_; p2_decode(item_, bs_, g_, ka_, kb_, ip_); \
        const bf16_t* ib_ = inter + ((size_t)seq_base(bs_) * 8 + (size_t)g_ * S) * 64; \
        _Pragma("unroll") for (int j = 0; j < NTASK; ++j) { const int q = tid + NTHREADS * j, h = q / (4 * N2), r = q % (4 * N2), rp = r >> 3, ch = r & 7; \
            const bf16_t* src = ib_ + ((size_t)((h ? kb_ : ka_) * N2 + 2 * rp)) * 64 + ch * 8; va[j] = *(const u32x4*)src; vb[j] = *(const u32x4*)(src + 64); } } while (0)
    if (item0 < item_end) P2_LOAD(item0);
    LAS f32x2* R = (LAS f32x2*)(lds + LDS_R);
    LAS bf16_t* Ost = (LAS bf16_t*)(lds + LDS_OST);
    const float sc = rsqrtf((float)S);
    for (int item = item0; item < item_end; item += G) {
#pragma unroll
        for (int j = 0; j < NTASK; ++j) { const int q = tid + NTHREADS * j, h = q / (4 * N2), r = q % (4 * N2);
            xt_write(lds + LDS_XT + h * (64 * XSTR), r >> 3, r & 7, va[j], vb[j]); }
        if (item + G < item_end) P2_LOAD(item + G);
        LBAR();
        {
            f32x4 Pa[4], Qa[4]; const int quad = lane >> 4;
#pragma unroll
            for (int hh = 0; hh < (LOG2N == 7 ? 2 : 1); ++hh) {
                const int h = (LOG2N == 7) ? hh : (wave >> 2), kt = (LOG2N == 7) ? wave : (wave & 3);
                dft_mfma(lds + LDS_XT + h * (64 * XSTR), LOG2N, Br, Bi, Pa, Qa, lane);
                LAS f32x2* Rr = R + (h * N2 + 16 * kt + (lane & 15)) * RSTR + 2 * quad;
#pragma unroll
                for (int it = 0; it < 4; ++it)
                    *(LAS f32x4*)(Rr + 8 * it) = (f32x4){Pa[it][0] - Qa[it][1], Pa[it][1] + Qa[it][0], Pa[it][2] - Qa[it][3], Pa[it][3] + Qa[it][2]};
            }
        }
        LBAR();
        int bs, g, k1a, k1b, ip; p2_decode(item, bs, g, k1a, k1b, ip);
        const int tb = seq_base(bs);
        for (int idx = tid; idx < 2 * N2 * 32; idx += NTHREADS) {
            const int c = idx & 31, tl = idx >> 5, h = tl >> LOG2N, k2 = tl & (N2 - 1);
            const int ph = (ip == 0) ? h : 1 - h;
            const int k2p = (ip == 0 && h == 0) ? ((N2 - k2) & (N2 - 1)) : (N2 - 1 - k2);
            const f32x2 own = R[(h * N2 + k2) * RSTR + c], par = R[(ph * N2 + k2p) * RSTR + c];
            float v1 = (c == 0) ? 0.5f * (own.x + par.x) : own.x, v2 = (c == 0) ? 0.5f * (own.y + par.y) : par.x;
            v1 *= sc; v2 *= sc;
            float ss = v1 * v1 + v2 * v2;
            ss += __shfl_xor(ss, 1); ss += __shfl_xor(ss, 2); ss += __shfl_xor(ss, 4); ss += __shfl_xor(ss, 8); ss += __shfl_xor(ss, 16);
            const float rs = rsqrtf(ss * (1.f / 64.f) + EPS);
            Ost[tl * 64 + c] = (bf16_t)(cvt_pk_bf16(v1 * rs, 0.f) & 0xffffu);
            Ost[tl * 64 + (c == 0 ? 32 : 64 - c)] = (bf16_t)(cvt_pk_bf16(v2 * rs, 0.f) & 0xffffu);
        }
        LBAR();
        for (int idx = tid; idx < 2 * N2 * 8; idx += NTHREADS) {
            const int tl = idx >> 3, ch = idx & 7, h = tl >> LOG2N, k2 = tl & (N2 - 1);
            const int tok = tb + (h ? k1b : k1a) + 128 * k2;
            *(u32x4*)(Hm + (size_t)tok * D + 512 + g * 64 + ch * 8) = ((const LAS u32x4*)Ost)[idx];
        }
    }
    LBAR();
#undef P2_LOAD
}

#define XB_TMO      128
#define XB_XCNT(j)  (256  + 64 * (j))
#define XB_XSUB(j)  (1280 + 64 * (j))
#define XB_XGEN(j)  (2304 + 64 * (j))
#define XB_TOP      3328
#define XB_TOPGEN   3392
#define XCD_BAR_WORDS 3456
#define XB_SPIN_CAP (1u << 20)
__device__ __forceinline__ unsigned xb_ld(unsigned* p)              { return __hip_atomic_load(p, __ATOMIC_RELAXED, __HIP_MEMORY_SCOPE_AGENT); }
__device__ __forceinline__ unsigned xb_add(unsigned* p, unsigned v) { return __hip_atomic_fetch_add(p, v, __ATOMIC_RELAXED, __HIP_MEMORY_SCOPE_AGENT); }
__device__ __forceinline__ unsigned xb_xcc_id() { return (unsigned)__builtin_amdgcn_s_getreg((3 << 11) | 20) & 0xFu; }
#define XB_SPIN(cond, bar) do { unsigned _sp = 0; while (cond) { __builtin_amdgcn_s_sleep(1); \
    if ((++_sp & 255u) == 0u) { if (xb_ld(&(bar)[XB_TMO])) break; if (_sp > XB_SPIN_CAP) { atomicAdd(&(bar)[XB_TMO], 1u); break; } } } } while (0)
struct XcdBarrier { unsigned* bar; unsigned x; volatile LAS unsigned* st; };
__device__ __forceinline__ XcdBarrier xcd_barrier_post(unsigned* bar, volatile LAS unsigned* st) {
    XcdBarrier b; b.bar = bar; b.x = xb_xcc_id(); b.st = st;
    if (threadIdx.x == 0) (void)xb_add(&bar[XB_XCNT(b.x)], 1u);
    return b;
}
__device__ __forceinline__ void xcd_barrier_complete(unsigned* bar, unsigned x, unsigned& nloc, unsigned& nx) {
    const unsigned G = gridDim.x * gridDim.y * gridDim.z;
    unsigned sum, cnt, mine, sp = 0u;
    for (;;) {
        sum = 0u; cnt = 0u; mine = 0u;
#pragma unroll
        for (unsigned j = 0; j < 16; ++j) { const unsigned c = xb_ld(&bar[XB_XCNT(j)]); sum += c; cnt += (c > 0u) ? 1u : 0u; mine = (j == x) ? c : mine; }
        if (sum == G) break;
        __builtin_amdgcn_s_sleep(1);
        if ((++sp & 255u) == 0u) { if (xb_ld(&bar[XB_TMO])) break; if (sp > XB_SPIN_CAP) { atomicAdd(&bar[XB_TMO], 1u); break; } }
    }
    nloc = mine > 0u ? mine : 1u; nx = cnt > 0u ? cnt : 1u;
}
__device__ __forceinline__ void xcd_barrier(const XcdBarrier& b) {
    asm volatile("s_waitcnt vmcnt(0)" ::: "memory");
    __syncthreads();
    if (threadIdx.x == 0) {
        unsigned* bar = b.bar;
        __builtin_amdgcn_s_waitcnt(0);
        unsigned nloc = b.st[0], nx = b.st[1];
        if (nloc == 0u) { xcd_barrier_complete(bar, b.x, nloc, nx); b.st[0] = nloc; b.st[1] = nx; }
        const unsigned old = xb_add(&bar[XB_XSUB(b.x)], 1u);
        const unsigned gen = old / nloc;
        if (old + 1u == (gen + 1u) * nloc) {
            __builtin_amdgcn_fence(__ATOMIC_RELEASE, "agent");
            asm volatile("s_waitcnt vmcnt(0)" ::: "memory");
            const unsigned og = xb_add(&bar[XB_TOP], 1u);
            const unsigned tg = og / nx;
            if (og + 1u == (tg + 1u) * nx) xb_add(&bar[XB_TOPGEN], 1u);
            else XB_SPIN(xb_ld(&bar[XB_TOPGEN]) == tg, bar);
            __builtin_amdgcn_fence(__ATOMIC_ACQUIRE, "agent");
            xb_add(&bar[XB_XGEN(b.x)], 1u);
            asm volatile("s_waitcnt vmcnt(0)" ::: "memory");
        } else {
            XB_SPIN(xb_ld(&bar[XB_XGEN(b.x)]) == gen, bar);
            __builtin_amdgcn_fence(__ATOMIC_ACQUIRE, "agent");
            asm volatile("s_waitcnt vmcnt(0)" ::: "memory");
        }
    }
    __syncthreads();
}

__global__ void __launch_bounds__(NTHREADS, 2) fwd_megakernel(Params P) {
    extern __shared__ __attribute__((aligned(16))) unsigned char shm[];
    cg::grid_group grid = cg::this_grid();
    LAS unsigned char* lds = (LAS unsigned char*)shm;
    const int G = gridDim.x, bid = blockIdx.x, NGW = G * NWAVES;
#define FRESH() int tid = threadIdx.x; asm volatile("" : "+v"(tid)); const int lane = tid & 63, wave = __builtin_amdgcn_readfirstlane(tid >> 6), gw = bid * NWAVES + wave; (void)lane; (void)gw
#define TAB ((LAS float*)(lds + LDS_MISC))
    { FRESH();
      if (tid < 64) TAB[tid] = cospif((float)tid * (1.f / 32.f));
      if (tid < 4) ((volatile LAS unsigned*)(lds + LDS_MISC + 1024))[tid] = 0u; }
    __syncthreads();
    const XcdBarrier xbar = xcd_barrier_post((unsigned*)P.ws, (volatile LAS unsigned*)(lds + LDS_MISC + 1024));
#define GSYNC() xcd_barrier(xbar)

    unsigned char* ws = P.ws;
#define Xb ((bf16_t*)(ws + WS_X))
#define Hb ((bf16_t*)(ws + WS_H))
#define Pb ((bf16_t*)P.out)
#define Ib ((bf16_t*)(ws + WS_INTER))
#define MFb ((bf16_t*)(ws + WS_MF))
#define A0b ((bf16_t*)(ws + WS_H))
#define A1b ((bf16_t*)P.out)
#define RSb ((float*)(ws + WS_RS))

    {
        FRESH();
        LAS float* scr = (LAS float*)(lds + wave * 8704);
        constexpr int I_IN = 16 * 48, I_OUT = 16 * 32, I_UP = 16 * 128, I_DN = 64 * 32, I_F = 128, I_L = I_IN + I_OUT + I_UP + I_DN + I_F;
        for (int it = gw; it < NL * I_L; it += NGW) {
            const int l = it / I_L; int r = it % I_L;
            bf16_t* Wl = (bf16_t*)(ws + WS_W + (size_t)l * WL_SZ);
            const float* win = P.w_in + (size_t)l * D * DIN;
            if (r < I_IN) { p0_transpose_item<true>(win, D, DIN, 48, Wl + WL_IN / 2, P.g_mix_pre + l * D, scr, r, lane); continue; } r -= I_IN;
            if (r < I_OUT) {
                const int kb = r / 32; const float* gsrc = kb < 8 ? P.g_conv_out + l * 512 : P.g_fourier_out + l * 512 - 512;
                p0_transpose_item(P.w_out + (size_t)l * D * D, D, D, 32, Wl + WL_OUT / 2, gsrc, scr, r, lane); continue; } r -= I_OUT;
            if (r < I_UP) { p0_transpose_item(P.w_up + (size_t)l * D * DFF, D, DFF, 128, Wl + WL_UP / 2, P.g_mlp_pre + l * D, scr, r, lane); continue; } r -= I_UP;
            if (r < I_DN) { p0_transpose_item(P.w_down + (size_t)l * DFF * D, DFF, D, 32, Wl + WL_DN / 2, nullptr, scr, r, lane); continue; } r -= I_DN;
            p0_fold_item(win, P.g_mix_pre + l * D, Wl + WL_IN / 2, TAB, r, lane);
        }
        for (int t = gw; t < T; t += NGW) x_row_init(t < TP ? P.xp + (size_t)t * D : P.xs + (size_t)(t - TP) * D, Xb + (size_t)t * D, RSb + t, lane);
    }
    grid.sync();

    for (int l = 0; l < NL; ++l) {
        const bf16_t* Wl = (const bf16_t*)(ws + WS_W + (size_t)l * WL_SZ);
        { pg8::Gemm g{Xb, Wl + WL_IN / 2, T, DIN, D, nullptr, 1 << 20}; pg8::StaticOrder S; S.init(T, DIN, G, bid); pg8::EpiInProj E{Pb, RSb};
          pg8::gemm_phase(lds, g, S, E); }
        GSYNC();
        {
            FRESH();
            constexpr int NCONV = T / 128;
            for (int it = bid; it < NCONV; it += G) { const int t0 = it * 128 + wave * 16; const int S = t0 < TP ? SP : SS; const int pos0 = t0 < TP ? (t0 & (SP - 1)) : ((t0 - TP) & (SS - 1));
                conv_wave_item(Pb, P.conv_w + (size_t)l * 3 * 512, Hb, t0, pos0, S, lane); }
            fft_pass1(Pb, Ib, lds, bid, G, tid);
        }
        GSYNC();
        { FRESH(); fft_pass2<7>(Ib, Hb, lds, bid, 1024, G, tid); }
        { FRESH(); fft_pass2<6>(Ib, Hb, lds, 1024 + bid, 1024 + 4096, G, tid); }
        GSYNC();
        { pg8::Gemm g{Hb, Wl + WL_OUT / 2, T, D, D, nullptr, 1 << 20}; pg8::StaticOrder S; S.init(T, D, G, bid); pg8::EpiBf16 E{MFb, D, 0, nullptr, nullptr, 1 << 20};
          pg8::gemm_phase(lds, g, S, E); }
        GSYNC();
        { FRESH();
          for (int t = gw * 4; t < T; t += NGW * 4) row_pass_rows<4>(Xb, MFb, P.g_mix_post + l * D, RSb, nullptr, false, t, lane); }
        GSYNC();
        { pg8::Gemm g{Xb, Wl + WL_UP / 2, T, DFF, D, nullptr, 1 << 20}; pg8::StaticOrder S; S.init(T, DFF, G, bid); pg8::EpiBf16 E{A0b, DFF, 1, nullptr, A1b, TCH / 256};
          pg8::gemm_phase(lds, g, S, E); }
        GSYNC();
        { pg8::Gemm g{A0b, Wl + WL_DN / 2, T, D, DFF, A1b, TCH / 256}; pg8::StaticOrder S; S.init(T, D, G, bid); pg8::EpiBf16 E{MFb, D, 0, nullptr, nullptr, 1 << 20};
          pg8::gemm_phase(lds, g, S, E); }
        GSYNC();
        { FRESH();
          float* outf = (l + 1 < NL) ? nullptr : P.out;
          for (int t = gw * 4; t < T; t += NGW * 4) row_pass_rows<4>(Xb, MFb, P.g_mlp_post + l * D, RSb, outf, true, t, lane); }
        if (l + 1 < NL) GSYNC();
    }
}

extern "C" void kernel_launch(void* const* d_in, const int* in_sizes, int n_in, void* d_out, int out_size, void* d_ws, size_t ws_size, hipStream_t stream) {
    static int grid_blocks = 0;
    if (grid_blocks == 0) {
        if (n_in != 13 || out_size != T * D || ws_size < WS_END) { fprintf(stderr, "kernel_launch: unexpected shapes (n_in %d, out %d, ws %zu, need %zu)\n", n_in, out_size, ws_size, (size_t)WS_END); grid_blocks = -1; return; }
        int dev = 0, cus = 0, per_cu = 0;
        hipGetDevice(&dev);
        hipDeviceGetAttribute(&cus, hipDeviceAttributeMultiprocessorCount, dev);
        if (hipFuncSetAttribute((const void*)fwd_megakernel, hipFuncAttributeMaxDynamicSharedMemorySize, LDS_BYTES) != hipSuccess) { fprintf(stderr, "kernel_launch: hipFuncSetAttribute failed\n"); grid_blocks = -1; return; }
        hipOccupancyMaxActiveBlocksPerMultiprocessor(&per_cu, (const void*)fwd_megakernel, NTHREADS, LDS_BYTES);
        if (per_cu < 1) { fprintf(stderr, "kernel_launch: occupancy query says %d blocks per CU\n", per_cu); per_cu = 1; }
        grid_blocks = cus * per_cu;
    }
    if (grid_blocks < 0) return;
    Params p{};
    p.xp = (const float*)d_in[0]; p.xs = (const float*)d_in[1]; p.g_mix_pre = (const float*)d_in[2]; p.w_in = (const float*)d_in[3]; p.conv_w = (const float*)d_in[4];
    p.g_conv_out = (const float*)d_in[5]; p.g_fourier_out = (const float*)d_in[6]; p.w_out = (const float*)d_in[7]; p.g_mix_post = (const float*)d_in[8];
    p.g_mlp_pre = (const float*)d_in[9]; p.w_up = (const float*)d_in[10]; p.w_down = (const float*)d_in[11]; p.g_mlp_post = (const float*)d_in[12];
    p.out = (float*)d_out; p.ws = (unsigned char*)d_ws;
    if (hipMemsetAsync(d_ws, 0, 16384, stream) != hipSuccess) { fprintf(stderr, "kernel_launch: memset failed\n"); return; }
    void* args[] = {&p};
    hipError_t e = hipLaunchCooperativeKernel((const void*)fwd_megakernel, dim3(grid_blocks), dim3(NTHREADS), args, LDS_BYTES, stream);
    if (e != hipSuccess) fprintf(stderr, "cooperative launch failed: %s (grid %d)\n", hipGetErrorString(e), grid_blocks);
}
```

```cpp
#include <hip/hip_runtime.h>
#include <hip/hip_cooperative_groups.h>
#include <cstdio>
namespace cg = cooperative_groups;

#define LAS __attribute__((address_space(3)))
typedef unsigned short bf16_t;
typedef short bf16x8 __attribute__((ext_vector_type(8)));
typedef float f32x4 __attribute__((ext_vector_type(4)));
typedef float f32x2 __attribute__((ext_vector_type(2)));
typedef unsigned u32x4 __attribute__((ext_vector_type(4)));
typedef unsigned u32x2 __attribute__((ext_vector_type(2)));

constexpr int D = 1024, DIN = 2048, DFF = 4096, NL = 4;
constexpr int PLD = 1536;
constexpr int SP = 16384, BP = 2, SS = 8192, BS = 8;
constexpr int TP = BP * SP, TS = BS * SS, T = TP + TS;
constexpr float EPS = 1e-6f;
constexpr int NCH = 2;
constexpr int TCH = T / NCH;

constexpr size_t MiB = (size_t)1 << 20;
constexpr size_t WS_W = 1 * MiB;
constexpr size_t WL_IN = 0, WL_OUT = 4 * MiB, WL_UP = 6 * MiB, WL_DN = 14 * MiB, WL_SZ = 22 * MiB;
constexpr size_t WS_X = WS_W + NL * WL_SZ;
constexpr size_t WS_H = WS_X + (size_t)T * D * 2;
constexpr size_t WS_INTER = WS_H + (size_t)T * D * 2;
constexpr size_t WS_MF = WS_INTER + (size_t)T * 256 * 8;
constexpr size_t WS_RS = WS_MF + (size_t)T * D * 2;
constexpr size_t WS_END = WS_RS + 1 * MiB;

constexpr int LDS_STAGE = 131072, LDS_MISC = 139264, LDS_BYTES = LDS_MISC + 4096;
constexpr int NTHREADS = 512, NWAVES = 8;

struct Params {
    const float* xp; const float* xs; const float* g_mix_pre; const float* w_in; const float* conv_w;
    const float* g_conv_out; const float* g_fourier_out; const float* w_out; const float* g_mix_post;
    const float* g_mlp_pre; const float* w_up; const float* w_down; const float* g_mlp_post;
    float* out; unsigned char* ws;
};

__device__ __forceinline__ unsigned cvt_pk_bf16(float lo, float hi) { unsigned r; asm volatile("v_cvt_pk_bf16_f32 %0, %1, %2" : "=v"(r) : "v"(lo), "v"(hi)); return r; }
__device__ __forceinline__ float bf_lo(unsigned w) { return __uint_as_float(w << 16); }
__device__ __forceinline__ float bf_hi(unsigned w) { return __uint_as_float(w & 0xffff0000u); }
__device__ __forceinline__ float wave_sum(float v) {
#pragma unroll
    for (int o = 1; o < 64; o <<= 1) v += __shfl_xor(v, o);
    return v;
}
__device__ __forceinline__ void load8(const bf16_t* ptr, float (&v)[8]) {
    const u32x4 q = *(const u32x4*)ptr;
    v[0] = bf_lo(q.x); v[1] = bf_hi(q.x); v[2] = bf_lo(q.y); v[3] = bf_hi(q.y); v[4] = bf_lo(q.z); v[5] = bf_hi(q.z); v[6] = bf_lo(q.w); v[7] = bf_hi(q.w);
}

namespace pg8 {
constexpr int BM = 256, BK = 64, HALF = 128, HTB = HALF * BK * 2, STAGE_BYTES = 8 * HTB, NXCD = 8, WGM = 8;
__device__ __forceinline__ int lds_byte(int r, int c) { const int st = (r >> 4) * 2 + (c >> 5), rr = r & 15, cc = c & 31, ob = rr * 64 + cc * 2; return st * 1024 + (ob ^ (((ob >> 9) & 1) << 5)); }
__device__ __forceinline__ void stage_rc(int b, int& R, int& C) { const int st = b / 1024, sb = b % 1024, swz = sb ^ (((sb >> 9) & 1) << 5); R = (st >> 1) * 16 + swz / 64; C = (st & 1) * 32 + (swz % 64) / 2; }
__device__ __forceinline__ int perm32(int rho) { const int n = rho >> 4, i = rho & 15; return 8 * (i >> 2) + 4 * n + (i & 3); }

struct Unit { int pm, pn; };
struct Gemm { const bf16_t* A; const bf16_t* Bt; int M, N, K; const bf16_t* A2; int split; };

struct StaticOrder {
    int nM, nN, nwg, G, c;
    __device__ void init(int M, int N, int G_, int c_) { nM = M / BM; nN = N / BM; nwg = nM * nN; G = G_; c = c_; }
    __device__ bool next(int i, Unit& u) const {
        const long L = (long)i * G + c; if (L >= nwg) return false;
        int wgid = (int)L; { const int q = nwg / NXCD, r = nwg % NXCD, xcd = wgid % NXCD, off = wgid / NXCD; wgid = (xcd < r ? xcd * (q + 1) : r * (q + 1) + (xcd - r) * q) + off; }
        const int nig = WGM * nN, gid = wgid / nig, fm = gid * WGM, gsz = (nM - fm) < WGM ? (nM - fm) : WGM;
        u.pm = fm + ((wgid % nig) % gsz); u.pn = (wgid % nig) / gsz; return true;
    }
};

struct EpiBf16 {
    static constexpr bool FUSED = false;
    bf16_t* O; int ldc; int act; const float* rs; bf16_t* O2; int split;
    __device__ __forceinline__ void operator()(const f32x4 (&acc)[2][2][4][2], const Unit& u, int wr, int wc, int fr, int fq) const {
        const bool lo = u.pm < split; bf16_t* Ob = lo ? O : O2;
        const int grow0 = u.pm * BM + wr * 64 + fr, row0 = grow0 - (lo ? 0 : split * BM); const int col0 = u.pn * BM + wc * 32 + 8 * fq;
#pragma unroll
        for (int ai = 0; ai < 2; ++ai)
#pragma unroll
            for (int m = 0; m < 4; ++m) { bf16_t* rowp = Ob + (size_t)(row0 + ai * HALF + m * 16) * ldc + col0; const float sc = rs ? rs[grow0 + ai * HALF + m * 16] : 1.f;
#pragma unroll
                for (int bj = 0; bj < 2; ++bj) { f32x4 v0 = acc[ai][bj][m][0] * sc, v1 = acc[ai][bj][m][1] * sc;
                    if (act) {
#pragma unroll
                        for (int j = 0; j < 4; ++j) { const float a0 = fmaxf(v0[j], 0.f), a1 = fmaxf(v1[j], 0.f); v0[j] = a0 * a0; v1[j] = a1 * a1; } }
                    u32x4 w; w.x = cvt_pk_bf16(v0[0], v0[1]); w.y = cvt_pk_bf16(v0[2], v0[3]); w.z = cvt_pk_bf16(v1[0], v1[1]); w.w = cvt_pk_bf16(v1[2], v1[3]);
                    *(u32x4*)(rowp + bj * HALF) = w; } }
    }
};


struct EpiInProj {
    static constexpr bool FUSED = false;
    bf16_t* O; const float* rs;
    __device__ __forceinline__ void operator()(const f32x4 (&acc)[2][2][4][2], const Unit& u, int wr, int wc, int fr, int fq) const {
        const int row0 = u.pm * BM + wr * 64 + fr, sub = wc * 32 + 8 * fq;
        const bool isz = (u.pn >= 2 && u.pn < 6);
        const int cbase = isz ? 512 + (u.pn - 2) * 128 + sub : (u.pn < 2 ? u.pn * BM + sub : 1024 + (u.pn - 6) * BM + sub);
#pragma unroll
        for (int ai = 0; ai < 2; ++ai)
#pragma unroll
            for (int m = 0; m < 4; ++m) { const int row = row0 + ai * HALF + m * 16; bf16_t* rowp = O + (size_t)row * PLD + cbase; const float sc = rs[row];
                if (isz) { const float s2 = sc * sc; const f32x4 z0 = acc[ai][0][m][0] * acc[ai][1][m][0] * s2, z1 = acc[ai][0][m][1] * acc[ai][1][m][1] * s2;
                    u32x4 w; w.x = cvt_pk_bf16(z0[0], z0[1]); w.y = cvt_pk_bf16(z0[2], z0[3]); w.z = cvt_pk_bf16(z1[0], z1[1]); w.w = cvt_pk_bf16(z1[2], z1[3]);
                    *(u32x4*)rowp = w; }
                else {
#pragma unroll
                    for (int bj = 0; bj < 2; ++bj) { const f32x4 v0 = acc[ai][bj][m][0] * sc, v1 = acc[ai][bj][m][1] * sc;
                        u32x4 w; w.x = cvt_pk_bf16(v0[0], v0[1]); w.y = cvt_pk_bf16(v0[2], v0[3]); w.z = cvt_pk_bf16(v1[0], v1[1]); w.w = cvt_pk_bf16(v1[2], v1[3]);
                        *(u32x4*)(rowp + bj * HALF) = w; } } }
    }
};

template <class Epi, class Sched>
__device__ __forceinline__ void gemm_phase(LAS unsigned char* lds, const Gemm g, const Sched& S, const Epi& E) {
    int tid_ = threadIdx.x; asm volatile("" : "+v"(tid_));
    const int tid = tid_, wid = __builtin_amdgcn_readfirstlane(tid >> 6), lane = tid & 63, wr = wid >> 2, wc = wid & 3, fr = lane & 15, fq = lane >> 4;
    const int K = g.K, nt = K / BK;
    unsigned voffA[2], voffB[2];
#pragma unroll
    for (int i = 0; i < 2; ++i) { int R, C; stage_rc(tid * 16 + i * 8192, R, C); const int Rb = (R & ~31) + perm32(R & 31);
        voffA[i] = (unsigned)(R * K + C) * 2u; voffB[i] = (unsigned)(Rb * K + C) * 2u; }
    const size_t kstep = (size_t)(BK * 2);
    const size_t hstep = (size_t)HALF * K * 2;
    const size_t tstep = 2 * hstep;
    const unsigned ldsw = (unsigned)wid * 1024u;
    const int aoff = lds_byte(wr * 64 + fr, fq * 8), boff = lds_byte(wc * 32 + fr, fq * 8);
#define PG8_SA(b, h) (((b) * 2 + (h)) * HTB)
#define PG8_SB(b, h) ((4 + (b) * 2 + (h)) * HTB)
#define PG8_STAGE(bufoff, gbase, voff) do { _Pragma("unroll") for (int _i = 0; _i < 2; ++_i) \
        __builtin_amdgcn_global_load_lds((const unsigned*)((const char*)(gbase) + (voff)[_i]), (LAS unsigned*)(lds + (bufoff) + ldsw + _i * 8192), 16, 0, 0); } while (0)
#define PG8_LDA(dst, b, h) do { _Pragma("unroll") for (int m = 0; m < 4; ++m) _Pragma("unroll") for (int k = 0; k < 2; ++k) dst[m][k] = *(const LAS bf16x8*)(lds + PG8_SA(b, h) + aoff + m * 2048 + k * 1024); } while (0)
#define PG8_LDB(dst, b, h) do { _Pragma("unroll") for (int n = 0; n < 2; ++n) _Pragma("unroll") for (int k = 0; k < 2; ++k) dst[n][k] = *(const LAS bf16x8*)(lds + PG8_SB(b, h) + boff + n * 2048 + k * 1024); } while (0)
#define PG8_MMA(ai, bj, At, Bt) do { __builtin_amdgcn_s_setprio(1); _Pragma("unroll") for (int m = 0; m < 4; ++m) _Pragma("unroll") for (int n = 0; n < 2; ++n) _Pragma("unroll") for (int k = 0; k < 2; ++k) \
        acc[ai][bj][m][n] = __builtin_amdgcn_mfma_f32_16x16x32_bf16(Bt[n][k], At[m][k], acc[ai][bj][m][n], 0, 0, 0); __builtin_amdgcn_s_setprio(0); } while (0)
#define PG8_WAIT_V(n) asm volatile("s_waitcnt vmcnt(" #n ")" ::: "memory")
#define PG8_WAIT_L(n) asm volatile("s_waitcnt lgkmcnt(" #n ")" ::: "memory")
#define PG8_BAR __builtin_amdgcn_s_barrier()
#define PG8_SCHED __builtin_amdgcn_sched_barrier(0)
    Unit cur, nxt; int ui = 0;
    if (!S.next(0, cur)) return;
    f32x4 acc[2][2][4][2];
#pragma unroll
    for (int a = 0; a < 2; ++a)
#pragma unroll
        for (int b = 0; b < 2; ++b)
#pragma unroll
            for (int m = 0; m < 4; ++m)
#pragma unroll
                for (int n = 0; n < 2; ++n) acc[a][b][m][n] = (f32x4){0.f, 0.f, 0.f, 0.f};
    bf16x8 At[4][2], B0[2][2], B1[2][2];
#define PG8_APANEL(pm_) ((const char*)(((pm_) < g.split ? (unsigned long long)g.A : (unsigned long long)g.A2 - (unsigned long long)g.split * tstep) + (unsigned long long)(pm_) * tstep))
    const char* cA = PG8_APANEL(cur.pm); const char* cB = (const char*)g.Bt + (size_t)cur.pn * tstep;
    PG8_STAGE(PG8_SB(0, 0), cB, voffB); PG8_STAGE(PG8_SA(0, 0), cA, voffA); PG8_STAGE(PG8_SB(0, 1), cB + hstep, voffB); PG8_STAGE(PG8_SA(0, 1), cA + hstep, voffA);
    if (wr == 1) PG8_BAR;
    PG8_WAIT_V(4); PG8_BAR;
    PG8_STAGE(PG8_SB(1, 0), cB + kstep, voffB); PG8_STAGE(PG8_SA(1, 0), cA + kstep, voffA); PG8_STAGE(PG8_SB(1, 1), cB + hstep + kstep, voffB);
    PG8_WAIT_V(6); PG8_BAR;
    for (;;) {
        const bool has_next = S.next(ui + 1, nxt);
        const char* nA = has_next ? PG8_APANEL(nxt.pm) : cA; const char* nB = has_next ? (const char*)g.Bt + (size_t)nxt.pn * tstep : cB;
        for (int t = 0; t < nt; t += 2) {
            const bool last = (t == nt - 2);
            const char* a1 = cA + (size_t)(t + 1) * kstep;
            const char* a2 = last ? nA : cA + (size_t)(t + 2) * kstep; const char* b2 = last ? nB : cB + (size_t)(t + 2) * kstep;
            const char* a3 = a2 + kstep; const char* b3 = b2 + kstep;
            PG8_LDB(B0, 0, 0); PG8_SCHED; PG8_LDA(At, 0, 0); PG8_STAGE(PG8_SA(1, 1), a1 + hstep, voffA);
            PG8_WAIT_L(8); PG8_BAR; PG8_WAIT_L(0); PG8_MMA(0, 0, At, B0); PG8_BAR; PG8_SCHED;
            PG8_LDB(B1, 0, 1); PG8_STAGE(PG8_SB(0, 0), b2, voffB);
            PG8_BAR; PG8_WAIT_L(0); PG8_MMA(0, 1, At, B1); PG8_BAR;
            PG8_LDA(At, 0, 1); PG8_STAGE(PG8_SA(0, 0), a2, voffA);
            PG8_BAR; PG8_WAIT_L(0); PG8_MMA(1, 0, At, B0); PG8_BAR; PG8_SCHED;
            PG8_STAGE(PG8_SB(0, 1), b2 + hstep, voffB);
            PG8_WAIT_V(6); PG8_BAR; PG8_MMA(1, 1, At, B1); PG8_BAR;
            PG8_LDB(B0, 1, 0); PG8_SCHED; PG8_LDA(At, 1, 0); PG8_STAGE(PG8_SA(0, 1), a2 + hstep, voffA);
            PG8_WAIT_L(8); PG8_BAR; PG8_WAIT_L(0); PG8_MMA(0, 0, At, B0); PG8_BAR; PG8_SCHED;
            PG8_LDB(B1, 1, 1); PG8_STAGE(PG8_SB(1, 0), b3, voffB);
            PG8_BAR; PG8_WAIT_L(0); PG8_MMA(0, 1, At, B1); PG8_BAR;
            PG8_LDA(At, 1, 1); PG8_STAGE(PG8_SA(1, 0), a3, voffA);
            PG8_BAR; PG8_WAIT_L(0); PG8_MMA(1, 0, At, B0); PG8_BAR; PG8_SCHED;
            PG8_STAGE(PG8_SB(1, 1), b3 + hstep, voffB);
            PG8_WAIT_V(6); PG8_BAR; PG8_MMA(1, 1, At, B1); PG8_BAR;
        }
        E(acc, cur, wr, wc, fr, fq);
        if (!has_next) break;
#pragma unroll
        for (int a = 0; a < 2; ++a)
#pragma unroll
            for (int b = 0; b < 2; ++b)
#pragma unroll
                for (int m = 0; m < 4; ++m)
#pragma unroll
                    for (int n = 0; n < 2; ++n) acc[a][b][m][n] = (f32x4){0.f, 0.f, 0.f, 0.f};
        cur = nxt; cA = nA; cB = nB; ++ui;
    }
    PG8_WAIT_V(0);
    if (wr == 0) PG8_BAR;
    PG8_BAR;
#undef PG8_APANEL
#undef PG8_SA
#undef PG8_SB
#undef PG8_STAGE
#undef PG8_LDA
#undef PG8_LDB
#undef PG8_MMA
#undef PG8_WAIT_V
#undef PG8_WAIT_L
#undef PG8_BAR
#undef PG8_SCHED
}
}

template <bool INPROJ = false>
__device__ __forceinline__ void p0_transpose_item(const float* W, int K, int ldN, int nblk, bf16_t* WT, const float* gain, LAS float* scr, int item, int lane) {
    const int kb = item / nblk, nb = item % nblk, k0 = 64 * kb, n0 = 32 * nb;
    const int dn0 = !INPROJ || n0 < 512 ? n0 : (n0 < 1024 ? 512 + ((n0 - 512) >> 7) * 256 + ((n0 - 512) & 127) : 512 + ((n0 - 1024) >> 7) * 256 + 128 + ((n0 - 1024) & 127));
    float wv[32];
#pragma unroll
    for (int i = 0; i < 32; ++i) wv[i] = W[(size_t)(k0 + 2 * i + (lane >> 5)) * ldN + n0 + (lane & 31)];
#pragma unroll
    for (int i = 0; i < 32; ++i) { const int kk = 2 * i + (lane >> 5); const float gk = gain ? gain[k0 + kk] : 1.f;
        scr[kk * 33 + (lane & 31)] = wv[i] * gk; }
    asm volatile("s_waitcnt lgkmcnt(0)" ::: "memory");
    const int c = lane & 7;
#pragma unroll
    for (int j = 0; j < 4; ++j) { const int n = (lane >> 3) + 8 * j; const LAS float* s = scr + (8 * c) * 33 + n;
        u32x4 o; o.x = cvt_pk_bf16(s[0 * 33], s[1 * 33]); o.y = cvt_pk_bf16(s[2 * 33], s[3 * 33]); o.z = cvt_pk_bf16(s[4 * 33], s[5 * 33]); o.w = cvt_pk_bf16(s[6 * 33], s[7 * 33]);
        *(u32x4*)(WT + (size_t)(dn0 + n) * K + k0 + 8 * c) = o; }
    asm volatile("s_waitcnt lgkmcnt(0)" ::: "memory");
}
__device__ __forceinline__ void p0_fold_item(const float* Win  , const float* gpre, bf16_t* WT  , const LAS float* tab, int item, int lane) {
    const int kb = item >> 3, g = item & 7, k = kb * 64 + lane;
    const float gk = gpre[k] * 0.125f;
    const f32x4* src = (const f32x4*)(Win + (size_t)k * DIN + 1536 + g * 64);
    float row[64];
#pragma unroll
    for (int i = 0; i < 16; ++i) { const f32x4 v = src[i]; row[4 * i] = v.x * gk; row[4 * i + 1] = v.y * gk; row[4 * i + 2] = v.z * gk; row[4 * i + 3] = v.w * gk; }
    for (int j = 0; j < 64; ++j) {
        const int cj = (j == 0) ? 0 : (j == 1 ? 32 : (j >> 1)), off = (j >= 2 && (j & 1)) ? 16 : 0;
        float acc = 0.f;
#pragma unroll
        for (int d = 0; d < 64; ++d) acc += row[d] * tab[(cj * d + off) & 63];
        WT[(size_t)(1536 + g * 64 + j) * D + k] = (bf16_t)(cvt_pk_bf16(acc, 0.f) & 0xffffu);
    }
}
template <int NR>
__device__ __forceinline__ void x_rows_init(const float* xrow0, bf16_t* orow0, float* rs, int lane) {
    f32x4 v[NR][4];
#pragma unroll
    for (int r = 0; r < NR; ++r) { const f32x4* xr = (const f32x4*)(xrow0 + (size_t)r * D) + lane;
#pragma unroll
        for (int j = 0; j < 4; ++j) v[r][j] = xr[64 * j]; }
#pragma unroll
    for (int r = 0; r < NR; ++r) { float s = 0.f;
#pragma unroll
        for (int j = 0; j < 4; ++j) s += (v[r][j].x * v[r][j].x + v[r][j].y * v[r][j].y) + (v[r][j].z * v[r][j].z + v[r][j].w * v[r][j].w);
        const float rstd = rsqrtf(wave_sum(s) * (1.f / D) + EPS);
        u32x2* o8 = (u32x2*)(orow0 + (size_t)r * D) + lane;
#pragma unroll
        for (int j = 0; j < 4; ++j) { u32x2 w; w.x = cvt_pk_bf16(v[r][j].x, v[r][j].y); w.y = cvt_pk_bf16(v[r][j].z, v[r][j].w); o8[64 * j] = w; }
        if (lane == 0) rs[r] = rstd; }
}

template <int NR>
__device__ __forceinline__ void row_pass_rows(bf16_t* X, const bf16_t* MF, const float* gain, float* rs, float* outf, bool unscaled, int t0, int lane) {
    u32x4 xa[NR][2], ma[NR][2];
#pragma unroll
    for (int r = 0; r < NR; ++r) { const u32x4* xr = (const u32x4*)(X + (size_t)(t0 + r) * D); const u32x4* mr = (const u32x4*)(MF + (size_t)(t0 + r) * D);
        xa[r][0] = xr[lane]; xa[r][1] = xr[64 + lane]; ma[r][0] = mr[lane]; ma[r][1] = mr[64 + lane]; }
    float g[16];
    { const f32x4* g0 = (const f32x4*)(gain + lane * 8); const f32x4* g1 = (const f32x4*)(gain + 512 + lane * 8);
#pragma unroll
      for (int h = 0; h < 2; ++h) { const f32x4 a = g0[h], b = g1[h];
#pragma unroll
        for (int k = 0; k < 4; ++k) { g[4 * h + k] = a[k]; g[8 + 4 * h + k] = b[k]; } } }
#pragma unroll
    for (int r = 0; r < NR; ++r) {
        float x[16], m[16];
#pragma unroll
        for (int h = 0; h < 2; ++h) { const u32x4 xq = xa[r][h], mq = ma[r][h];
            x[8 * h + 0] = bf_lo(xq.x); x[8 * h + 1] = bf_hi(xq.x); x[8 * h + 2] = bf_lo(xq.y); x[8 * h + 3] = bf_hi(xq.y); x[8 * h + 4] = bf_lo(xq.z); x[8 * h + 5] = bf_hi(xq.z); x[8 * h + 6] = bf_lo(xq.w); x[8 * h + 7] = bf_hi(xq.w);
            m[8 * h + 0] = bf_lo(mq.x); m[8 * h + 1] = bf_hi(mq.x); m[8 * h + 2] = bf_lo(mq.y); m[8 * h + 3] = bf_hi(mq.y); m[8 * h + 4] = bf_lo(mq.z); m[8 * h + 5] = bf_hi(mq.z); m[8 * h + 6] = bf_lo(mq.w); m[8 * h + 7] = bf_hi(mq.w); }
        float sm = 0.f;
#pragma unroll
        for (int k = 0; k < 16; ++k) sm += m[k] * m[k];
        float eps_eff = EPS; if (unscaled) { const float rr = rs[t0 + r], r2 = rr * rr; eps_eff = EPS / (r2 * r2); }
        const float rm = rsqrtf(wave_sum(sm) * (1.f / D) + eps_eff);
        float s1 = 0.f;
#pragma unroll
        for (int k = 0; k < 16; ++k) { x[k] = x[k] + m[k] * rm * g[k]; s1 += x[k] * x[k]; }
        if (outf) {
            f32x4* o = (f32x4*)(outf + (size_t)(t0 + r) * D);
            o[lane * 2] = (f32x4){x[0], x[1], x[2], x[3]}; o[lane * 2 + 1] = (f32x4){x[4], x[5], x[6], x[7]};
            o[128 + lane * 2] = (f32x4){x[8], x[9], x[10], x[11]}; o[128 + lane * 2 + 1] = (f32x4){x[12], x[13], x[14], x[15]};
        } else {
            const float r1 = rsqrtf(wave_sum(s1) * (1.f / D) + EPS);
            u32x4* xo = (u32x4*)(X + (size_t)(t0 + r) * D);
            u32x4 w0, w1;
            w0.x = cvt_pk_bf16(x[0], x[1]); w0.y = cvt_pk_bf16(x[2], x[3]); w0.z = cvt_pk_bf16(x[4], x[5]); w0.w = cvt_pk_bf16(x[6], x[7]);
            w1.x = cvt_pk_bf16(x[8], x[9]); w1.y = cvt_pk_bf16(x[10], x[11]); w1.z = cvt_pk_bf16(x[12], x[13]); w1.w = cvt_pk_bf16(x[14], x[15]);
            xo[lane] = w0; xo[64 + lane] = w1;
            if (lane == 0) rs[t0 + r] = r1;
        }
    }
}

__device__ __forceinline__ void conv_wave_item(const bf16_t* p, const float* cw, bf16_t* Hm, int t0, int pos0, int S, int lane) {
    float w0[8], w1[8], w2[8];
    { const f32x4* a = (const f32x4*)(cw + lane * 8); const f32x4* b = (const f32x4*)(cw + 512 + lane * 8); const f32x4* c = (const f32x4*)(cw + 1024 + lane * 8);
#pragma unroll
      for (int h = 0; h < 2; ++h) { const f32x4 va = a[h], vb = b[h], vc = c[h];
#pragma unroll
        for (int k = 0; k < 4; ++k) { w0[4 * h + k] = va[k]; w1[4 * h + k] = vb[k]; w2[4 * h + k] = vc[k]; } } }
    float zp[8], zc[8], zn[8], gb[8];
    const bf16_t* base = p + (size_t)t0 * PLD + lane * 8;
    if (pos0 == 0) {
#pragma unroll
        for (int k = 0; k < 8; ++k) zp[k] = 0.f;
    } else load8(base - PLD + 512, zp);
    load8(base + 512, zc);
#pragma unroll 8
    for (int i = 0; i < 16; ++i) {
        const bf16_t* r = base + (size_t)i * PLD;
        if (pos0 + i + 1 == S) {
#pragma unroll
            for (int k = 0; k < 8; ++k) zn[k] = 0.f;
        } else load8(r + PLD + 512, zn);
        load8(r, gb);
        float y[8], ss = 0.f;
#pragma unroll
        for (int k = 0; k < 8; ++k) { y[k] = gb[k] * (zp[k] * w0[k] + zc[k] * w1[k] + zn[k] * w2[k]); ss += y[k] * y[k]; }
        ss += __shfl_xor(ss, 1); ss += __shfl_xor(ss, 2); ss += __shfl_xor(ss, 4);
        const float rs = rsqrtf(ss * (1.f / 64.f) + EPS);
        u32x4 o; o.x = cvt_pk_bf16(y[0] * rs, y[1] * rs); o.y = cvt_pk_bf16(y[2] * rs, y[3] * rs); o.z = cvt_pk_bf16(y[4] * rs, y[5] * rs); o.w = cvt_pk_bf16(y[6] * rs, y[7] * rs);
        *(u32x4*)(Hm + (size_t)(t0 + i) * D + lane * 8) = o;
#pragma unroll
        for (int k = 0; k < 8; ++k) { zp[k] = zc[k]; zc[k] = zn[k]; }
    }
}

constexpr int XSTR = 272;
constexpr int RSTR = 34;
constexpr int LDS_XT = 0, LDS_R = 36864, LDS_OST = 106496;
#define LBAR() do { asm volatile("s_waitcnt lgkmcnt(0)" ::: "memory"); __builtin_amdgcn_s_barrier(); asm volatile("" ::: "memory"); } while (0)
__device__ __forceinline__ int seq_base(int bs) { return bs < BP ? bs * SP : TP + (bs - BP) * SS; }

__device__ __forceinline__ void dft_frags(bf16x8 (&Br)[4], bf16x8 (&Bi)[4], int log2n, int kt, int lane) {
    const int N = 1 << log2n, k = 16 * kt + (lane & 15); const float sc = 2.f / (float)N;
#pragma unroll
    for (int ks = 0; ks < 4; ++ks) { u32x4 wr, wi;
#pragma unroll
        for (int e2 = 0; e2 < 4; ++e2) { float c0, s0, c1, s1; const int n0 = 32 * ks + 8 * (lane >> 4) + 2 * e2;
            sincospif(-(float)((n0 * k) & (N - 1)) * sc, &s0, &c0); sincospif(-(float)(((n0 + 1) * k) & (N - 1)) * sc, &s1, &c1);
            wr[e2] = cvt_pk_bf16(c0, c1); wi[e2] = cvt_pk_bf16(s0, s1); }
        Br[ks] = __builtin_bit_cast(bf16x8, wr); Bi[ks] = __builtin_bit_cast(bf16x8, wi); }
}
__device__ __forceinline__ void xt_write(LAS unsigned char* xt, int rp, int ch, const u32x4 va, const u32x4 vb) {
    LAS unsigned char* base = xt + (8 * ch) * XSTR + ((((rp >> 2) ^ ch) << 4) + (rp & 3) * 4);
#pragma unroll
    for (int e2 = 0; e2 < 4; ++e2) {
        *(LAS unsigned*)(base + (2 * e2) * XSTR) = (va[e2] & 0xffffu) | (vb[e2] << 16);
        *(LAS unsigned*)(base + (2 * e2 + 1) * XSTR) = (va[e2] >> 16) | (vb[e2] & 0xffff0000u); }
}
__device__ __forceinline__ void dft_mfma(const LAS unsigned char* xt, int log2n, const bf16x8 (&Br)[4], const bf16x8 (&Bi)[4], f32x4 (&Pa)[4], f32x4 (&Qa)[4], int lane) {
#pragma unroll
    for (int it = 0; it < 4; ++it) { Pa[it] = (f32x4){0.f, 0.f, 0.f, 0.f}; Qa[it] = (f32x4){0.f, 0.f, 0.f, 0.f}; }
#pragma unroll
    for (int ks = 0; ks < 4; ++ks) if (ks < (1 << (log2n - 5))) {
#pragma unroll
        for (int it = 0; it < 4; ++it) { const int col = 16 * it + (lane & 15), gr = 4 * ks + (lane >> 4);
            const bf16x8 a = *(const LAS bf16x8*)(xt + col * XSTR + ((gr ^ (col >> 3)) << 4));
            Pa[it] = __builtin_amdgcn_mfma_f32_16x16x32_bf16(a, Br[ks], Pa[it], 0, 0, 0);
            Qa[it] = __builtin_amdgcn_mfma_f32_16x16x32_bf16(a, Bi[ks], Qa[it], 0, 0, 0); } }
}

__device__ __forceinline__ void p1_decode(int item, int& bs, int& g, int& n2, int& S, int& log2N2) {
    if (item < 2048) { bs = item >> 10; const int r = item & 1023; n2 = r >> 3; g = r & 7; S = SP; log2N2 = 7; }
    else { const int it = item - 2048; bs = BP + (it >> 9); const int r = it & 511; n2 = r >> 3; g = r & 7; S = SS; log2N2 = 6; }
}
__device__ __forceinline__ void p1_load(const bf16_t* p, int item, int rp, int ch, u32x4& va, u32x4& vb) {
    int bs, g, n2, S, l2; p1_decode(item, bs, g, n2, S, l2);
    const bf16_t* src = p + (size_t)(seq_base(bs) + ((2 * rp) << l2) + n2) * PLD + 1024 + g * 64 + ch * 8;
    va = *(const u32x4*)src; vb = *(const u32x4*)(src + ((size_t)PLD << l2));
}
__device__ __forceinline__ void fft_pass1(const bf16_t* p, bf16_t* inter, LAS unsigned char* lds, int bid, int G, int tid) {
    constexpr int NP1 = 2048 + 4096;
    const int lane = tid & 63, wave = __builtin_amdgcn_readfirstlane(tid >> 6), rp = tid >> 3, ch = tid & 7;
    bf16x8 Br[4], Bi[4]; dft_frags(Br, Bi, 7, wave, lane);
    u32x4 va, vb;
    if (bid < NP1) p1_load(p, bid, rp, ch, va, vb);
    int par = 0;
    for (int item = bid; item < NP1; item += G, par ^= 1) {
        LAS unsigned char* xt = lds + LDS_XT + par * (64 * XSTR);
        xt_write(xt, rp, ch, va, vb);
        if (item + G < NP1) p1_load(p, item + G, rp, ch, va, vb);
        LBAR();
        f32x4 Pa[4], Qa[4]; dft_mfma(xt, 7, Br, Bi, Pa, Qa, lane);
        int bs, g, n2, S, l2; p1_decode(item, bs, g, n2, S, l2);
        const int k1 = 16 * wave + (lane & 15), quad = lane >> 4;
        float sn, cs; sincospif(-2.0f * (float)(n2 * k1) / (float)S, &sn, &cs);
        bf16_t* dst = inter + ((size_t)seq_base(bs) * 8 + (size_t)g * S + ((size_t)k1 << l2) + n2) * 64 + 4 * quad;
#pragma unroll
        for (int it = 0; it < 4; ++it) {
            const float r0 = Pa[it][0] - Qa[it][1], i0 = Pa[it][1] + Qa[it][0], r1 = Pa[it][2] - Qa[it][3], i1 = Pa[it][3] + Qa[it][2];
            u32x2 w; w.x = cvt_pk_bf16(r0 * cs - i0 * sn, r0 * sn + i0 * cs); w.y = cvt_pk_bf16(r1 * cs - i1 * sn, r1 * sn + i1 * cs);
            *(u32x2*)(dst + 16 * it) = w; }
    }
    LBAR();
}

__device__ __forceinline__ void p2_decode(int item, int& bs, int& g, int& k1a, int& k1b, int& ip) {
    int r;
    if (item < 1024) { bs = item >> 9; r = item & 511; } else { const int it = item - 1024; bs = BP + (it >> 9); r = it & 511; }
    g = r >> 6; ip = r & 63; k1a = ip; k1b = ip == 0 ? 64 : 128 - ip;
}
template <int LOG2N>
__device__ __forceinline__ void fft_pass2(const bf16_t* inter, bf16_t* Hm, LAS unsigned char* lds, int item0, int item_end, int G, int tid) {
    constexpr int N2 = 1 << LOG2N, NTASK = N2 / 64, S = (LOG2N == 7) ? SP : SS;
    const int lane = tid & 63, wave = __builtin_amdgcn_readfirstlane(tid >> 6);
    bf16x8 Br[4], Bi[4]; dft_frags(Br, Bi, LOG2N, LOG2N == 7 ? wave : (wave & 3), lane);
    u32x4 va[NTASK], vb[NTASK];
#define P2_LOAD(item_) do { int bs_, g_, ka_, kb_, ip_; p2_decode(item_, bs_, g_, ka_, kb_, ip_); \
        const bf16_t* ib_ = inter + ((size_t)seq_base(bs_) * 8 + (size_t)g_ * S) * 64; \
        _Pragma("unroll") for (int j = 0; j < NTASK; ++j) { const int q = tid + NTHREADS * j, h = q / (4 * N2), r = q % (4 * N2), rp = r >> 3, ch = r & 7; \
            const bf16_t* src = ib_ + ((size_t)((h ? kb_ : ka_) * N2 + 2 * rp)) * 64 + ch * 8; va[j] = *(const u32x4*)src; vb[j] = *(const u32x4*)(src + 64); } } while (0)
    if (item0 < item_end) P2_LOAD(item0);
    LAS f32x2* R = (LAS f32x2*)(lds + LDS_R);
    LAS bf16_t* Ost = (LAS bf16_t*)(lds + LDS_OST);
    const float sc = rsqrtf((float)S);
    for (int item = item0; item < item_end; item += G) {
#pragma unroll
        for (int j = 0; j < NTASK; ++j) { const int q = tid + NTHREADS * j, h = q / (4 * N2), r = q % (4 * N2);
            xt_write(lds + LDS_XT + h * (64 * XSTR), r >> 3, r & 7, va[j], vb[j]); }
        if (item + G < item_end) P2_LOAD(item + G);
        LBAR();
        {
            f32x4 Pa[4], Qa[4]; const int quad = lane >> 4;
#pragma unroll
            for (int hh = 0; hh < (LOG2N == 7 ? 2 : 1); ++hh) {
                const int h = (LOG2N == 7) ? hh : (wave >> 2), kt = (LOG2N == 7) ? wave : (wave & 3);
                dft_mfma(lds + LDS_XT + h * (64 * XSTR), LOG2N, Br, Bi, Pa, Qa, lane);
                LAS f32x2* Rr = R + (h * N2 + 16 * kt + (lane & 15)) * RSTR + 2 * quad;
#pragma unroll
                for (int it = 0; it < 4; ++it)
                    *(LAS f32x4*)(Rr + 8 * it) = (f32x4){Pa[it][0] - Qa[it][1], Pa[it][1] + Qa[it][0], Pa[it][2] - Qa[it][3], Pa[it][3] + Qa[it][2]};
            }
        }
        LBAR();
        int bs, g, k1a, k1b, ip; p2_decode(item, bs, g, k1a, k1b, ip);
        const int tb = seq_base(bs);
        for (int idx = tid; idx < 2 * N2 * 32; idx += NTHREADS) {
            const int c = idx & 31, tl = idx >> 5, h = tl >> LOG2N, k2 = tl & (N2 - 1);
            const int ph = (ip == 0) ? h : 1 - h;
            const int k2p = (ip == 0 && h == 0) ? ((N2 - k2) & (N2 - 1)) : (N2 - 1 - k2);
            const f32x2 own = R[(h * N2 + k2) * RSTR + c], par = R[(ph * N2 + k2p) * RSTR + c];
            float v1 = (c == 0) ? 0.5f * (own.x + par.x) : own.x, v2 = (c == 0) ? 0.5f * (own.y + par.y) : par.x;
            v1 *= sc; v2 *= sc;
            float ss = v1 * v1 + v2 * v2;
            ss += __shfl_xor(ss, 1); ss += __shfl_xor(ss, 2); ss += __shfl_xor(ss, 4); ss += __shfl_xor(ss, 8); ss += __shfl_xor(ss, 16);
            const float rs = rsqrtf(ss * (1.f / 64.f) + EPS);
            Ost[tl * 64 + c] = (bf16_t)(cvt_pk_bf16(v1 * rs, 0.f) & 0xffffu);
            Ost[tl * 64 + (c == 0 ? 32 : 64 - c)] = (bf16_t)(cvt_pk_bf16(v2 * rs, 0.f) & 0xffffu);
        }
        LBAR();
        for (int idx = tid; idx < 2 * N2 * 8; idx += NTHREADS) {
            const int tl = idx >> 3, ch = idx & 7, h = tl >> LOG2N, k2 = tl & (N2 - 1);
            const int tok = tb + (h ? k1b : k1a) + 128 * k2;
            *(u32x4*)(Hm + (size_t)tok * D + 512 + g * 64 + ch * 8) = ((const LAS u32x4*)Ost)[idx];
        }
    }
    LBAR();
#undef P2_LOAD
}

#define XB_TMO      128
#define XB_XCNT(j)  (256  + 64 * (j))
#define XB_XSUB(j)  (1280 + 64 * (j))
#define XB_XGEN(j)  (2304 + 64 * (j))
#define XB_TOP      3328
#define XB_TOPGEN   3392
#define XCD_BAR_WORDS 3456
#define XB_SPIN_CAP (1u << 20)
__device__ __forceinline__ unsigned xb_ld(unsigned* p)              { return __hip_atomic_load(p, __ATOMIC_RELAXED, __HIP_MEMORY_SCOPE_AGENT); }
__device__ __forceinline__ unsigned xb_add(unsigned* p, unsigned v) { return __hip_atomic_fetch_add(p, v, __ATOMIC_RELAXED, __HIP_MEMORY_SCOPE_AGENT); }
__device__ __forceinline__ unsigned xb_xcc_id() { return (unsigned)__builtin_amdgcn_s_getreg((3 << 11) | 20) & 0xFu; }
#define XB_SPIN(cond, bar) do { unsigned _sp = 0; while (cond) { __builtin_amdgcn_s_sleep(1); \
    if ((++_sp & 255u) == 0u) { if (xb_ld(&(bar)[XB_TMO])) break; if (_sp > XB_SPIN_CAP) { atomicAdd(&(bar)[XB_TMO], 1u); break; } } } } while (0)
struct XcdBarrier { unsigned* bar; unsigned x; volatile LAS unsigned* st; };
__device__ __forceinline__ XcdBarrier xcd_barrier_post(unsigned* bar, volatile LAS unsigned* st) {
    XcdBarrier b; b.bar = bar; b.x = xb_xcc_id(); b.st = st;
    if (threadIdx.x == 0) (void)xb_add(&bar[XB_XCNT(b.x)], 1u);
    return b;
}
__device__ __forceinline__ void xcd_barrier_complete(unsigned* bar, unsigned x, unsigned& nloc, unsigned& nx) {
    const unsigned G = gridDim.x * gridDim.y * gridDim.z;
    unsigned sum, cnt, mine, sp = 0u;
    for (;;) {
        sum = 0u; cnt = 0u; mine = 0u;
#pragma unroll
        for (unsigned j = 0; j < 16; ++j) { const unsigned c = xb_ld(&bar[XB_XCNT(j)]); sum += c; cnt += (c > 0u) ? 1u : 0u; mine = (j == x) ? c : mine; }
        if (sum == G) break;
        __builtin_amdgcn_s_sleep(1);
        if ((++sp & 255u) == 0u) { if (xb_ld(&bar[XB_TMO])) break; if (sp > XB_SPIN_CAP) { atomicAdd(&bar[XB_TMO], 1u); break; } }
    }
    nloc = mine > 0u ? mine : 1u; nx = cnt > 0u ? cnt : 1u;
}
__device__ __forceinline__ void xcd_barrier(const XcdBarrier& b) {
    asm volatile("s_waitcnt vmcnt(0)" ::: "memory");
    __syncthreads();
    if (threadIdx.x == 0) {
        unsigned* bar = b.bar;
        __builtin_amdgcn_s_waitcnt(0);
        unsigned nloc = b.st[0], nx = b.st[1];
        if (nloc == 0u) { xcd_barrier_complete(bar, b.x, nloc, nx); b.st[0] = nloc; b.st[1] = nx; }
        const unsigned old = xb_add(&bar[XB_XSUB(b.x)], 1u);
        const unsigned gen = old / nloc;
        if (old + 1u == (gen + 1u) * nloc) {
            __builtin_amdgcn_fence(__ATOMIC_RELEASE, "agent");
            asm volatile("s_waitcnt vmcnt(0)" ::: "memory");
            const unsigned og = xb_add(&bar[XB_TOP], 1u);
            const unsigned tg = og / nx;
            if (og + 1u == (tg + 1u) * nx) xb_add(&bar[XB_TOPGEN], 1u);
            else XB_SPIN(xb_ld(&bar[XB_TOPGEN]) == tg, bar);
            __builtin_amdgcn_fence(__ATOMIC_ACQUIRE, "agent");
            xb_add(&bar[XB_XGEN(b.x)], 1u);
            asm volatile("s_waitcnt vmcnt(0)" ::: "memory");
        } else {
            XB_SPIN(xb_ld(&bar[XB_XGEN(b.x)]) == gen, bar);
            __builtin_amdgcn_fence(__ATOMIC_ACQUIRE, "agent");
            asm volatile("s_waitcnt vmcnt(0)" ::: "memory");
        }
    }
    __syncthreads();
}

__global__ void __launch_bounds__(NTHREADS, 2) fwd_megakernel(Params P) {
    extern __shared__ __attribute__((aligned(16))) unsigned char shm[];
    cg::grid_group grid = cg::this_grid();
    LAS unsigned char* lds = (LAS unsigned char*)shm;
    const int G = gridDim.x, bid = blockIdx.x, NGW = G * NWAVES;
#define FRESH() int tid = threadIdx.x; asm volatile("" : "+v"(tid)); const int lane = tid & 63, wave = __builtin_amdgcn_readfirstlane(tid >> 6), gw = bid * NWAVES + wave; (void)lane; (void)gw
#define TAB ((LAS float*)(lds + LDS_MISC))
    { FRESH();
      if (tid < 64) TAB[tid] = cospif((float)tid * (1.f / 32.f));
      if (tid < 4) ((volatile LAS unsigned*)(lds + LDS_MISC + 1024))[tid] = 0u; }
    __syncthreads();
    const XcdBarrier xbar = xcd_barrier_post((unsigned*)P.ws, (volatile LAS unsigned*)(lds + LDS_MISC + 1024));
#define GSYNC() xcd_barrier(xbar)

    unsigned char* ws = P.ws;
#define Xb ((bf16_t*)(ws + WS_X))
#define Hb ((bf16_t*)(ws + WS_H))
#define Pb ((bf16_t*)P.out)
#define Ib ((bf16_t*)(ws + WS_INTER))
#define MFb ((bf16_t*)(ws + WS_MF))
#define A0b ((bf16_t*)(ws + WS_H))
#define A1b ((bf16_t*)P.out)
#define RSb ((float*)(ws + WS_RS))

    {
        FRESH();
        LAS float* scr = (LAS float*)(lds + wave * 8704);
        constexpr int I_IN = 16 * 48, I_OUT = 16 * 32, I_UP = 16 * 128, I_DN = 64 * 32, I_F = 128, I_L = I_IN + I_OUT + I_UP + I_DN + I_F;
        for (int it = gw; it < NL * I_L; it += NGW) {
            const int l = it / I_L; int r = it % I_L;
            bf16_t* Wl = (bf16_t*)(ws + WS_W + (size_t)l * WL_SZ);
            const float* win = P.w_in + (size_t)l * D * DIN;
            if (r < I_IN) { p0_transpose_item<true>(win, D, DIN, 48, Wl + WL_IN / 2, P.g_mix_pre + l * D, scr, r, lane); continue; } r -= I_IN;
            if (r < I_OUT) {
                const int kb = r / 32; const float* gsrc = kb < 8 ? P.g_conv_out + l * 512 : P.g_fourier_out + l * 512 - 512;
                p0_transpose_item(P.w_out + (size_t)l * D * D, D, D, 32, Wl + WL_OUT / 2, gsrc, scr, r, lane); continue; } r -= I_OUT;
            if (r < I_UP) { p0_transpose_item(P.w_up + (size_t)l * D * DFF, D, DFF, 128, Wl + WL_UP / 2, P.g_mlp_pre + l * D, scr, r, lane); continue; } r -= I_UP;
            if (r < I_DN) { p0_transpose_item(P.w_down + (size_t)l * DFF * D, DFF, D, 32, Wl + WL_DN / 2, nullptr, scr, r, lane); continue; } r -= I_DN;
            p0_fold_item(win, P.g_mix_pre + l * D, Wl + WL_IN / 2, TAB, r, lane);
        }
        for (int t = gw * 4; t < T; t += NGW * 4) x_rows_init<4>(t < TP ? P.xp + (size_t)t * D : P.xs + (size_t)(t - TP) * D, Xb + (size_t)t * D, RSb + t, lane);
    }
    grid.sync();

    for (int l = 0; l < NL; ++l) {
        const bf16_t* Wl = (const bf16_t*)(ws + WS_W + (size_t)l * WL_SZ);
        { pg8::Gemm g{Xb, Wl + WL_IN / 2, T, DIN, D, nullptr, 1 << 20}; pg8::StaticOrder S; S.init(T, DIN, G, bid); pg8::EpiInProj E{Pb, RSb};
          pg8::gemm_phase(lds, g, S, E); }
        GSYNC();
        {
            FRESH();
            constexpr int NCONV = T / 128;
            for (int it = bid; it < NCONV; it += G) { const int t0 = it * 128 + wave * 16; const int S = t0 < TP ? SP : SS; const int pos0 = t0 < TP ? (t0 & (SP - 1)) : ((t0 - TP) & (SS - 1));
                conv_wave_item(Pb, P.conv_w + (size_t)l * 3 * 512, Hb, t0, pos0, S, lane); }
            fft_pass1(Pb, Ib, lds, bid, G, tid);
        }
        GSYNC();
        { FRESH(); fft_pass2<7>(Ib, Hb, lds, bid, 1024, G, tid); }
        { FRESH(); fft_pass2<6>(Ib, Hb, lds, 1024 + bid, 1024 + 4096, G, tid); }
        GSYNC();
        { pg8::Gemm g{Hb, Wl + WL_OUT / 2, T, D, D, nullptr, 1 << 20}; pg8::StaticOrder S; S.init(T, D, G, bid); pg8::EpiBf16 E{MFb, D, 0, nullptr, nullptr, 1 << 20};
          pg8::gemm_phase(lds, g, S, E); }
        GSYNC();
        { FRESH();
          for (int t = gw * 8; t < T; t += NGW * 8) row_pass_rows<8>(Xb, MFb, P.g_mix_post + l * D, RSb, nullptr, false, t, lane); }
        GSYNC();
        { pg8::Gemm g{Xb, Wl + WL_UP / 2, T, DFF, D, nullptr, 1 << 20}; pg8::StaticOrder S; S.init(T, DFF, G, bid); pg8::EpiBf16 E{A0b, DFF, 1, nullptr, A1b, TCH / 256};
          pg8::gemm_phase(lds, g, S, E); }
        GSYNC();
        { pg8::Gemm g{A0b, Wl + WL_DN / 2, T, D, DFF, A1b, TCH / 256}; pg8::StaticOrder S; S.init(T, D, G, bid); pg8::EpiBf16 E{MFb, D, 0, nullptr, nullptr, 1 << 20};
          pg8::gemm_phase(lds, g, S, E); }
        GSYNC();
        { FRESH();
          float* outf = (l + 1 < NL) ? nullptr : P.out;
          for (int t = gw * 8; t < T; t += NGW * 8) row_pass_rows<8>(Xb, MFb, P.g_mlp_post + l * D, RSb, outf, true, t, lane); }
        if (l + 1 < NL) GSYNC();
    }
}

extern "C" void kernel_launch(void* const* d_in, const int* in_sizes, int n_in, void* d_out, int out_size, void* d_ws, size_t ws_size, hipStream_t stream) {
    static int grid_blocks = 0;
    if (grid_blocks == 0) {
        if (n_in != 13 || out_size != T * D || ws_size < WS_END) { fprintf(stderr, "kernel_launch: unexpected shapes (n_in %d, out %d, ws %zu, need %zu)\n", n_in, out_size, ws_size, (size_t)WS_END); grid_blocks = -1; return; }
        int dev = 0, cus = 0, per_cu = 0;
        hipGetDevice(&dev);
        hipDeviceGetAttribute(&cus, hipDeviceAttributeMultiprocessorCount, dev);
        if (hipFuncSetAttribute((const void*)fwd_megakernel, hipFuncAttributeMaxDynamicSharedMemorySize, LDS_BYTES) != hipSuccess) { fprintf(stderr, "kernel_launch: hipFuncSetAttribute failed\n"); grid_blocks = -1; return; }
        hipOccupancyMaxActiveBlocksPerMultiprocessor(&per_cu, (const void*)fwd_megakernel, NTHREADS, LDS_BYTES);
        if (per_cu < 1) { fprintf(stderr, "kernel_launch: occupancy query says %d blocks per CU\n", per_cu); per_cu = 1; }
        grid_blocks = cus * per_cu;
    }
    if (grid_blocks < 0) return;
    Params p{};
    p.xp = (const float*)d_in[0]; p.xs = (const float*)d_in[1]; p.g_mix_pre = (const float*)d_in[2]; p.w_in = (const float*)d_in[3]; p.conv_w = (const float*)d_in[4];
    p.g_conv_out = (const float*)d_in[5]; p.g_fourier_out = (const float*)d_in[6]; p.w_out = (const float*)d_in[7]; p.g_mix_post = (const float*)d_in[8];
    p.g_mlp_pre = (const float*)d_in[9]; p.w_up = (const float*)d_in[10]; p.w_down = (const float*)d_in[11]; p.g_mlp_post = (const float*)d_in[12];
    p.out = (float*)d_out; p.ws = (unsigned char*)d_ws;
    if (hipMemsetAsync(d_ws, 0, 16384, stream) != hipSuccess) { fprintf(stderr, "kernel_launch: memset failed\n"); return; }
    void* args[] = {&p};
    hipError_t e = hipLaunchCooperativeKernel((const void*)fwd_megakernel, dim3(grid_blocks), dim3(NTHREADS), args, LDS_BYTES, stream);
    if (e != hipSuccess) fprintf(stderr, "cooperative launch failed: %s (grid %d)\n", hipGetErrorString(e), grid_blocks);
}
```

```cpp
#include <hip/hip_runtime.h>
#include <hip/hip_cooperative_groups.h>
#include <cstdio>
namespace cg = cooperative_groups;

#define LAS __attribute__((address_space(3)))
typedef unsigned short bf16_t;
typedef short bf16x8 __attribute__((ext_vector_type(8)));
typedef float f32x4 __attribute__((ext_vector_type(4)));
typedef float f32x2 __attribute__((ext_vector_type(2)));
typedef unsigned u32x4 __attribute__((ext_vector_type(4)));
typedef unsigned u32x2 __attribute__((ext_vector_type(2)));

constexpr int D = 1024, DIN = 2048, DFF = 4096, NL = 4;
constexpr int PLD = 1536;
constexpr int SP = 16384, BP = 2, SS = 8192, BS = 8;
constexpr int TP = BP * SP, TS = BS * SS, T = TP + TS;
constexpr float EPS = 1e-6f;
constexpr int NCH = 2;
constexpr int TCH = T / NCH;

constexpr size_t MiB = (size_t)1 << 20;
constexpr size_t WS_W = 1 * MiB;
constexpr size_t WL_IN = 0, WL_OUT = 4 * MiB, WL_UP = 6 * MiB, WL_DN = 14 * MiB, WL_SZ = 22 * MiB;
constexpr size_t WS_X = WS_W + NL * WL_SZ;
constexpr size_t WS_H = WS_X + (size_t)T * D * 2;
constexpr size_t WS_INTER = WS_H + (size_t)T * D * 2;
constexpr size_t WS_MF = WS_INTER + (size_t)T * 256 * 8;
constexpr size_t WS_RS = WS_MF + (size_t)T * D * 2;
constexpr size_t WS_END = WS_RS + 1 * MiB;

constexpr int LDS_STAGE = 131072, LDS_MISC = 139264, LDS_BYTES = LDS_MISC + 4096;
constexpr int NTHREADS = 512, NWAVES = 8;

struct Params {
    const float* xp; const float* xs; const float* g_mix_pre; const float* w_in; const float* conv_w;
    const float* g_conv_out; const float* g_fourier_out; const float* w_out; const float* g_mix_post;
    const float* g_mlp_pre; const float* w_up; const float* w_down; const float* g_mlp_post;
    float* out; unsigned char* ws;
};

__device__ __forceinline__ unsigned cvt_pk_bf16(float lo, float hi) { unsigned r; asm volatile("v_cvt_pk_bf16_f32 %0, %1, %2" : "=v"(r) : "v"(lo), "v"(hi)); return r; }
__device__ __forceinline__ float bf_lo(unsigned w) { return __uint_as_float(w << 16); }
__device__ __forceinline__ float bf_hi(unsigned w) { return __uint_as_float(w & 0xffff0000u); }
__device__ __forceinline__ float wave_sum(float v) {
#pragma unroll
    for (int o = 1; o < 64; o <<= 1) v += __shfl_xor(v, o);
    return v;
}
__device__ __forceinline__ void load8(const bf16_t* ptr, float (&v)[8]) {
    const u32x4 q = *(const u32x4*)ptr;
    v[0] = bf_lo(q.x); v[1] = bf_hi(q.x); v[2] = bf_lo(q.y); v[3] = bf_hi(q.y); v[4] = bf_lo(q.z); v[5] = bf_hi(q.z); v[6] = bf_lo(q.w); v[7] = bf_hi(q.w);
}

namespace pg8 {
constexpr int BM = 256, BK = 64, HALF = 128, HTB = HALF * BK * 2, STAGE_BYTES = 8 * HTB, NXCD = 8, WGM = 8;
__device__ __forceinline__ int lds_byte(int r, int c) { const int st = (r >> 4) * 2 + (c >> 5), rr = r & 15, cc = c & 31, ob = rr * 64 + cc * 2; return st * 1024 + (ob ^ (((ob >> 9) & 1) << 5)); }
__device__ __forceinline__ void stage_rc(int b, int& R, int& C) { const int st = b / 1024, sb = b % 1024, swz = sb ^ (((sb >> 9) & 1) << 5); R = (st >> 1) * 16 + swz / 64; C = (st & 1) * 32 + (swz % 64) / 2; }
__device__ __forceinline__ int perm32(int rho) { const int n = rho >> 4, i = rho & 15; return 8 * (i >> 2) + 4 * n + (i & 3); }

struct Unit { int pm, pn; };
struct Gemm { const bf16_t* A; const bf16_t* Bt; int M, N, K; const bf16_t* A2; int split; };

struct StaticOrder {
    int nM, nN, nwg, G, c;
    __device__ void init(int M, int N, int G_, int c_) { nM = M / BM; nN = N / BM; nwg = nM * nN; G = G_; c = c_; }
    __device__ bool next(int i, Unit& u) const {
        const long L = (long)i * G + c; if (L >= nwg) return false;
        int wgid = (int)L; { const int q = nwg / NXCD, r = nwg % NXCD, xcd = wgid % NXCD, off = wgid / NXCD; wgid = (xcd < r ? xcd * (q + 1) : r * (q + 1) + (xcd - r) * q) + off; }
        const int nig = WGM * nN, gid = wgid / nig, fm = gid * WGM, gsz = (nM - fm) < WGM ? (nM - fm) : WGM;
        u.pm = fm + ((wgid % nig) % gsz); u.pn = (wgid % nig) / gsz; return true;
    }
};

struct EpiBf16 {
    static constexpr bool FUSED = false;
    bf16_t* O; int ldc; int act; const float* rs; bf16_t* O2; int split;
    __device__ __forceinline__ void operator()(const f32x4 (&acc)[2][2][4][2], const Unit& u, int wr, int wc, int fr, int fq) const {
        const bool lo = u.pm < split; bf16_t* Ob = lo ? O : O2;
        const int grow0 = u.pm * BM + wr * 64 + fr, row0 = grow0 - (lo ? 0 : split * BM); const int col0 = u.pn * BM + wc * 32 + 8 * fq;
#pragma unroll
        for (int ai = 0; ai < 2; ++ai)
#pragma unroll
            for (int m = 0; m < 4; ++m) { bf16_t* rowp = Ob + (size_t)(row0 + ai * HALF + m * 16) * ldc + col0; const float sc = rs ? rs[grow0 + ai * HALF + m * 16] : 1.f;
#pragma unroll
                for (int bj = 0; bj < 2; ++bj) { f32x4 v0 = acc[ai][bj][m][0] * sc, v1 = acc[ai][bj][m][1] * sc;
                    if (act) {
#pragma unroll
                        for (int j = 0; j < 4; ++j) { const float a0 = __builtin_amdgcn_fmed3f(v0[j], 0.f, __builtin_inff()), a1 = __builtin_amdgcn_fmed3f(v1[j], 0.f, __builtin_inff()); v0[j] = a0 * a0; v1[j] = a1 * a1; } }
                    u32x4 w; w.x = cvt_pk_bf16(v0[0], v0[1]); w.y = cvt_pk_bf16(v0[2], v0[3]); w.z = cvt_pk_bf16(v1[0], v1[1]); w.w = cvt_pk_bf16(v1[2], v1[3]);
                    *(u32x4*)(rowp + bj * HALF) = w; } }
    }
};


struct EpiInProj {
    static constexpr bool FUSED = false;
    bf16_t* O; const float* rs;
    __device__ __forceinline__ void operator()(const f32x4 (&acc)[2][2][4][2], const Unit& u, int wr, int wc, int fr, int fq) const {
        const int row0 = u.pm * BM + wr * 64 + fr, sub = wc * 32 + 8 * fq;
        const bool isz = (u.pn >= 2 && u.pn < 6);
        const int cbase = isz ? 512 + (u.pn - 2) * 128 + sub : (u.pn < 2 ? u.pn * BM + sub : 1024 + (u.pn - 6) * BM + sub);
#pragma unroll
        for (int ai = 0; ai < 2; ++ai)
#pragma unroll
            for (int m = 0; m < 4; ++m) { const int row = row0 + ai * HALF + m * 16; bf16_t* rowp = O + (size_t)row * PLD + cbase; const float sc = rs[row];
                if (isz) { const float s2 = sc * sc; const f32x4 z0 = acc[ai][0][m][0] * acc[ai][1][m][0] * s2, z1 = acc[ai][0][m][1] * acc[ai][1][m][1] * s2;
                    u32x4 w; w.x = cvt_pk_bf16(z0[0], z0[1]); w.y = cvt_pk_bf16(z0[2], z0[3]); w.z = cvt_pk_bf16(z1[0], z1[1]); w.w = cvt_pk_bf16(z1[2], z1[3]);
                    *(u32x4*)rowp = w; }
                else {
#pragma unroll
                    for (int bj = 0; bj < 2; ++bj) { const f32x4 v0 = acc[ai][bj][m][0] * sc, v1 = acc[ai][bj][m][1] * sc;
                        u32x4 w; w.x = cvt_pk_bf16(v0[0], v0[1]); w.y = cvt_pk_bf16(v0[2], v0[3]); w.z = cvt_pk_bf16(v1[0], v1[1]); w.w = cvt_pk_bf16(v1[2], v1[3]);
                        *(u32x4*)(rowp + bj * HALF) = w; } } }
    }
};

template <class Epi, class Sched>
__device__ __forceinline__ void gemm_phase(LAS unsigned char* lds, const Gemm g, const Sched& S, const Epi& E) {
    int tid_ = threadIdx.x; asm volatile("" : "+v"(tid_));
    const int tid = tid_, wid = __builtin_amdgcn_readfirstlane(tid >> 6), lane = tid & 63, wr = wid >> 2, wc = wid & 3, fr = lane & 15, fq = lane >> 4;
    const int K = g.K, nt = K / BK;
    unsigned voffA[2], voffB[2];
#pragma unroll
    for (int i = 0; i < 2; ++i) { int R, C; stage_rc(tid * 16 + i * 8192, R, C); const int Rb = (R & ~31) + perm32(R & 31);
        voffA[i] = (unsigned)(R * K + C) * 2u; voffB[i] = (unsigned)(Rb * K + C) * 2u; }
    const size_t kstep = (size_t)(BK * 2);
    const size_t hstep = (size_t)HALF * K * 2;
    const size_t tstep = 2 * hstep;
    const unsigned ldsw = (unsigned)wid * 1024u;
    const int aoff = lds_byte(wr * 64 + fr, fq * 8), boff = lds_byte(wc * 32 + fr, fq * 8);
#define PG8_SA(b, h) (((b) * 2 + (h)) * HTB)
#define PG8_SB(b, h) ((4 + (b) * 2 + (h)) * HTB)
#define PG8_STAGE(bufoff, gbase, voff) do { _Pragma("unroll") for (int _i = 0; _i < 2; ++_i) \
        __builtin_amdgcn_global_load_lds((const unsigned*)((const char*)(gbase) + (voff)[_i]), (LAS unsigned*)(lds + (bufoff) + ldsw + _i * 8192), 16, 0, 0); } while (0)
#define PG8_LDA(dst, b, h) do { _Pragma("unroll") for (int m = 0; m < 4; ++m) _Pragma("unroll") for (int k = 0; k < 2; ++k) dst[m][k] = *(const LAS bf16x8*)(lds + PG8_SA(b, h) + aoff + m * 2048 + k * 1024); } while (0)
#define PG8_LDB(dst, b, h) do { _Pragma("unroll") for (int n = 0; n < 2; ++n) _Pragma("unroll") for (int k = 0; k < 2; ++k) dst[n][k] = *(const LAS bf16x8*)(lds + PG8_SB(b, h) + boff + n * 2048 + k * 1024); } while (0)
#define PG8_MMA(ai, bj, At, Bt) do { __builtin_amdgcn_s_setprio(1); _Pragma("unroll") for (int m = 0; m < 4; ++m) _Pragma("unroll") for (int n = 0; n < 2; ++n) _Pragma("unroll") for (int k = 0; k < 2; ++k) \
        acc[ai][bj][m][n] = __builtin_amdgcn_mfma_f32_16x16x32_bf16(Bt[n][k], At[m][k], acc[ai][bj][m][n], 0, 0, 0); __builtin_amdgcn_s_setprio(0); } while (0)
#define PG8_WAIT_V(n) asm volatile("s_waitcnt vmcnt(" #n ")" ::: "memory")
#define PG8_WAIT_L(n) asm volatile("s_waitcnt lgkmcnt(" #n ")" ::: "memory")
#define PG8_BAR __builtin_amdgcn_s_barrier()
#define PG8_SCHED __builtin_amdgcn_sched_barrier(0)
    Unit cur, nxt; int ui = 0;
    if (!S.next(0, cur)) return;
    f32x4 acc[2][2][4][2];
#pragma unroll
    for (int a = 0; a < 2; ++a)
#pragma unroll
        for (int b = 0; b < 2; ++b)
#pragma unroll
            for (int m = 0; m < 4; ++m)
#pragma unroll
                for (int n = 0; n < 2; ++n) acc[a][b][m][n] = (f32x4){0.f, 0.f, 0.f, 0.f};
    bf16x8 At[4][2], B0[2][2], B1[2][2];
#define PG8_APANEL(pm_) ((const char*)(((pm_) < g.split ? (unsigned long long)g.A : (unsigned long long)g.A2 - (unsigned long long)g.split * tstep) + (unsigned long long)(pm_) * tstep))
    const char* cA = PG8_APANEL(cur.pm); const char* cB = (const char*)g.Bt + (size_t)cur.pn * tstep;
    PG8_STAGE(PG8_SB(0, 0), cB, voffB); PG8_STAGE(PG8_SA(0, 0), cA, voffA); PG8_STAGE(PG8_SB(0, 1), cB + hstep, voffB); PG8_STAGE(PG8_SA(0, 1), cA + hstep, voffA);
    if (wr == 1) PG8_BAR;
    PG8_WAIT_V(4); PG8_BAR;
    PG8_STAGE(PG8_SB(1, 0), cB + kstep, voffB); PG8_STAGE(PG8_SA(1, 0), cA + kstep, voffA); PG8_STAGE(PG8_SB(1, 1), cB + hstep + kstep, voffB);
    PG8_WAIT_V(6); PG8_BAR;
    for (;;) {
        const bool has_next = S.next(ui + 1, nxt);
        const char* nA = has_next ? PG8_APANEL(nxt.pm) : cA; const char* nB = has_next ? (const char*)g.Bt + (size_t)nxt.pn * tstep : cB;
        for (int t = 0; t < nt; t += 2) {
            const bool last = (t == nt - 2);
            const char* a1 = cA + (size_t)(t + 1) * kstep;
            const char* a2 = last ? nA : cA + (size_t)(t + 2) * kstep; const char* b2 = last ? nB : cB + (size_t)(t + 2) * kstep;
            const char* a3 = a2 + kstep; const char* b3 = b2 + kstep;
            PG8_LDB(B0, 0, 0); PG8_SCHED; PG8_LDA(At, 0, 0); PG8_STAGE(PG8_SA(1, 1), a1 + hstep, voffA);
            PG8_WAIT_L(8); PG8_BAR; PG8_WAIT_L(0); PG8_MMA(0, 0, At, B0); PG8_BAR; PG8_SCHED;
            PG8_LDB(B1, 0, 1); PG8_STAGE(PG8_SB(0, 0), b2, voffB);
            PG8_BAR; PG8_WAIT_L(0); PG8_MMA(0, 1, At, B1); PG8_BAR;
            PG8_LDA(At, 0, 1); PG8_STAGE(PG8_SA(0, 0), a2, voffA);
            PG8_BAR; PG8_WAIT_L(0); PG8_MMA(1, 0, At, B0); PG8_BAR; PG8_SCHED;
            PG8_STAGE(PG8_SB(0, 1), b2 + hstep, voffB);
            PG8_WAIT_V(6); PG8_BAR; PG8_MMA(1, 1, At, B1); PG8_BAR;
            PG8_LDB(B0, 1, 0); PG8_SCHED; PG8_LDA(At, 1, 0); PG8_STAGE(PG8_SA(0, 1), a2 + hstep, voffA);
            PG8_WAIT_L(8); PG8_BAR; PG8_WAIT_L(0); PG8_MMA(0, 0, At, B0); PG8_BAR; PG8_SCHED;
            PG8_LDB(B1, 1, 1); PG8_STAGE(PG8_SB(1, 0), b3, voffB);
            PG8_BAR; PG8_WAIT_L(0); PG8_MMA(0, 1, At, B1); PG8_BAR;
            PG8_LDA(At, 1, 1); PG8_STAGE(PG8_SA(1, 0), a3, voffA);
            PG8_BAR; PG8_WAIT_L(0); PG8_MMA(1, 0, At, B0); PG8_BAR; PG8_SCHED;
            PG8_STAGE(PG8_SB(1, 1), b3 + hstep, voffB);
            PG8_WAIT_V(6); PG8_BAR; PG8_MMA(1, 1, At, B1); PG8_BAR;
        }
        if (wr == 0) PG8_BAR;
        E(acc, cur, wr, wc, fr, fq);
        if (wr == 1) PG8_BAR;
        if (!has_next) break;
#pragma unroll
        for (int a = 0; a < 2; ++a)
#pragma unroll
            for (int b = 0; b < 2; ++b)
#pragma unroll
                for (int m = 0; m < 4; ++m)
#pragma unroll
                    for (int n = 0; n < 2; ++n) acc[a][b][m][n] = (f32x4){0.f, 0.f, 0.f, 0.f};
        cur = nxt; cA = nA; cB = nB; ++ui;
    }
    PG8_WAIT_V(0);
    if (wr == 0) PG8_BAR;
    PG8_BAR;
#undef PG8_APANEL
#undef PG8_SA
#undef PG8_SB
#undef PG8_STAGE
#undef PG8_LDA
#undef PG8_LDB
#undef PG8_MMA
#undef PG8_WAIT_V
#undef PG8_WAIT_L
#undef PG8_BAR
#undef PG8_SCHED
}
}

template <bool INPROJ = false>
__device__ __forceinline__ void p0_transpose_item(const float* W, int K, int ldN, int nblk, bf16_t* WT, const float* gain, LAS float* scr, int item, int lane) {
    const int kb = item / nblk, nb = item % nblk, k0 = 64 * kb, n0 = 32 * nb;
    const int dn0 = !INPROJ || n0 < 512 ? n0 : (n0 < 1024 ? 512 + ((n0 - 512) >> 7) * 256 + ((n0 - 512) & 127) : 512 + ((n0 - 1024) >> 7) * 256 + 128 + ((n0 - 1024) & 127));
    float wv[32];
#pragma unroll
    for (int i = 0; i < 32; ++i) wv[i] = W[(size_t)(k0 + 2 * i + (lane >> 5)) * ldN + n0 + (lane & 31)];
#pragma unroll
    for (int i = 0; i < 32; ++i) { const int kk = 2 * i + (lane >> 5); const float gk = gain ? gain[k0 + kk] : 1.f;
        scr[kk * 33 + (lane & 31)] = wv[i] * gk; }
    asm volatile("s_waitcnt lgkmcnt(0)" ::: "memory");
    const int c = lane & 7;
#pragma unroll
    for (int j = 0; j < 4; ++j) { const int n = (lane >> 3) + 8 * j; const LAS float* s = scr + (8 * c) * 33 + n;
        u32x4 o; o.x = cvt_pk_bf16(s[0 * 33], s[1 * 33]); o.y = cvt_pk_bf16(s[2 * 33], s[3 * 33]); o.z = cvt_pk_bf16(s[4 * 33], s[5 * 33]); o.w = cvt_pk_bf16(s[6 * 33], s[7 * 33]);
        *(u32x4*)(WT + (size_t)(dn0 + n) * K + k0 + 8 * c) = o; }
    asm volatile("s_waitcnt lgkmcnt(0)" ::: "memory");
}
__device__ __forceinline__ void p0_fold_item(const float* Win  , const float* gpre, bf16_t* WT  , const LAS float* tab, int item, int lane) {
    const int kb = item >> 3, g = item & 7, k = kb * 64 + lane;
    const float gk = gpre[k] * 0.125f;
    const f32x4* src = (const f32x4*)(Win + (size_t)k * DIN + 1536 + g * 64);
    float row[64];
#pragma unroll
    for (int i = 0; i < 16; ++i) { const f32x4 v = src[i]; row[4 * i] = v.x * gk; row[4 * i + 1] = v.y * gk; row[4 * i + 2] = v.z * gk; row[4 * i + 3] = v.w * gk; }
    for (int j = 0; j < 64; ++j) {
        const int cj = (j == 0) ? 0 : (j == 1 ? 32 : (j >> 1)), off = (j >= 2 && (j & 1)) ? 16 : 0;
        float acc = 0.f;
#pragma unroll
        for (int d = 0; d < 64; ++d) acc += row[d] * tab[(cj * d + off) & 63];
        WT[(size_t)(1536 + g * 64 + j) * D + k] = (bf16_t)(cvt_pk_bf16(acc, 0.f) & 0xffffu);
    }
}
template <int NR>
__device__ __forceinline__ void x_rows_init(const float* xrow0, bf16_t* orow0, float* rs, int lane) {
    f32x4 v[NR][4];
#pragma unroll
    for (int r = 0; r < NR; ++r) { const f32x4* xr = (const f32x4*)(xrow0 + (size_t)r * D) + lane;
#pragma unroll
        for (int j = 0; j < 4; ++j) v[r][j] = xr[64 * j]; }
#pragma unroll
    for (int r = 0; r < NR; ++r) { float s = 0.f;
#pragma unroll
        for (int j = 0; j < 4; ++j) s += (v[r][j].x * v[r][j].x + v[r][j].y * v[r][j].y) + (v[r][j].z * v[r][j].z + v[r][j].w * v[r][j].w);
        const float rstd = rsqrtf(wave_sum(s) * (1.f / D) + EPS);
        u32x2* o8 = (u32x2*)(orow0 + (size_t)r * D) + lane;
#pragma unroll
        for (int j = 0; j < 4; ++j) { u32x2 w; w.x = cvt_pk_bf16(v[r][j].x, v[r][j].y); w.y = cvt_pk_bf16(v[r][j].z, v[r][j].w); o8[64 * j] = w; }
        if (lane == 0) rs[r] = rstd; }
}

template <int NR>
__device__ __forceinline__ void row_pass_rows(bf16_t* X, const bf16_t* MF, const float* gain, float* rs, float* outf, bool unscaled, int t0, int lane) {
    u32x4 xa[NR][2], ma[NR][2];
#pragma unroll
    for (int r = 0; r < NR; ++r) { const u32x4* xr = (const u32x4*)(X + (size_t)(t0 + r) * D); const u32x4* mr = (const u32x4*)(MF + (size_t)(t0 + r) * D);
        xa[r][0] = xr[lane]; xa[r][1] = xr[64 + lane]; ma[r][0] = mr[lane]; ma[r][1] = mr[64 + lane]; }
    float g[16];
    { const f32x4* g0 = (const f32x4*)(gain + lane * 8); const f32x4* g1 = (const f32x4*)(gain + 512 + lane * 8);
#pragma unroll
      for (int h = 0; h < 2; ++h) { const f32x4 a = g0[h], b = g1[h];
#pragma unroll
        for (int k = 0; k < 4; ++k) { g[4 * h + k] = a[k]; g[8 + 4 * h + k] = b[k]; } } }
#pragma unroll
    for (int r = 0; r < NR; ++r) {
        float x[16], m[16];
#pragma unroll
        for (int h = 0; h < 2; ++h) { const u32x4 xq = xa[r][h], mq = ma[r][h];
            x[8 * h + 0] = bf_lo(xq.x); x[8 * h + 1] = bf_hi(xq.x); x[8 * h + 2] = bf_lo(xq.y); x[8 * h + 3] = bf_hi(xq.y); x[8 * h + 4] = bf_lo(xq.z); x[8 * h + 5] = bf_hi(xq.z); x[8 * h + 6] = bf_lo(xq.w); x[8 * h + 7] = bf_hi(xq.w);
            m[8 * h + 0] = bf_lo(mq.x); m[8 * h + 1] = bf_hi(mq.x); m[8 * h + 2] = bf_lo(mq.y); m[8 * h + 3] = bf_hi(mq.y); m[8 * h + 4] = bf_lo(mq.z); m[8 * h + 5] = bf_hi(mq.z); m[8 * h + 6] = bf_lo(mq.w); m[8 * h + 7] = bf_hi(mq.w); }
        float sm = 0.f;
#pragma unroll
        for (int k = 0; k < 16; ++k) sm += m[k] * m[k];
        float eps_eff = EPS; if (unscaled) { const float rr = rs[t0 + r], r2 = rr * rr; eps_eff = EPS / (r2 * r2); }
        const float rm = rsqrtf(wave_sum(sm) * (1.f / D) + eps_eff);
        float s1 = 0.f;
#pragma unroll
        for (int k = 0; k < 16; ++k) { x[k] = x[k] + m[k] * rm * g[k]; s1 += x[k] * x[k]; }
        if (outf) {
            f32x4* o = (f32x4*)(outf + (size_t)(t0 + r) * D);
            o[lane * 2] = (f32x4){x[0], x[1], x[2], x[3]}; o[lane * 2 + 1] = (f32x4){x[4], x[5], x[6], x[7]};
            o[128 + lane * 2] = (f32x4){x[8], x[9], x[10], x[11]}; o[128 + lane * 2 + 1] = (f32x4){x[12], x[13], x[14], x[15]};
        } else {
            const float r1 = rsqrtf(wave_sum(s1) * (1.f / D) + EPS);
            u32x4* xo = (u32x4*)(X + (size_t)(t0 + r) * D);
            u32x4 w0, w1;
            w0.x = cvt_pk_bf16(x[0], x[1]); w0.y = cvt_pk_bf16(x[2], x[3]); w0.z = cvt_pk_bf16(x[4], x[5]); w0.w = cvt_pk_bf16(x[6], x[7]);
            w1.x = cvt_pk_bf16(x[8], x[9]); w1.y = cvt_pk_bf16(x[10], x[11]); w1.z = cvt_pk_bf16(x[12], x[13]); w1.w = cvt_pk_bf16(x[14], x[15]);
            xo[lane] = w0; xo[64 + lane] = w1;
            if (lane == 0) rs[t0 + r] = r1;
        }
    }
}

__device__ __forceinline__ void conv_wave_item(const bf16_t* p, const float* cw, bf16_t* Hm, int t0, int pos0, int S, int lane) {
    float w0[8], w1[8], w2[8];
    { const f32x4* a = (const f32x4*)(cw + lane * 8); const f32x4* b = (const f32x4*)(cw + 512 + lane * 8); const f32x4* c = (const f32x4*)(cw + 1024 + lane * 8);
#pragma unroll
      for (int h = 0; h < 2; ++h) { const f32x4 va = a[h], vb = b[h], vc = c[h];
#pragma unroll
        for (int k = 0; k < 4; ++k) { w0[4 * h + k] = va[k]; w1[4 * h + k] = vb[k]; w2[4 * h + k] = vc[k]; } } }
    float zp[8], zc[8], zn[8], gb[8];
    const bf16_t* base = p + (size_t)t0 * PLD + lane * 8;
    if (pos0 == 0) {
#pragma unroll
        for (int k = 0; k < 8; ++k) zp[k] = 0.f;
    } else load8(base - PLD + 512, zp);
    load8(base + 512, zc);
#pragma unroll 8
    for (int i = 0; i < 16; ++i) {
        const bf16_t* r = base + (size_t)i * PLD;
        if (pos0 + i + 1 == S) {
#pragma unroll
            for (int k = 0; k < 8; ++k) zn[k] = 0.f;
        } else load8(r + PLD + 512, zn);
        load8(r, gb);
        float y[8], ss = 0.f;
#pragma unroll
        for (int k = 0; k < 8; ++k) { y[k] = gb[k] * (zp[k] * w0[k] + zc[k] * w1[k] + zn[k] * w2[k]); ss += y[k] * y[k]; }
        ss += __shfl_xor(ss, 1); ss += __shfl_xor(ss, 2); ss += __shfl_xor(ss, 4);
        const float rs = rsqrtf(ss * (1.f / 64.f) + EPS);
        u32x4 o; o.x = cvt_pk_bf16(y[0] * rs, y[1] * rs); o.y = cvt_pk_bf16(y[2] * rs, y[3] * rs); o.z = cvt_pk_bf16(y[4] * rs, y[5] * rs); o.w = cvt_pk_bf16(y[6] * rs, y[7] * rs);
        *(u32x4*)(Hm + (size_t)(t0 + i) * D + lane * 8) = o;
#pragma unroll
        for (int k = 0; k < 8; ++k) { zp[k] = zc[k]; zc[k] = zn[k]; }
    }
}

constexpr int XSTR = 272;
constexpr int RSTR = 34;
constexpr int LDS_XT = 0, LDS_R = 36864, LDS_OST = 106496;
#define LBAR() do { asm volatile("s_waitcnt lgkmcnt(0)" ::: "memory"); __builtin_amdgcn_s_barrier(); asm volatile("" ::: "memory"); } while (0)
__device__ __forceinline__ int seq_base(int bs) { return bs < BP ? bs * SP : TP + (bs - BP) * SS; }

__device__ __forceinline__ void dft_frags(bf16x8 (&Br)[4], bf16x8 (&Bi)[4], int log2n, int kt, int lane) {
    const int N = 1 << log2n, k = 16 * kt + (lane & 15); const float sc = 2.f / (float)N;
#pragma unroll
    for (int ks = 0; ks < 4; ++ks) { u32x4 wr, wi;
#pragma unroll
        for (int e2 = 0; e2 < 4; ++e2) { float c0, s0, c1, s1; const int n0 = 32 * ks + 8 * (lane >> 4) + 2 * e2;
            sincospif(-(float)((n0 * k) & (N - 1)) * sc, &s0, &c0); sincospif(-(float)(((n0 + 1) * k) & (N - 1)) * sc, &s1, &c1);
            wr[e2] = cvt_pk_bf16(c0, c1); wi[e2] = cvt_pk_bf16(s0, s1); }
        Br[ks] = __builtin_bit_cast(bf16x8, wr); Bi[ks] = __builtin_bit_cast(bf16x8, wi); }
}
__device__ __forceinline__ void xt_write(LAS unsigned char* xt, int rp, int ch, const u32x4 va, const u32x4 vb) {
    LAS unsigned char* base = xt + (8 * ch) * XSTR + ((((rp >> 2) ^ ch) << 4) + (rp & 3) * 4);
#pragma unroll
    for (int e2 = 0; e2 < 4; ++e2) {
        *(LAS unsigned*)(base + (2 * e2) * XSTR) = (va[e2] & 0xffffu) | (vb[e2] << 16);
        *(LAS unsigned*)(base + (2 * e2 + 1) * XSTR) = (va[e2] >> 16) | (vb[e2] & 0xffff0000u); }
}
__device__ __forceinline__ void dft_mfma(const LAS unsigned char* xt, int log2n, const bf16x8 (&Br)[4], const bf16x8 (&Bi)[4], f32x4 (&Pa)[4], f32x4 (&Qa)[4], int lane) {
#pragma unroll
    for (int it = 0; it < 4; ++it) { Pa[it] = (f32x4){0.f, 0.f, 0.f, 0.f}; Qa[it] = (f32x4){0.f, 0.f, 0.f, 0.f}; }
#pragma unroll
    for (int ks = 0; ks < 4; ++ks) if (ks < (1 << (log2n - 5))) {
#pragma unroll
        for (int it = 0; it < 4; ++it) { const int col = 16 * it + (lane & 15), gr = 4 * ks + (lane >> 4);
            const bf16x8 a = *(const LAS bf16x8*)(xt + col * XSTR + ((gr ^ (col >> 3)) << 4));
            Pa[it] = __builtin_amdgcn_mfma_f32_16x16x32_bf16(a, Br[ks], Pa[it], 0, 0, 0);
            Qa[it] = __builtin_amdgcn_mfma_f32_16x16x32_bf16(a, Bi[ks], Qa[it], 0, 0, 0); } }
}

__device__ __forceinline__ void p1_decode(int item, int& bs, int& g, int& n2, int& S, int& log2N2) {
    if (item < 2048) { bs = item >> 10; const int r = item & 1023; n2 = r >> 3; g = r & 7; S = SP; log2N2 = 7; }
    else { const int it = item - 2048; bs = BP + (it >> 9); const int r = it & 511; n2 = r >> 3; g = r & 7; S = SS; log2N2 = 6; }
}
__device__ __forceinline__ void p1_load(const bf16_t* p, int item, int rp, int ch, u32x4& va, u32x4& vb) {
    int bs, g, n2, S, l2; p1_decode(item, bs, g, n2, S, l2);
    const bf16_t* src = p + (size_t)(seq_base(bs) + ((2 * rp) << l2) + n2) * PLD + 1024 + g * 64 + ch * 8;
    va = *(const u32x4*)src; vb = *(const u32x4*)(src + ((size_t)PLD << l2));
}
__device__ __forceinline__ void fft_pass1(const bf16_t* p, bf16_t* inter, LAS unsigned char* lds, int bid, int G, int tid) {
    constexpr int NP1 = 2048 + 4096;
    const int lane = tid & 63, wave = __builtin_amdgcn_readfirstlane(tid >> 6), rp = tid >> 3, ch = tid & 7;
    bf16x8 Br[4], Bi[4]; dft_frags(Br, Bi, 7, wave, lane);
    u32x4 va, vb;
    if (bid < NP1) p1_load(p, bid, rp, ch, va, vb);
    int par = 0;
    for (int item = bid; item < NP1; item += G, par ^= 1) {
        LAS unsigned char* xt = lds + LDS_XT + par * (64 * XSTR);
        xt_write(xt, rp, ch, va, vb);
        if (item + G < NP1) p1_load(p, item + G, rp, ch, va, vb);
        LBAR();
        f32x4 Pa[4], Qa[4]; dft_mfma(xt, 7, Br, Bi, Pa, Qa, lane);
        int bs, g, n2, S, l2; p1_decode(item, bs, g, n2, S, l2);
        const int k1 = 16 * wave + (lane & 15), quad = lane >> 4;
        float sn, cs; sincospif(-2.0f * (float)(n2 * k1) / (float)S, &sn, &cs);
        bf16_t* dst = inter + ((size_t)seq_base(bs) * 8 + (size_t)g * S + ((size_t)k1 << l2) + n2) * 64 + 4 * quad;
#pragma unroll
        for (int it = 0; it < 4; ++it) {
            const float r0 = Pa[it][0] - Qa[it][1], i0 = Pa[it][1] + Qa[it][0], r1 = Pa[it][2] - Qa[it][3], i1 = Pa[it][3] + Qa[it][2];
            u32x2 w; w.x = cvt_pk_bf16(r0 * cs - i0 * sn, r0 * sn + i0 * cs); w.y = cvt_pk_bf16(r1 * cs - i1 * sn, r1 * sn + i1 * cs);
            *(u32x2*)(dst + 16 * it) = w; }
    }
    LBAR();
}

__device__ __forceinline__ void p2_decode(int item, int& bs, int& g, int& k1a, int& k1b, int& ip) {
    int r;
    if (item < 1024) { bs = item >> 9; r = item & 511; } else { const int it = item - 1024; bs = BP + (it >> 9); r = it & 511; }
    g = r >> 6; ip = r & 63; k1a = ip; k1b = ip == 0 ? 64 : 128 - ip;
}
template <int LOG2N>
__device__ __forceinline__ void fft_pass2(const bf16_t* inter, bf16_t* Hm, LAS unsigned char* lds, int item0, int item_end, int G, int tid) {
    constexpr int N2 = 1 << LOG2N, NTASK = N2 / 64, S = (LOG2N == 7) ? SP : SS;
    const int lane = tid & 63, wave = __builtin_amdgcn_readfirstlane(tid >> 6);
    bf16x8 Br[4], Bi[4]; dft_frags(Br, Bi, LOG2N, LOG2N == 7 ? wave : (wave & 3), lane);
    u32x4 va[NTASK], vb[NTASK];
#define P2_LOAD(item_) do { int bs_, g_, ka_, kb_, ip_; p2_decode(item_, bs_, g_, ka_, kb_, ip_); \
        const bf16_t* ib_ = inter + ((size_t)seq_base(bs_) * 8 + (size_t)g_ * S) * 64; \
        _Pragma("unroll") for (int j = 0; j < NTASK; ++j) { const int q = tid + NTHREADS * j, h = q / (4 * N2), r = q % (4 * N2), rp = r >> 3, ch = r & 7; \
            const bf16_t* src = ib_ + ((size_t)((h ? kb_ : ka_) * N2 + 2 * rp)) * 64 + ch * 8; va[j] = *(const u32x4*)src; vb[j] = *(const u32x4*)(src + 64); } } while (0)
    if (item0 < item_end) P2_LOAD(item0);
    LAS f32x2* R = (LAS f32x2*)(lds + LDS_R);
    LAS bf16_t* Ost = (LAS bf16_t*)(lds + LDS_OST);
    const float sc = rsqrtf((float)S);
    for (int item = item0; item < item_end; item += G) {
#pragma unroll
        for (int j = 0; j < NTASK; ++j) { const int q = tid + NTHREADS * j, h = q / (4 * N2), r = q % (4 * N2);
            xt_write(lds + LDS_XT + h * (64 * XSTR), r >> 3, r & 7, va[j], vb[j]); }
        if (item + G < item_end) P2_LOAD(item + G);
        LBAR();
        {
            f32x4 Pa[4], Qa[4]; const int quad = lane >> 4;
#pragma unroll
            for (int hh = 0; hh < (LOG2N == 7 ? 2 : 1); ++hh) {
                const int h = (LOG2N == 7) ? hh : (wave >> 2), kt = (LOG2N == 7) ? wave : (wave & 3);
                dft_mfma(lds + LDS_XT + h * (64 * XSTR), LOG2N, Br, Bi, Pa, Qa, lane);
                LAS f32x2* Rr = R + (h * N2 + 16 * kt + (lane & 15)) * RSTR + 2 * quad;
#pragma unroll
                for (int it = 0; it < 4; ++it)
                    *(LAS f32x4*)(Rr + 8 * it) = (f32x4){Pa[it][0] - Qa[it][1], Pa[it][1] + Qa[it][0], Pa[it][2] - Qa[it][3], Pa[it][3] + Qa[it][2]};
            }
        }
        LBAR();
        int bs, g, k1a, k1b, ip; p2_decode(item, bs, g, k1a, k1b, ip);
        const int tb = seq_base(bs);
        for (int idx = tid; idx < 2 * N2 * 32; idx += NTHREADS) {
            const int c = idx & 31, tl = idx >> 5, h = tl >> LOG2N, k2 = tl & (N2 - 1);
            const int ph = (ip == 0) ? h : 1 - h;
            const int k2p = (ip == 0 && h == 0) ? ((N2 - k2) & (N2 - 1)) : (N2 - 1 - k2);
            const f32x2 own = R[(h * N2 + k2) * RSTR + c], par = R[(ph * N2 + k2p) * RSTR + c];
            float v1 = (c == 0) ? 0.5f * (own.x + par.x) : own.x, v2 = (c == 0) ? 0.5f * (own.y + par.y) : par.x;
            v1 *= sc; v2 *= sc;
            float ss = v1 * v1 + v2 * v2;
            ss += __shfl_xor(ss, 1); ss += __shfl_xor(ss, 2); ss += __shfl_xor(ss, 4); ss += __shfl_xor(ss, 8); ss += __shfl_xor(ss, 16);
            const float rs = rsqrtf(ss * (1.f / 64.f) + EPS);
            Ost[tl * 64 + c] = (bf16_t)(cvt_pk_bf16(v1 * rs, 0.f) & 0xffffu);
            Ost[tl * 64 + (c == 0 ? 32 : 64 - c)] = (bf16_t)(cvt_pk_bf16(v2 * rs, 0.f) & 0xffffu);
        }
        LBAR();
        for (int idx = tid; idx < 2 * N2 * 8; idx += NTHREADS) {
            const int tl = idx >> 3, ch = idx & 7, h = tl >> LOG2N, k2 = tl & (N2 - 1);
            const int tok = tb + (h ? k1b : k1a) + 128 * k2;
            *(u32x4*)(Hm + (size_t)tok * D + 512 + g * 64 + ch * 8) = ((const LAS u32x4*)Ost)[idx];
        }
    }
    LBAR();
#undef P2_LOAD
}

#define XB_TMO      128
#define XB_XCNT(j)  (256  + 64 * (j))
#define XB_XSUB(j)  (1280 + 64 * (j))
#define XB_XGEN(j)  (2304 + 64 * (j))
#define XB_TOP      3328
#define XB_TOPGEN   3392
#define XCD_BAR_WORDS 3456
#define XB_SPIN_CAP (1u << 20)
__device__ __forceinline__ unsigned xb_ld(unsigned* p)              { return __hip_atomic_load(p, __ATOMIC_RELAXED, __HIP_MEMORY_SCOPE_AGENT); }
__device__ __forceinline__ unsigned xb_add(unsigned* p, unsigned v) { return __hip_atomic_fetch_add(p, v, __ATOMIC_RELAXED, __HIP_MEMORY_SCOPE_AGENT); }
__device__ __forceinline__ unsigned xb_xcc_id() { return (unsigned)__builtin_amdgcn_s_getreg((3 << 11) | 20) & 0xFu; }
#define XB_SPIN(cond, bar) do { unsigned _sp = 0; while (cond) { __builtin_amdgcn_s_sleep(1); \
    if ((++_sp & 255u) == 0u) { if (xb_ld(&(bar)[XB_TMO])) break; if (_sp > XB_SPIN_CAP) { atomicAdd(&(bar)[XB_TMO], 1u); break; } } } } while (0)
struct XcdBarrier { unsigned* bar; unsigned x; volatile LAS unsigned* st; };
__device__ __forceinline__ XcdBarrier xcd_barrier_post(unsigned* bar, volatile LAS unsigned* st) {
    XcdBarrier b; b.bar = bar; b.x = xb_xcc_id(); b.st = st;
    if (threadIdx.x == 0) (void)xb_add(&bar[XB_XCNT(b.x)], 1u);
    return b;
}
__device__ __forceinline__ void xcd_barrier_complete(unsigned* bar, unsigned x, unsigned& nloc, unsigned& nx) {
    const unsigned G = gridDim.x * gridDim.y * gridDim.z;
    unsigned sum, cnt, mine, sp = 0u;
    for (;;) {
        sum = 0u; cnt = 0u; mine = 0u;
#pragma unroll
        for (unsigned j = 0; j < 16; ++j) { const unsigned c = xb_ld(&bar[XB_XCNT(j)]); sum += c; cnt += (c > 0u) ? 1u : 0u; mine = (j == x) ? c : mine; }
        if (sum == G) break;
        __builtin_amdgcn_s_sleep(1);
        if ((++sp & 255u) == 0u) { if (xb_ld(&bar[XB_TMO])) break; if (sp > XB_SPIN_CAP) { atomicAdd(&bar[XB_TMO], 1u); break; } }
    }
    nloc = mine > 0u ? mine : 1u; nx = cnt > 0u ? cnt : 1u;
}
__device__ __forceinline__ void xcd_barrier(const XcdBarrier& b) {
    asm volatile("s_waitcnt vmcnt(0)" ::: "memory");
    __syncthreads();
    if (threadIdx.x == 0) {
        unsigned* bar = b.bar;
        __builtin_amdgcn_s_waitcnt(0);
        unsigned nloc = b.st[0], nx = b.st[1];
        if (nloc == 0u) { xcd_barrier_complete(bar, b.x, nloc, nx); b.st[0] = nloc; b.st[1] = nx; }
        const unsigned old = xb_add(&bar[XB_XSUB(b.x)], 1u);
        const unsigned gen = old / nloc;
        if (old + 1u == (gen + 1u) * nloc) {
            __builtin_amdgcn_fence(__ATOMIC_RELEASE, "agent");
            asm volatile("s_waitcnt vmcnt(0)" ::: "memory");
            const unsigned og = xb_add(&bar[XB_TOP], 1u);
            const unsigned tg = og / nx;
            if (og + 1u == (tg + 1u) * nx) xb_add(&bar[XB_TOPGEN], 1u);
            else XB_SPIN(xb_ld(&bar[XB_TOPGEN]) == tg, bar);
            __builtin_amdgcn_fence(__ATOMIC_ACQUIRE, "agent");
            xb_add(&bar[XB_XGEN(b.x)], 1u);
            asm volatile("s_waitcnt vmcnt(0)" ::: "memory");
        } else {
            XB_SPIN(xb_ld(&bar[XB_XGEN(b.x)]) == gen, bar);
            __builtin_amdgcn_fence(__ATOMIC_ACQUIRE, "agent");
            asm volatile("s_waitcnt vmcnt(0)" ::: "memory");
        }
    }
    __syncthreads();
}

__global__ void __launch_bounds__(NTHREADS, 2) fwd_megakernel(Params P) {
    extern __shared__ __attribute__((aligned(16))) unsigned char shm[];
    cg::grid_group grid = cg::this_grid();
    LAS unsigned char* lds = (LAS unsigned char*)shm;
    const int G = gridDim.x, bid = blockIdx.x, NGW = G * NWAVES;
#define FRESH() int tid = threadIdx.x; asm volatile("" : "+v"(tid)); const int lane = tid & 63, wave = __builtin_amdgcn_readfirstlane(tid >> 6), gw = bid * NWAVES + wave; (void)lane; (void)gw
#define TAB ((LAS float*)(lds + LDS_MISC))
    { FRESH();
      if (tid < 64) TAB[tid] = cospif((float)tid * (1.f / 32.f));
      if (tid < 4) ((volatile LAS unsigned*)(lds + LDS_MISC + 1024))[tid] = 0u; }
    __syncthreads();
    const XcdBarrier xbar = xcd_barrier_post((unsigned*)P.ws, (volatile LAS unsigned*)(lds + LDS_MISC + 1024));
#define GSYNC() xcd_barrier(xbar)

    unsigned char* ws = P.ws;
#define Xb ((bf16_t*)(ws + WS_X))
#define Hb ((bf16_t*)(ws + WS_H))
#define Pb ((bf16_t*)P.out)
#define Ib ((bf16_t*)(ws + WS_INTER))
#define MFb ((bf16_t*)(ws + WS_MF))
#define A0b ((bf16_t*)(ws + WS_H))
#define A1b ((bf16_t*)P.out)
#define RSb ((float*)(ws + WS_RS))

    {
        FRESH();
        LAS float* scr = (LAS float*)(lds + wave * 8704);
        constexpr int I_IN = 16 * 48, I_OUT = 16 * 32, I_UP = 16 * 128, I_DN = 64 * 32, I_F = 128, I_L = I_IN + I_OUT + I_UP + I_DN + I_F;
        for (int it = gw; it < NL * I_L; it += NGW) {
            const int l = it / I_L; int r = it % I_L;
            bf16_t* Wl = (bf16_t*)(ws + WS_W + (size_t)l * WL_SZ);
            const float* win = P.w_in + (size_t)l * D * DIN;
            if (r < I_IN) { p0_transpose_item<true>(win, D, DIN, 48, Wl + WL_IN / 2, P.g_mix_pre + l * D, scr, r, lane); continue; } r -= I_IN;
            if (r < I_OUT) {
                const int kb = r / 32; const float* gsrc = kb < 8 ? P.g_conv_out + l * 512 : P.g_fourier_out + l * 512 - 512;
                p0_transpose_item(P.w_out + (size_t)l * D * D, D, D, 32, Wl + WL_OUT / 2, gsrc, scr, r, lane); continue; } r -= I_OUT;
            if (r < I_UP) { p0_transpose_item(P.w_up + (size_t)l * D * DFF, D, DFF, 128, Wl + WL_UP / 2, P.g_mlp_pre + l * D, scr, r, lane); continue; } r -= I_UP;
            if (r < I_DN) { p0_transpose_item(P.w_down + (size_t)l * DFF * D, DFF, D, 32, Wl + WL_DN / 2, nullptr, scr, r, lane); continue; } r -= I_DN;
            p0_fold_item(win, P.g_mix_pre + l * D, Wl + WL_IN / 2, TAB, r, lane);
        }
        for (int t = gw * 4; t < T; t += NGW * 4) x_rows_init<4>(t < TP ? P.xp + (size_t)t * D : P.xs + (size_t)(t - TP) * D, Xb + (size_t)t * D, RSb + t, lane);
    }
    grid.sync();

    for (int l = 0; l < NL; ++l) {
        const bf16_t* Wl = (const bf16_t*)(ws + WS_W + (size_t)l * WL_SZ);
        { pg8::Gemm g{Xb, Wl + WL_IN / 2, T, DIN, D, nullptr, 1 << 20}; pg8::StaticOrder S; S.init(T, DIN, G, bid); pg8::EpiInProj E{Pb, RSb};
          pg8::gemm_phase(lds, g, S, E); }
        GSYNC();
        {
            FRESH();
            constexpr int NCONV = T / 128;
            for (int it = bid; it < NCONV; it += G) { const int t0 = it * 128 + wave * 16; const int S = t0 < TP ? SP : SS; const int pos0 = t0 < TP ? (t0 & (SP - 1)) : ((t0 - TP) & (SS - 1));
                conv_wave_item(Pb, P.conv_w + (size_t)l * 3 * 512, Hb, t0, pos0, S, lane); }
            fft_pass1(Pb, Ib, lds, bid, G, tid);
        }
        GSYNC();
        { FRESH(); fft_pass2<7>(Ib, Hb, lds, bid, 1024, G, tid); }
        { FRESH(); fft_pass2<6>(Ib, Hb, lds, 1024 + bid, 1024 + 4096, G, tid); }
        GSYNC();
        { pg8::Gemm g{Hb, Wl + WL_OUT / 2, T, D, D, nullptr, 1 << 20}; pg8::StaticOrder S; S.init(T, D, G, bid); pg8::EpiBf16 E{MFb, D, 0, nullptr, nullptr, 1 << 20};
          pg8::gemm_phase(lds, g, S, E); }
        GSYNC();
        { FRESH();
          for (int t = gw * 8; t < T; t += NGW * 8) row_pass_rows<8>(Xb, MFb, P.g_mix_post + l * D, RSb, nullptr, false, t, lane); }
        GSYNC();
        { pg8::Gemm g{Xb, Wl + WL_UP / 2, T, DFF, D, nullptr, 1 << 20}; pg8::StaticOrder S; S.init(T, DFF, G, bid); pg8::EpiBf16 E{A0b, DFF, 1, nullptr, A1b, TCH / 256};
          pg8::gemm_phase(lds, g, S, E); }
        GSYNC();
        { pg8::Gemm g{A0b, Wl + WL_DN / 2, T, D, DFF, A1b, TCH / 256}; pg8::StaticOrder S; S.init(T, D, G, bid); pg8::EpiBf16 E{MFb, D, 0, nullptr, nullptr, 1 << 20};
          pg8::gemm_phase(lds, g, S, E); }
        GSYNC();
        { FRESH();
          float* outf = (l + 1 < NL) ? nullptr : P.out;
          for (int t = gw * 8; t < T; t += NGW * 8) row_pass_rows<8>(Xb, MFb, P.g_mlp_post + l * D, RSb, outf, true, t, lane); }
        if (l + 1 < NL) GSYNC();
    }
}

extern "C" void kernel_launch(void* const* d_in, const int* in_sizes, int n_in, void* d_out, int out_size, void* d_ws, size_t ws_size, hipStream_t stream) {
    static int grid_blocks = 0;
    if (grid_blocks == 0) {
        if (n_in != 13 || out_size != T * D || ws_size < WS_END) { fprintf(stderr, "kernel_launch: unexpected shapes (n_in %d, out %d, ws %zu, need %zu)\n", n_in, out_size, ws_size, (size_t)WS_END); grid_blocks = -1; return; }
        int dev = 0, cus = 0, per_cu = 0;
        hipGetDevice(&dev);
        hipDeviceGetAttribute(&cus, hipDeviceAttributeMultiprocessorCount, dev);
        if (hipFuncSetAttribute((const void*)fwd_megakernel, hipFuncAttributeMaxDynamicSharedMemorySize, LDS_BYTES) != hipSuccess) { fprintf(stderr, "kernel_launch: hipFuncSetAttribute failed\n"); grid_blocks = -1; return; }
        hipOccupancyMaxActiveBlocksPerMultiprocessor(&per_cu, (const void*)fwd_megakernel, NTHREADS, LDS_BYTES);
        if (per_cu < 1) { fprintf(stderr, "kernel_launch: occupancy query says %d blocks per CU\n", per_cu); per_cu = 1; }
        grid_blocks = cus * per_cu;
    }
    if (grid_blocks < 0) return;
    Params p{};
    p.xp = (const float*)d_in[0]; p.xs = (const float*)d_in[1]; p.g_mix_pre = (const float*)d_in[2]; p.w_in = (const float*)d_in[3]; p.conv_w = (const float*)d_in[4];
    p.g_conv_out = (const float*)d_in[5]; p.g_fourier_out = (const float*)d_in[6]; p.w_out = (const float*)d_in[7]; p.g_mix_post = (const float*)d_in[8];
    p.g_mlp_pre = (const float*)d_in[9]; p.w_up = (const float*)d_in[10]; p.w_down = (const float*)d_in[11]; p.g_mlp_post = (const float*)d_in[12];
    p.out = (float*)d_out; p.ws = (unsigned char*)d_ws;
    if (hipMemsetAsync(d_ws, 0, 16384, stream) != hipSuccess) { fprintf(stderr, "kernel_launch: memset failed\n"); return; }
    void* args[] = {&p};
    hipError_t e = hipLaunchCooperativeKernel((const void*)fwd_megakernel, dim3(grid_blocks), dim3(NTHREADS), args, LDS_BYTES, stream);
    if (e != hipSuccess) fprintf(stderr, "cooperative launch failed: %s (grid %d)\n", hipGetErrorString(e), grid_blocks);
}
```

```cpp
#include <hip/hip_runtime.h>
#include <hip/hip_cooperative_groups.h>
#include <cstdio>
namespace cg = cooperative_groups;

#define LAS __attribute__((address_space(3)))
typedef unsigned short bf16_t;
typedef short bf16x8 __attribute__((ext_vector_type(8)));
typedef float f32x4 __attribute__((ext_vector_type(4)));
typedef float f32x2 __attribute__((ext_vector_type(2)));
typedef unsigned u32x4 __attribute__((ext_vector_type(4)));
typedef unsigned u32x2 __attribute__((ext_vector_type(2)));

constexpr int D = 1024, DIN = 2048, DFF = 4096, NL = 4;
constexpr int PLD = 1536;
constexpr int SP = 16384, BP = 2, SS = 8192, BS = 8;
constexpr int TP = BP * SP, TS = BS * SS, T = TP + TS;
constexpr float EPS = 1e-6f;
constexpr int NCH = 2;
constexpr int TCH = T / NCH;

constexpr size_t MiB = (size_t)1 << 20;
constexpr size_t WS_W = 1 * MiB;
constexpr size_t WL_IN = 0, WL_OUT = 4 * MiB, WL_UP = 6 * MiB, WL_DN = 14 * MiB, WL_SZ = 22 * MiB;
constexpr size_t WS_X = WS_W + NL * WL_SZ;
constexpr size_t WS_H = WS_X + (size_t)T * D * 2;
constexpr size_t WS_INTER = WS_H + (size_t)T * D * 2;
constexpr size_t WS_MF = WS_INTER + (size_t)T * 256 * 8;
constexpr size_t WS_RS = WS_MF + (size_t)T * D * 2;
constexpr size_t WS_END = WS_RS + 1 * MiB;

constexpr int LDS_STAGE = 131072, LDS_MISC = 139264, LDS_BYTES = LDS_MISC + 4096;
constexpr int NTHREADS = 512, NWAVES = 8;

struct Params {
    const float* xp; const float* xs; const float* g_mix_pre; const float* w_in; const float* conv_w;
    const float* g_conv_out; const float* g_fourier_out; const float* w_out; const float* g_mix_post;
    const float* g_mlp_pre; const float* w_up; const float* w_down; const float* g_mlp_post;
    float* out; unsigned char* ws;
};

__device__ __forceinline__ unsigned cvt_pk_bf16(float lo, float hi) { unsigned r; asm volatile("v_cvt_pk_bf16_f32 %0, %1, %2" : "=v"(r) : "v"(lo), "v"(hi)); return r; }
__device__ __forceinline__ float bf_lo(unsigned w) { return __uint_as_float(w << 16); }
__device__ __forceinline__ float bf_hi(unsigned w) { return __uint_as_float(w & 0xffff0000u); }
__device__ __forceinline__ float wave_sum(float v) {
#pragma unroll
    for (int o = 1; o < 64; o <<= 1) v += __shfl_xor(v, o);
    return v;
}
__device__ __forceinline__ void load8(const bf16_t* ptr, float (&v)[8]) {
    const u32x4 q = *(const u32x4*)ptr;
    v[0] = bf_lo(q.x); v[1] = bf_hi(q.x); v[2] = bf_lo(q.y); v[3] = bf_hi(q.y); v[4] = bf_lo(q.z); v[5] = bf_hi(q.z); v[6] = bf_lo(q.w); v[7] = bf_hi(q.w);
}

namespace pg8 {
constexpr int BM = 256, BK = 64, HALF = 128, HTB = HALF * BK * 2, STAGE_BYTES = 8 * HTB, NXCD = 8, WGM = 8;
__device__ __forceinline__ int lds_byte(int r, int c) { const int st = (r >> 4) * 2 + (c >> 5), rr = r & 15, cc = c & 31, ob = rr * 64 + cc * 2; return st * 1024 + (ob ^ (((ob >> 9) & 1) << 5)); }
__device__ __forceinline__ void stage_rc(int b, int& R, int& C) { const int st = b / 1024, sb = b % 1024, swz = sb ^ (((sb >> 9) & 1) << 5); R = (st >> 1) * 16 + swz / 64; C = (st & 1) * 32 + (swz % 64) / 2; }
__device__ __forceinline__ int perm32(int rho) { const int n = rho >> 4, i = rho & 15; return 8 * (i >> 2) + 4 * n + (i & 3); }

struct Unit { int pm, pn; };
struct Gemm { const bf16_t* A; const bf16_t* Bt; int M, N, K; const bf16_t* A2; int split; };

struct StaticOrder {
    int nM, nN, nwg, G, c;
    __device__ void init(int M, int N, int G_, int c_) { nM = M / BM; nN = N / BM; nwg = nM * nN; G = G_; c = c_; }
    __device__ bool next(int i, Unit& u) const {
        const long L = (long)i * G + c; if (L >= nwg) return false;
        int wgid = (int)L; { const int q = nwg / NXCD, r = nwg % NXCD, xcd = wgid % NXCD, off = wgid / NXCD; wgid = (xcd < r ? xcd * (q + 1) : r * (q + 1) + (xcd - r) * q) + off; }
        const int nig = WGM * nN, gid = wgid / nig, fm = gid * WGM, gsz = (nM - fm) < WGM ? (nM - fm) : WGM;
        u.pm = fm + ((wgid % nig) % gsz); u.pn = (wgid % nig) / gsz; return true;
    }
};

struct EpiBf16 {
    static constexpr bool FUSED = false;
    bf16_t* O; int ldc; int act; const float* rs; bf16_t* O2; int split;
    __device__ __forceinline__ void operator()(const f32x4 (&acc)[2][2][4][2], const Unit& u, int wr, int wc, int fr, int fq) const {
        const bool lo = u.pm < split; bf16_t* Ob = lo ? O : O2;
        const int grow0 = u.pm * BM + wr * 64 + fr, row0 = grow0 - (lo ? 0 : split * BM); const int col0 = u.pn * BM + wc * 32 + 8 * fq;
#pragma unroll
        for (int ai = 0; ai < 2; ++ai)
#pragma unroll
            for (int m = 0; m < 4; ++m) { bf16_t* rowp = Ob + (size_t)(row0 + ai * HALF + m * 16) * ldc + col0; const float sc = rs ? rs[grow0 + ai * HALF + m * 16] : 1.f;
#pragma unroll
                for (int bj = 0; bj < 2; ++bj) { f32x4 v0 = acc[ai][bj][m][0] * sc, v1 = acc[ai][bj][m][1] * sc;
                    if (act) {
#pragma unroll
                        for (int j = 0; j < 4; ++j) { const float a0 = __builtin_amdgcn_fmed3f(v0[j], 0.f, __builtin_inff()), a1 = __builtin_amdgcn_fmed3f(v1[j], 0.f, __builtin_inff()); v0[j] = a0 * a0; v1[j] = a1 * a1; } }
                    u32x4 w; w.x = cvt_pk_bf16(v0[0], v0[1]); w.y = cvt_pk_bf16(v0[2], v0[3]); w.z = cvt_pk_bf16(v1[0], v1[1]); w.w = cvt_pk_bf16(v1[2], v1[3]);
                    *(u32x4*)(rowp + bj * HALF) = w; } }
    }
};


struct EpiInProj {
    static constexpr bool FUSED = false;
    bf16_t* O; const float* rs;
    __device__ __forceinline__ void operator()(const f32x4 (&acc)[2][2][4][2], const Unit& u, int wr, int wc, int fr, int fq) const {
        const int row0 = u.pm * BM + wr * 64 + fr, sub = wc * 32 + 8 * fq;
        const bool isz = (u.pn >= 2 && u.pn < 6);
        const int cbase = isz ? 512 + (u.pn - 2) * 128 + sub : (u.pn < 2 ? u.pn * BM + sub : 1024 + (u.pn - 6) * BM + sub);
#pragma unroll
        for (int ai = 0; ai < 2; ++ai)
#pragma unroll
            for (int m = 0; m < 4; ++m) { const int row = row0 + ai * HALF + m * 16; bf16_t* rowp = O + (size_t)row * PLD + cbase; const float sc = rs[row];
                if (isz) { const float s2 = sc * sc; const f32x4 z0 = acc[ai][0][m][0] * acc[ai][1][m][0] * s2, z1 = acc[ai][0][m][1] * acc[ai][1][m][1] * s2;
                    u32x4 w; w.x = cvt_pk_bf16(z0[0], z0[1]); w.y = cvt_pk_bf16(z0[2], z0[3]); w.z = cvt_pk_bf16(z1[0], z1[1]); w.w = cvt_pk_bf16(z1[2], z1[3]);
                    *(u32x4*)rowp = w; }
                else {
#pragma unroll
                    for (int bj = 0; bj < 2; ++bj) { const f32x4 v0 = acc[ai][bj][m][0] * sc, v1 = acc[ai][bj][m][1] * sc;
                        u32x4 w; w.x = cvt_pk_bf16(v0[0], v0[1]); w.y = cvt_pk_bf16(v0[2], v0[3]); w.z = cvt_pk_bf16(v1[0], v1[1]); w.w = cvt_pk_bf16(v1[2], v1[3]);
                        *(u32x4*)(rowp + bj * HALF) = w; } } }
    }
};

template <class Epi, class Sched>
__device__ __forceinline__ void gemm_phase(LAS unsigned char* lds, const Gemm g, const Sched& S, const Epi& E) {
    int tid_ = threadIdx.x; asm volatile("" : "+v"(tid_));
    const int tid = tid_, wid = __builtin_amdgcn_readfirstlane(tid >> 6), lane = tid & 63, wr = wid >> 2, wc = wid & 3, fr = lane & 15, fq = lane >> 4;
    const int K = g.K, nt = K / BK;
    unsigned voffA[2], voffB[2];
#pragma unroll
    for (int i = 0; i < 2; ++i) { int R, C; stage_rc(tid * 16 + i * 8192, R, C); const int Rb = (R & ~31) + perm32(R & 31);
        voffA[i] = (unsigned)(R * K + C) * 2u; voffB[i] = (unsigned)(Rb * K + C) * 2u; }
    const size_t kstep = (size_t)(BK * 2);
    const size_t hstep = (size_t)HALF * K * 2;
    const size_t tstep = 2 * hstep;
    const unsigned ldsw = (unsigned)wid * 1024u;
    const int aoff = lds_byte(wr * 64 + fr, fq * 8), boff = lds_byte(wc * 32 + fr, fq * 8);
#define PG8_SA(b, h) (((b) * 2 + (h)) * HTB)
#define PG8_SB(b, h) ((4 + (b) * 2 + (h)) * HTB)
#define PG8_STAGE(bufoff, gbase, voff) do { _Pragma("unroll") for (int _i = 0; _i < 2; ++_i) \
        __builtin_amdgcn_global_load_lds((const unsigned*)((const char*)(gbase) + (voff)[_i]), (LAS unsigned*)(lds + (bufoff) + ldsw + _i * 8192), 16, 0, 0); } while (0)
#define PG8_LDA(dst, b, h) do { _Pragma("unroll") for (int m = 0; m < 4; ++m) _Pragma("unroll") for (int k = 0; k < 2; ++k) dst[m][k] = *(const LAS bf16x8*)(lds + PG8_SA(b, h) + aoff + m * 2048 + k * 1024); } while (0)
#define PG8_LDB(dst, b, h) do { _Pragma("unroll") for (int n = 0; n < 2; ++n) _Pragma("unroll") for (int k = 0; k < 2; ++k) dst[n][k] = *(const LAS bf16x8*)(lds + PG8_SB(b, h) + boff + n * 2048 + k * 1024); } while (0)
#define PG8_MMA(ai, bj, At, Bt) do { __builtin_amdgcn_s_setprio(1); _Pragma("unroll") for (int m = 0; m < 4; ++m) _Pragma("unroll") for (int n = 0; n < 2; ++n) _Pragma("unroll") for (int k = 0; k < 2; ++k) \
        acc[ai][bj][m][n] = __builtin_amdgcn_mfma_f32_16x16x32_bf16(Bt[n][k], At[m][k], acc[ai][bj][m][n], 0, 0, 0); __builtin_amdgcn_s_setprio(0); } while (0)
#define PG8_WAIT_V(n) asm volatile("s_waitcnt vmcnt(" #n ")" ::: "memory")
#define PG8_WAIT_L(n) asm volatile("s_waitcnt lgkmcnt(" #n ")" ::: "memory")
#define PG8_BAR __builtin_amdgcn_s_barrier()
#define PG8_SCHED __builtin_amdgcn_sched_barrier(0)
    Unit cur, nxt; int ui = 0;
    if (!S.next(0, cur)) return;
    f32x4 acc[2][2][4][2];
#pragma unroll
    for (int a = 0; a < 2; ++a)
#pragma unroll
        for (int b = 0; b < 2; ++b)
#pragma unroll
            for (int m = 0; m < 4; ++m)
#pragma unroll
                for (int n = 0; n < 2; ++n) acc[a][b][m][n] = (f32x4){0.f, 0.f, 0.f, 0.f};
    bf16x8 At[4][2], B0[2][2], B1[2][2];
#define PG8_APANEL(pm_) ((const char*)(((pm_) < g.split ? (unsigned long long)g.A : (unsigned long long)g.A2 - (unsigned long long)g.split * tstep) + (unsigned long long)(pm_) * tstep))
    const char* cA = PG8_APANEL(cur.pm); const char* cB = (const char*)g.Bt + (size_t)cur.pn * tstep;
    PG8_STAGE(PG8_SB(0, 0), cB, voffB); PG8_STAGE(PG8_SA(0, 0), cA, voffA); PG8_STAGE(PG8_SB(0, 1), cB + hstep, voffB); PG8_STAGE(PG8_SA(0, 1), cA + hstep, voffA);
    if (wr == 1) PG8_BAR;
    PG8_WAIT_V(4); PG8_BAR;
    PG8_STAGE(PG8_SB(1, 0), cB + kstep, voffB); PG8_STAGE(PG8_SA(1, 0), cA + kstep, voffA); PG8_STAGE(PG8_SB(1, 1), cB + hstep + kstep, voffB);
    PG8_WAIT_V(6); PG8_BAR;
    for (;;) {
        const bool has_next = S.next(ui + 1, nxt);
        const char* nA = has_next ? PG8_APANEL(nxt.pm) : cA; const char* nB = has_next ? (const char*)g.Bt + (size_t)nxt.pn * tstep : cB;
        for (int t = 0; t < nt; t += 2) {
            const bool last = (t == nt - 2);
            const char* a1 = cA + (size_t)(t + 1) * kstep;
            const char* a2 = last ? nA : cA + (size_t)(t + 2) * kstep; const char* b2 = last ? nB : cB + (size_t)(t + 2) * kstep;
            const char* a3 = a2 + kstep; const char* b3 = b2 + kstep;
            PG8_LDB(B0, 0, 0); PG8_SCHED; PG8_LDA(At, 0, 0); PG8_STAGE(PG8_SA(1, 1), a1 + hstep, voffA);
            PG8_WAIT_L(8); PG8_BAR; PG8_WAIT_L(0); PG8_MMA(0, 0, At, B0); PG8_BAR; PG8_SCHED;
            PG8_LDB(B1, 0, 1); PG8_STAGE(PG8_SB(0, 0), b2, voffB);
            PG8_BAR; PG8_WAIT_L(0); PG8_MMA(0, 1, At, B1); PG8_BAR;
            PG8_LDA(At, 0, 1); PG8_STAGE(PG8_SA(0, 0), a2, voffA);
            PG8_BAR; PG8_WAIT_L(0); PG8_MMA(1, 0, At, B0); PG8_BAR; PG8_SCHED;
            PG8_STAGE(PG8_SB(0, 1), b2 + hstep, voffB);
            PG8_WAIT_V(6); PG8_BAR; PG8_MMA(1, 1, At, B1); PG8_BAR;
            PG8_LDB(B0, 1, 0); PG8_SCHED; PG8_LDA(At, 1, 0); PG8_STAGE(PG8_SA(0, 1), a2 + hstep, voffA);
            PG8_WAIT_L(8); PG8_BAR; PG8_WAIT_L(0); PG8_MMA(0, 0, At, B0); PG8_BAR; PG8_SCHED;
            PG8_LDB(B1, 1, 1); PG8_STAGE(PG8_SB(1, 0), b3, voffB);
            PG8_BAR; PG8_WAIT_L(0); PG8_MMA(0, 1, At, B1); PG8_BAR;
            PG8_LDA(At, 1, 1); PG8_STAGE(PG8_SA(1, 0), a3, voffA);
            PG8_BAR; PG8_WAIT_L(0); PG8_MMA(1, 0, At, B0); PG8_BAR; PG8_SCHED;
            PG8_STAGE(PG8_SB(1, 1), b3 + hstep, voffB);
            PG8_WAIT_V(6); PG8_BAR; PG8_MMA(1, 1, At, B1); PG8_BAR;
        }
        if (wr == 0) PG8_BAR;
        E(acc, cur, wr, wc, fr, fq);
        if (wr == 1) PG8_BAR;
        if (!has_next) break;
#pragma unroll
        for (int a = 0; a < 2; ++a)
#pragma unroll
            for (int b = 0; b < 2; ++b)
#pragma unroll
                for (int m = 0; m < 4; ++m)
#pragma unroll
                    for (int n = 0; n < 2; ++n) acc[a][b][m][n] = (f32x4){0.f, 0.f, 0.f, 0.f};
        cur = nxt; cA = nA; cB = nB; ++ui;
    }
    PG8_WAIT_V(0);
    if (wr == 0) PG8_BAR;
    PG8_BAR;
#undef PG8_APANEL
#undef PG8_SA
#undef PG8_SB
#undef PG8_STAGE
#undef PG8_LDA
#undef PG8_LDB
#undef PG8_MMA
#undef PG8_WAIT_V
#undef PG8_WAIT_L
#undef PG8_BAR
#undef PG8_SCHED
}
}

template <bool INPROJ = false>
__device__ __forceinline__ void p0_transpose_item(const float* W, int K, int ldN, int nblk, bf16_t* WT, const float* gain, LAS float* scr, int item, int lane) {
    const int kb = item / nblk, nb = item % nblk, k0 = 64 * kb, n0 = 32 * nb;
    const int dn0 = !INPROJ || n0 < 512 ? n0 : (n0 < 1024 ? 512 + ((n0 - 512) >> 7) * 256 + ((n0 - 512) & 127) : 512 + ((n0 - 1024) >> 7) * 256 + 128 + ((n0 - 1024) & 127));
    float wv[32];
#pragma unroll
    for (int i = 0; i < 32; ++i) wv[i] = W[(size_t)(k0 + 2 * i + (lane >> 5)) * ldN + n0 + (lane & 31)];
#pragma unroll
    for (int i = 0; i < 32; ++i) { const int kk = 2 * i + (lane >> 5); const float gk = gain ? gain[k0 + kk] : 1.f;
        scr[kk * 33 + (lane & 31)] = wv[i] * gk; }
    asm volatile("s_waitcnt lgkmcnt(0)" ::: "memory");
    const int c = lane & 7;
#pragma unroll
    for (int j = 0; j < 4; ++j) { const int n = (lane >> 3) + 8 * j; const LAS float* s = scr + (8 * c) * 33 + n;
        u32x4 o; o.x = cvt_pk_bf16(s[0 * 33], s[1 * 33]); o.y = cvt_pk_bf16(s[2 * 33], s[3 * 33]); o.z = cvt_pk_bf16(s[4 * 33], s[5 * 33]); o.w = cvt_pk_bf16(s[6 * 33], s[7 * 33]);
        *(u32x4*)(WT + (size_t)(dn0 + n) * K + k0 + 8 * c) = o; }
    asm volatile("s_waitcnt lgkmcnt(0)" ::: "memory");
}
__device__ __forceinline__ void p0_fold_item(const float* Win  , const float* gpre, bf16_t* WT  , const LAS float* tab, int item, int lane) {
    const int kb = item >> 3, g = item & 7, k = kb * 64 + lane;
    const float gk = gpre[k] * 0.125f;
    const f32x4* src = (const f32x4*)(Win + (size_t)k * DIN + 1536 + g * 64);
    float row[64];
#pragma unroll
    for (int i = 0; i < 16; ++i) { const f32x4 v = src[i]; row[4 * i] = v.x * gk; row[4 * i + 1] = v.y * gk; row[4 * i + 2] = v.z * gk; row[4 * i + 3] = v.w * gk; }
    for (int j = 0; j < 64; ++j) {
        const int cj = (j == 0) ? 0 : (j == 1 ? 32 : (j >> 1)), off = (j >= 2 && (j & 1)) ? 16 : 0;
        float acc = 0.f;
#pragma unroll
        for (int d = 0; d < 64; ++d) acc += row[d] * tab[(cj * d + off) & 63];
        WT[(size_t)(1536 + g * 64 + j) * D + k] = (bf16_t)(cvt_pk_bf16(acc, 0.f) & 0xffffu);
    }
}
template <int NR>
__device__ __forceinline__ void x_rows_init(const float* xrow0, bf16_t* orow0, float* rs, int lane) {
    f32x4 v[NR][4];
#pragma unroll
    for (int r = 0; r < NR; ++r) { const f32x4* xr = (const f32x4*)(xrow0 + (size_t)r * D) + lane;
#pragma unroll
        for (int j = 0; j < 4; ++j) v[r][j] = xr[64 * j]; }
#pragma unroll
    for (int r = 0; r < NR; ++r) { float s = 0.f;
#pragma unroll
        for (int j = 0; j < 4; ++j) s += (v[r][j].x * v[r][j].x + v[r][j].y * v[r][j].y) + (v[r][j].z * v[r][j].z + v[r][j].w * v[r][j].w);
        const float rstd = rsqrtf(wave_sum(s) * (1.f / D) + EPS);
        u32x2* o8 = (u32x2*)(orow0 + (size_t)r * D) + lane;
#pragma unroll
        for (int j = 0; j < 4; ++j) { u32x2 w; w.x = cvt_pk_bf16(v[r][j].x, v[r][j].y); w.y = cvt_pk_bf16(v[r][j].z, v[r][j].w); o8[64 * j] = w; }
        if (lane == 0) rs[r] = rstd; }
}

template <int NR>
__device__ __forceinline__ void row_pass_rows(bf16_t* X, const bf16_t* MF, const float* gain, float* rs, float* outf, bool unscaled, int t0, int lane) {
    u32x4 xa[NR][2], ma[NR][2];
#pragma unroll
    for (int r = 0; r < NR; ++r) { const u32x4* xr = (const u32x4*)(X + (size_t)(t0 + r) * D); const u32x4* mr = (const u32x4*)(MF + (size_t)(t0 + r) * D);
        xa[r][0] = xr[lane]; xa[r][1] = xr[64 + lane]; ma[r][0] = mr[lane]; ma[r][1] = mr[64 + lane]; }
    float g[16];
    { const f32x4* g0 = (const f32x4*)(gain + lane * 8); const f32x4* g1 = (const f32x4*)(gain + 512 + lane * 8);
#pragma unroll
      for (int h = 0; h < 2; ++h) { const f32x4 a = g0[h], b = g1[h];
#pragma unroll
        for (int k = 0; k < 4; ++k) { g[4 * h + k] = a[k]; g[8 + 4 * h + k] = b[k]; } } }
#pragma unroll
    for (int r = 0; r < NR; ++r) {
        float x[16], m[16];
#pragma unroll
        for (int h = 0; h < 2; ++h) { const u32x4 xq = xa[r][h], mq = ma[r][h];
            x[8 * h + 0] = bf_lo(xq.x); x[8 * h + 1] = bf_hi(xq.x); x[8 * h + 2] = bf_lo(xq.y); x[8 * h + 3] = bf_hi(xq.y); x[8 * h + 4] = bf_lo(xq.z); x[8 * h + 5] = bf_hi(xq.z); x[8 * h + 6] = bf_lo(xq.w); x[8 * h + 7] = bf_hi(xq.w);
            m[8 * h + 0] = bf_lo(mq.x); m[8 * h + 1] = bf_hi(mq.x); m[8 * h + 2] = bf_lo(mq.y); m[8 * h + 3] = bf_hi(mq.y); m[8 * h + 4] = bf_lo(mq.z); m[8 * h + 5] = bf_hi(mq.z); m[8 * h + 6] = bf_lo(mq.w); m[8 * h + 7] = bf_hi(mq.w); }
        float sm = 0.f;
#pragma unroll
        for (int k = 0; k < 16; ++k) sm += m[k] * m[k];
        float eps_eff = EPS; if (unscaled) { const float rr = rs[t0 + r], r2 = rr * rr; eps_eff = EPS / (r2 * r2); }
        const float rm = rsqrtf(wave_sum(sm) * (1.f / D) + eps_eff);
        float s1 = 0.f;
#pragma unroll
        for (int k = 0; k < 16; ++k) { x[k] = x[k] + m[k] * rm * g[k]; s1 += x[k] * x[k]; }
        if (outf) {
            f32x4* o = (f32x4*)(outf + (size_t)(t0 + r) * D);
            o[lane * 2] = (f32x4){x[0], x[1], x[2], x[3]}; o[lane * 2 + 1] = (f32x4){x[4], x[5], x[6], x[7]};
            o[128 + lane * 2] = (f32x4){x[8], x[9], x[10], x[11]}; o[128 + lane * 2 + 1] = (f32x4){x[12], x[13], x[14], x[15]};
        } else {
            const float r1 = rsqrtf(wave_sum(s1) * (1.f / D) + EPS);
            u32x4* xo = (u32x4*)(X + (size_t)(t0 + r) * D);
            u32x4 w0, w1;
            w0.x = cvt_pk_bf16(x[0], x[1]); w0.y = cvt_pk_bf16(x[2], x[3]); w0.z = cvt_pk_bf16(x[4], x[5]); w0.w = cvt_pk_bf16(x[6], x[7]);
            w1.x = cvt_pk_bf16(x[8], x[9]); w1.y = cvt_pk_bf16(x[10], x[11]); w1.z = cvt_pk_bf16(x[12], x[13]); w1.w = cvt_pk_bf16(x[14], x[15]);
            xo[lane] = w0; xo[64 + lane] = w1;
            if (lane == 0) rs[t0 + r] = r1;
        }
    }
}

__device__ __forceinline__ void conv_wave_item(const bf16_t* p, const float* cw, bf16_t* Hm, int t0, int pos0, int S, int lane) {
    float w0[8], w1[8], w2[8];
    { const f32x4* a = (const f32x4*)(cw + lane * 8); const f32x4* b = (const f32x4*)(cw + 512 + lane * 8); const f32x4* c = (const f32x4*)(cw + 1024 + lane * 8);
#pragma unroll
      for (int h = 0; h < 2; ++h) { const f32x4 va = a[h], vb = b[h], vc = c[h];
#pragma unroll
        for (int k = 0; k < 4; ++k) { w0[4 * h + k] = va[k]; w1[4 * h + k] = vb[k]; w2[4 * h + k] = vc[k]; } } }
    float zp[8], zc[8], zn[8], gb[8];
    const bf16_t* base = p + (size_t)t0 * PLD + lane * 8;
    if (pos0 == 0) {
#pragma unroll
        for (int k = 0; k < 8; ++k) zp[k] = 0.f;
    } else load8(base - PLD + 512, zp);
    load8(base + 512, zc);
#pragma unroll 8
    for (int i = 0; i < 16; ++i) {
        const bf16_t* r = base + (size_t)i * PLD;
        if (pos0 + i + 1 == S) {
#pragma unroll
            for (int k = 0; k < 8; ++k) zn[k] = 0.f;
        } else load8(r + PLD + 512, zn);
        load8(r, gb);
        float y[8], ss = 0.f;
#pragma unroll
        for (int k = 0; k < 8; ++k) { y[k] = gb[k] * (zp[k] * w0[k] + zc[k] * w1[k] + zn[k] * w2[k]); ss += y[k] * y[k]; }
        ss += __shfl_xor(ss, 1); ss += __shfl_xor(ss, 2); ss += __shfl_xor(ss, 4);
        const float rs = rsqrtf(ss * (1.f / 64.f) + EPS);
        u32x4 o; o.x = cvt_pk_bf16(y[0] * rs, y[1] * rs); o.y = cvt_pk_bf16(y[2] * rs, y[3] * rs); o.z = cvt_pk_bf16(y[4] * rs, y[5] * rs); o.w = cvt_pk_bf16(y[6] * rs, y[7] * rs);
        *(u32x4*)(Hm + (size_t)(t0 + i) * D + lane * 8) = o;
#pragma unroll
        for (int k = 0; k < 8; ++k) { zp[k] = zc[k]; zc[k] = zn[k]; }
    }
}

constexpr int XSTR = 272;
constexpr int RSTR = 34;
constexpr int LDS_XT = 0, LDS_R = 36864, LDS_OST = 106496;
#define LBAR() do { asm volatile("s_waitcnt lgkmcnt(0)" ::: "memory"); __builtin_amdgcn_s_barrier(); asm volatile("" ::: "memory"); } while (0)
__device__ __forceinline__ int seq_base(int bs) { return bs < BP ? bs * SP : TP + (bs - BP) * SS; }

__device__ __forceinline__ void dft_frags(bf16x8 (&Br)[4], bf16x8 (&Bi)[4], int log2n, int kt, int lane) {
    const int N = 1 << log2n, k = 16 * kt + (lane & 15); const float sc = 2.f / (float)N;
#pragma unroll
    for (int ks = 0; ks < 4; ++ks) { u32x4 wr, wi;
#pragma unroll
        for (int e2 = 0; e2 < 4; ++e2) { float c0, s0, c1, s1; const int n0 = 32 * ks + 8 * (lane >> 4) + 2 * e2;
            sincospif(-(float)((n0 * k) & (N - 1)) * sc, &s0, &c0); sincospif(-(float)(((n0 + 1) * k) & (N - 1)) * sc, &s1, &c1);
            wr[e2] = cvt_pk_bf16(c0, c1); wi[e2] = cvt_pk_bf16(s0, s1); }
        Br[ks] = __builtin_bit_cast(bf16x8, wr); Bi[ks] = __builtin_bit_cast(bf16x8, wi); }
}
template <int XS = XSTR>
__device__ __forceinline__ void xt_write(LAS unsigned char* xt, int rp, int ch, const u32x4 va, const u32x4 vb) {
    LAS unsigned char* base = xt + (8 * ch) * XS + ((((rp >> 2) ^ ch) << 4) + (rp & 3) * 4);
#pragma unroll
    for (int e2 = 0; e2 < 4; ++e2) {
        *(LAS unsigned*)(base + (2 * e2) * XS) = (va[e2] & 0xffffu) | (vb[e2] << 16);
        *(LAS unsigned*)(base + (2 * e2 + 1) * XS) = (va[e2] >> 16) | (vb[e2] & 0xffff0000u); }
}
template <int XS = XSTR>
__device__ __forceinline__ void dft_mfma(const LAS unsigned char* xt, int log2n, const bf16x8 (&Br)[4], const bf16x8 (&Bi)[4], f32x4 (&Pa)[4], f32x4 (&Qa)[4], int lane) {
#pragma unroll
    for (int it = 0; it < 4; ++it) { Pa[it] = (f32x4){0.f, 0.f, 0.f, 0.f}; Qa[it] = (f32x4){0.f, 0.f, 0.f, 0.f}; }
#pragma unroll
    for (int ks = 0; ks < 4; ++ks) if (ks < (1 << (log2n - 5))) {
#pragma unroll
        for (int it = 0; it < 4; ++it) { const int col = 16 * it + (lane & 15), gr = 4 * ks + (lane >> 4);
            const bf16x8 a = *(const LAS bf16x8*)(xt + col * XS + ((gr ^ (col >> 3)) << 4));
            Pa[it] = __builtin_amdgcn_mfma_f32_16x16x32_bf16(a, Br[ks], Pa[it], 0, 0, 0);
            Qa[it] = __builtin_amdgcn_mfma_f32_16x16x32_bf16(a, Bi[ks], Qa[it], 0, 0, 0); } }
}

__device__ __forceinline__ void p1_decode(int item, int& bs, int& g, int& n2, int& S, int& log2N2) {
    if (item < 2048) { bs = item >> 10; const int r = item & 1023; n2 = r >> 3; g = r & 7; S = SP; log2N2 = 7; }
    else { const int it = item - 2048; bs = BP + (it >> 9); const int r = it & 511; n2 = r >> 3; g = r & 7; S = SS; log2N2 = 6; }
}
__device__ __forceinline__ void p1_load(const bf16_t* p, int item, int rp, int ch, u32x4& va, u32x4& vb) {
    int bs, g, n2, S, l2; p1_decode(item, bs, g, n2, S, l2);
    const bf16_t* src = p + (size_t)(seq_base(bs) + ((2 * rp) << l2) + n2) * PLD + 1024 + g * 64 + ch * 8;
    va = *(const u32x4*)src; vb = *(const u32x4*)(src + ((size_t)PLD << l2));
}
__device__ __forceinline__ void fft_pass1(const bf16_t* p, bf16_t* inter, LAS unsigned char* lds, int bid, int G, int tid) {
    constexpr int NP1 = 2048 + 4096;
    const int lane = tid & 63, wave = __builtin_amdgcn_readfirstlane(tid >> 6), rp = tid >> 3, ch = tid & 7;
    bf16x8 Br[4], Bi[4]; dft_frags(Br, Bi, 7, wave, lane);
    u32x4 va, vb;
    if (bid < NP1) p1_load(p, bid, rp, ch, va, vb);
    int par = 0;
    for (int item = bid; item < NP1; item += G, par ^= 1) {
        LAS unsigned char* xt = lds + LDS_XT + par * (64 * XSTR);
        xt_write(xt, rp, ch, va, vb);
        if (item + G < NP1) p1_load(p, item + G, rp, ch, va, vb);
        LBAR();
        f32x4 Pa[4], Qa[4]; dft_mfma(xt, 7, Br, Bi, Pa, Qa, lane);
        int bs, g, n2, S, l2; p1_decode(item, bs, g, n2, S, l2);
        const int k1 = 16 * wave + (lane & 15), quad = lane >> 4;
        float sn, cs; sincospif(-2.0f * (float)(n2 * k1) / (float)S, &sn, &cs);
        bf16_t* dst = inter + ((size_t)seq_base(bs) * 8 + (size_t)g * S + ((size_t)k1 << l2) + n2) * 64 + 4 * quad;
#pragma unroll
        for (int it = 0; it < 4; ++it) {
            const float r0 = Pa[it][0] - Qa[it][1], i0 = Pa[it][1] + Qa[it][0], r1 = Pa[it][2] - Qa[it][3], i1 = Pa[it][3] + Qa[it][2];
            u32x2 w; w.x = cvt_pk_bf16(r0 * cs - i0 * sn, r0 * sn + i0 * cs); w.y = cvt_pk_bf16(r1 * cs - i1 * sn, r1 * sn + i1 * cs);
            *(u32x2*)(dst + 16 * it) = w; }
    }
    LBAR();
}

__device__ __forceinline__ void p2_decode(int item, int& bs, int& g, int& k1a, int& k1b, int& ip) {
    int r;
    if (item < 1024) { bs = item >> 9; r = item & 511; } else { const int it = item - 1024; bs = BP + (it >> 9); r = it & 511; }
    g = r >> 6; ip = r & 63; k1a = ip; k1b = ip == 0 ? 64 : 128 - ip;
}
template <int LOG2N>
__device__ __forceinline__ void fft_pass2(const bf16_t* inter, bf16_t* Hm, LAS unsigned char* lds, int item0, int item_end, int G, int tid) {
    constexpr int N2 = 1 << LOG2N, NTASK = N2 / 64, S = (LOG2N == 7) ? SP : SS;
    const int lane = tid & 63, wave = __builtin_amdgcn_readfirstlane(tid >> 6);
    bf16x8 Br[4], Bi[4]; dft_frags(Br, Bi, LOG2N, LOG2N == 7 ? wave : (wave & 3), lane);
    u32x4 va[NTASK], vb[NTASK];
#define P2_LOAD(item_) do { int bs_, g_, ka_, kb_, ip_; p2_decode(item_, bs_, g_, ka_, kb_, ip_); \
        const bf16_t* ib_ = inter + ((size_t)seq_base(bs_) * 8 + (size_t)g_ * S) * 64; \
        _Pragma("unroll") for (int j = 0; j < NTASK; ++j) { const int q = tid + NTHREADS * j, h = q / (4 * N2), r = q % (4 * N2), rp = r >> 3, ch = r & 7; \
            const bf16_t* src = ib_ + ((size_t)((h ? kb_ : ka_) * N2 + 2 * rp)) * 64 + ch * 8; va[j] = *(const u32x4*)src; vb[j] = *(const u32x4*)(src + 64); } } while (0)
    if (item0 < item_end) P2_LOAD(item0);
    LAS f32x2* R = (LAS f32x2*)(lds + LDS_R);
    LAS bf16_t* Ost = (LAS bf16_t*)(lds + LDS_OST);
    const float sc = rsqrtf((float)S);
    for (int item = item0; item < item_end; item += G) {
#pragma unroll
        for (int j = 0; j < NTASK; ++j) { const int q = tid + NTHREADS * j, h = q / (4 * N2), r = q % (4 * N2);
            xt_write(lds + LDS_XT + h * (64 * XSTR), r >> 3, r & 7, va[j], vb[j]); }
        if (item + G < item_end) P2_LOAD(item + G);
        LBAR();
        {
            f32x4 Pa[4], Qa[4]; const int quad = lane >> 4;
#pragma unroll
            for (int hh = 0; hh < (LOG2N == 7 ? 2 : 1); ++hh) {
                const int h = (LOG2N == 7) ? hh : (wave >> 2), kt = (LOG2N == 7) ? wave : (wave & 3);
                dft_mfma(lds + LDS_XT + h * (64 * XSTR), LOG2N, Br, Bi, Pa, Qa, lane);
                LAS f32x2* Rr = R + (h * N2 + 16 * kt + (lane & 15)) * RSTR + 2 * quad;
#pragma unroll
                for (int it = 0; it < 4; ++it)
                    *(LAS f32x4*)(Rr + 8 * it) = (f32x4){Pa[it][0] - Qa[it][1], Pa[it][1] + Qa[it][0], Pa[it][2] - Qa[it][3], Pa[it][3] + Qa[it][2]};
            }
        }
        LBAR();
        int bs, g, k1a, k1b, ip; p2_decode(item, bs, g, k1a, k1b, ip);
        const int tb = seq_base(bs);
        for (int idx = tid; idx < 2 * N2 * 32; idx += NTHREADS) {
            const int c = idx & 31, tl = idx >> 5, h = tl >> LOG2N, k2 = tl & (N2 - 1);
            const int ph = (ip == 0) ? h : 1 - h;
            const int k2p = (ip == 0 && h == 0) ? ((N2 - k2) & (N2 - 1)) : (N2 - 1 - k2);
            const f32x2 own = R[(h * N2 + k2) * RSTR + c], par = R[(ph * N2 + k2p) * RSTR + c];
            float v1 = (c == 0) ? 0.5f * (own.x + par.x) : own.x, v2 = (c == 0) ? 0.5f * (own.y + par.y) : par.x;
            v1 *= sc; v2 *= sc;
            float ss = v1 * v1 + v2 * v2;
            ss += __shfl_xor(ss, 1); ss += __shfl_xor(ss, 2); ss += __shfl_xor(ss, 4); ss += __shfl_xor(ss, 8); ss += __shfl_xor(ss, 16);
            const float rs = rsqrtf(ss * (1.f / 64.f) + EPS);
            Ost[tl * 64 + c] = (bf16_t)(cvt_pk_bf16(v1 * rs, 0.f) & 0xffffu);
            Ost[tl * 64 + (c == 0 ? 32 : 64 - c)] = (bf16_t)(cvt_pk_bf16(v2 * rs, 0.f) & 0xffffu);
        }
        LBAR();
        for (int idx = tid; idx < 2 * N2 * 8; idx += NTHREADS) {
            const int tl = idx >> 3, ch = idx & 7, h = tl >> LOG2N, k2 = tl & (N2 - 1);
            const int tok = tb + (h ? k1b : k1a) + 128 * k2;
            *(u32x4*)(Hm + (size_t)tok * D + 512 + g * 64 + ch * 8) = ((const LAS u32x4*)Ost)[idx];
        }
    }
    LBAR();
#undef P2_LOAD
}

__device__ __forceinline__ void fft_pass2s(const bf16_t* inter, bf16_t* Hm, LAS unsigned char* lds, int item0, int item_end, int G, int tid) {
    constexpr int N2 = 64, XS6 = 144, S = SS;
    const int lane = tid & 63, wave = __builtin_amdgcn_readfirstlane(tid >> 6);
    bf16x8 Br[4], Bi[4]; dft_frags(Br, Bi, 6, wave & 3, lane);
    u32x4 va[2], vb[2];
#define P2S_K1(ip_, hl_) ((hl_) == 0 ? (ip_) : ((ip_) == 0 ? 64 : 128 - (ip_)))
#define P2S_LOAD(item_) do { const int bs_ = BP + ((item_) >> 8), r_ = (item_) & 255, g_ = r_ >> 5, jp_ = r_ & 31; \
        const bf16_t* ib_ = inter + ((size_t)seq_base(bs_) * 8 + (size_t)g_ * S) * 64; \
        _Pragma("unroll") for (int j = 0; j < 2; ++j) { const int q = tid + NTHREADS * j, h = q >> 8, r = q & 255, rp = r >> 3, ch = r & 7, ip_ = 2 * jp_ + (h >> 1); \
            const bf16_t* src = ib_ + ((size_t)(P2S_K1(ip_, h & 1) * N2 + 2 * rp)) * 64 + ch * 8; va[j] = *(const u32x4*)src; vb[j] = *(const u32x4*)(src + 64); } } while (0)
    if (item0 < item_end) P2S_LOAD(item0);
    LAS f32x2* R = (LAS f32x2*)(lds + LDS_R);
    LAS bf16_t* Ost = (LAS bf16_t*)(lds + LDS_OST);
    const float sc = rsqrtf((float)S);
    for (int item = item0; item < item_end; item += G) {
#pragma unroll
        for (int j = 0; j < 2; ++j) { const int q = tid + NTHREADS * j, h = q >> 8, r = q & 255;
            xt_write<XS6>(lds + LDS_XT + h * (64 * XS6), r >> 3, r & 7, va[j], vb[j]); }
        if (item + G < item_end) P2S_LOAD(item + G);
        LBAR();
        {
            f32x4 Pa[4], Qa[4]; const int quad = lane >> 4, kt = wave & 3;
#pragma unroll
            for (int hh = 0; hh < 2; ++hh) { const int h = (wave >> 2) + 2 * hh;
                dft_mfma<XS6>(lds + LDS_XT + h * (64 * XS6), 6, Br, Bi, Pa, Qa, lane);
                LAS f32x2* Rr = R + (h * N2 + 16 * kt + (lane & 15)) * RSTR + 2 * quad;
#pragma unroll
                for (int it = 0; it < 4; ++it)
                    *(LAS f32x4*)(Rr + 8 * it) = (f32x4){Pa[it][0] - Qa[it][1], Pa[it][1] + Qa[it][0], Pa[it][2] - Qa[it][3], Pa[it][3] + Qa[it][2]};
            }
        }
        LBAR();
        const int bs = BP + (item >> 8), rr = item & 255, g = rr >> 5, jp = rr & 31, tb = seq_base(bs);
        for (int idx = tid; idx < 4 * N2 * 32; idx += NTHREADS) {
            const int c = idx & 31, tl = idx >> 5, h = tl >> 6, k2 = tl & (N2 - 1), ip = 2 * jp + (h >> 1);
            const int ph = (ip == 0) ? h : (h ^ 1);
            const int k2p = (ip == 0 && (h & 1) == 0) ? ((N2 - k2) & (N2 - 1)) : (N2 - 1 - k2);
            const f32x2 own = R[(h * N2 + k2) * RSTR + c], par = R[(ph * N2 + k2p) * RSTR + c];
            float v1 = (c == 0) ? 0.5f * (own.x + par.x) : own.x, v2 = (c == 0) ? 0.5f * (own.y + par.y) : par.x;
            v1 *= sc; v2 *= sc;
            float ss = v1 * v1 + v2 * v2;
            ss += __shfl_xor(ss, 1); ss += __shfl_xor(ss, 2); ss += __shfl_xor(ss, 4); ss += __shfl_xor(ss, 8); ss += __shfl_xor(ss, 16);
            const float rs = rsqrtf(ss * (1.f / 64.f) + EPS);
            Ost[tl * 64 + c] = (bf16_t)(cvt_pk_bf16(v1 * rs, 0.f) & 0xffffu);
            Ost[tl * 64 + (c == 0 ? 32 : 64 - c)] = (bf16_t)(cvt_pk_bf16(v2 * rs, 0.f) & 0xffffu);
        }
        LBAR();
        for (int idx = tid; idx < 4 * N2 * 8; idx += NTHREADS) {
            const int tl = idx >> 3, ch = idx & 7, h = tl >> 6, k2 = tl & (N2 - 1), ip = 2 * jp + (h >> 1);
            const int tok = tb + P2S_K1(ip, h & 1) + 128 * k2;
            *(u32x4*)(Hm + (size_t)tok * D + 512 + g * 64 + ch * 8) = ((const LAS u32x4*)Ost)[idx];
        }
    }
    LBAR();
#undef P2S_LOAD
#undef P2S_K1
}

#define XB_TMO      128
#define XB_XCNT(j)  (256  + 64 * (j))
#define XB_XSUB(j)  (1280 + 64 * (j))
#define XB_XGEN(j)  (2304 + 64 * (j))
#define XB_TOP      3328
#define XB_TOPGEN   3392
#define XCD_BAR_WORDS 3456
#define XB_SPIN_CAP (1u << 20)
__device__ __forceinline__ unsigned xb_ld(unsigned* p)              { return __hip_atomic_load(p, __ATOMIC_RELAXED, __HIP_MEMORY_SCOPE_AGENT); }
__device__ __forceinline__ unsigned xb_add(unsigned* p, unsigned v) { return __hip_atomic_fetch_add(p, v, __ATOMIC_RELAXED, __HIP_MEMORY_SCOPE_AGENT); }
__device__ __forceinline__ unsigned xb_xcc_id() { return (unsigned)__builtin_amdgcn_s_getreg((3 << 11) | 20) & 0xFu; }
#define XB_SPIN(cond, bar) do { unsigned _sp = 0; while (cond) { __builtin_amdgcn_s_sleep(1); \
    if ((++_sp & 255u) == 0u) { if (xb_ld(&(bar)[XB_TMO])) break; if (_sp > XB_SPIN_CAP) { atomicAdd(&(bar)[XB_TMO], 1u); break; } } } } while (0)
struct XcdBarrier { unsigned* bar; unsigned x; volatile LAS unsigned* st; };
__device__ __forceinline__ XcdBarrier xcd_barrier_post(unsigned* bar, volatile LAS unsigned* st) {
    XcdBarrier b; b.bar = bar; b.x = xb_xcc_id(); b.st = st;
    if (threadIdx.x == 0) (void)xb_add(&bar[XB_XCNT(b.x)], 1u);
    return b;
}
__device__ __forceinline__ void xcd_barrier_complete(unsigned* bar, unsigned x, unsigned& nloc, unsigned& nx) {
    const unsigned G = gridDim.x * gridDim.y * gridDim.z;
    unsigned sum, cnt, mine, sp = 0u;
    for (;;) {
        sum = 0u; cnt = 0u; mine = 0u;
#pragma unroll
        for (unsigned j = 0; j < 16; ++j) { const unsigned c = xb_ld(&bar[XB_XCNT(j)]); sum += c; cnt += (c > 0u) ? 1u : 0u; mine = (j == x) ? c : mine; }
        if (sum == G) break;
        __builtin_amdgcn_s_sleep(1);
        if ((++sp & 255u) == 0u) { if (xb_ld(&bar[XB_TMO])) break; if (sp > XB_SPIN_CAP) { atomicAdd(&bar[XB_TMO], 1u); break; } }
    }
    nloc = mine > 0u ? mine : 1u; nx = cnt > 0u ? cnt : 1u;
}
__device__ __forceinline__ void xcd_barrier(const XcdBarrier& b) {
    asm volatile("s_waitcnt vmcnt(0)" ::: "memory");
    __syncthreads();
    if (threadIdx.x == 0) {
        unsigned* bar = b.bar;
        __builtin_amdgcn_s_waitcnt(0);
        unsigned nloc = b.st[0], nx = b.st[1];
        if (nloc == 0u) { xcd_barrier_complete(bar, b.x, nloc, nx); b.st[0] = nloc; b.st[1] = nx; }
        const unsigned old = xb_add(&bar[XB_XSUB(b.x)], 1u);
        const unsigned gen = old / nloc;
        if (old + 1u == (gen + 1u) * nloc) {
            __builtin_amdgcn_fence(__ATOMIC_RELEASE, "agent");
            asm volatile("s_waitcnt vmcnt(0)" ::: "memory");
            const unsigned og = xb_add(&bar[XB_TOP], 1u);
            const unsigned tg = og / nx;
            if (og + 1u == (tg + 1u) * nx) xb_add(&bar[XB_TOPGEN], 1u);
            else XB_SPIN(xb_ld(&bar[XB_TOPGEN]) == tg, bar);
            __builtin_amdgcn_fence(__ATOMIC_ACQUIRE, "agent");
            xb_add(&bar[XB_XGEN(b.x)], 1u);
            asm volatile("s_waitcnt vmcnt(0)" ::: "memory");
        } else {
            XB_SPIN(xb_ld(&bar[XB_XGEN(b.x)]) == gen, bar);
            __builtin_amdgcn_fence(__ATOMIC_ACQUIRE, "agent");
            asm volatile("s_waitcnt vmcnt(0)" ::: "memory");
        }
    }
    __syncthreads();
}

__global__ void __launch_bounds__(NTHREADS, 2) fwd_megakernel(Params P) {
    extern __shared__ __attribute__((aligned(16))) unsigned char shm[];
    cg::grid_group grid = cg::this_grid();
    LAS unsigned char* lds = (LAS unsigned char*)shm;
    const int G = gridDim.x, bid = blockIdx.x, NGW = G * NWAVES;
#define FRESH() int tid = threadIdx.x; asm volatile("" : "+v"(tid)); const int lane = tid & 63, wave = __builtin_amdgcn_readfirstlane(tid >> 6), gw = bid * NWAVES + wave; (void)lane; (void)gw
#define TAB ((LAS float*)(lds + LDS_MISC))
    { FRESH();
      if (tid < 64) TAB[tid] = cospif((float)tid * (1.f / 32.f));
      if (tid < 4) ((volatile LAS unsigned*)(lds + LDS_MISC + 1024))[tid] = 0u; }
    __syncthreads();
    const XcdBarrier xbar = xcd_barrier_post((unsigned*)P.ws, (volatile LAS unsigned*)(lds + LDS_MISC + 1024));
#define GSYNC() xcd_barrier(xbar)

    unsigned char* ws = P.ws;
#define Xb ((bf16_t*)(ws + WS_X))
#define Hb ((bf16_t*)(ws + WS_H))
#define Pb ((bf16_t*)P.out)
#define Ib ((bf16_t*)(ws + WS_INTER))
#define MFb ((bf16_t*)(ws + WS_MF))
#define A0b ((bf16_t*)(ws + WS_H))
#define A1b ((bf16_t*)P.out)
#define RSb ((float*)(ws + WS_RS))

    {
        FRESH();
        LAS float* scr = (LAS float*)(lds + wave * 8704);
        constexpr int I_IN = 16 * 48, I_OUT = 16 * 32, I_UP = 16 * 128, I_DN = 64 * 32, I_F = 128, I_L = I_IN + I_OUT + I_UP + I_DN + I_F;
        for (int it = gw; it < NL * I_L; it += NGW) {
            const int l = it / I_L; int r = it % I_L;
            bf16_t* Wl = (bf16_t*)(ws + WS_W + (size_t)l * WL_SZ);
            const float* win = P.w_in + (size_t)l * D * DIN;
            if (r < I_IN) { p0_transpose_item<true>(win, D, DIN, 48, Wl + WL_IN / 2, P.g_mix_pre + l * D, scr, r, lane); continue; } r -= I_IN;
            if (r < I_OUT) {
                const int kb = r / 32; const float* gsrc = kb < 8 ? P.g_conv_out + l * 512 : P.g_fourier_out + l * 512 - 512;
                p0_transpose_item(P.w_out + (size_t)l * D * D, D, D, 32, Wl + WL_OUT / 2, gsrc, scr, r, lane); continue; } r -= I_OUT;
            if (r < I_UP) { p0_transpose_item(P.w_up + (size_t)l * D * DFF, D, DFF, 128, Wl + WL_UP / 2, P.g_mlp_pre + l * D, scr, r, lane); continue; } r -= I_UP;
            if (r < I_DN) { p0_transpose_item(P.w_down + (size_t)l * DFF * D, DFF, D, 32, Wl + WL_DN / 2, nullptr, scr, r, lane); continue; } r -= I_DN;
            p0_fold_item(win, P.g_mix_pre + l * D, Wl + WL_IN / 2, TAB, r, lane);
        }
        for (int t = gw * 4; t < T; t += NGW * 4) x_rows_init<4>(t < TP ? P.xp + (size_t)t * D : P.xs + (size_t)(t - TP) * D, Xb + (size_t)t * D, RSb + t, lane);
    }
    grid.sync();

    for (int l = 0; l < NL; ++l) {
        const bf16_t* Wl = (const bf16_t*)(ws + WS_W + (size_t)l * WL_SZ);
        { pg8::Gemm g{Xb, Wl + WL_IN / 2, T, DIN, D, nullptr, 1 << 20}; pg8::StaticOrder S; S.init(T, DIN, G, bid); pg8::EpiInProj E{Pb, RSb};
          pg8::gemm_phase(lds, g, S, E); }
        GSYNC();
        {
            FRESH();
            constexpr int NCONV = T / 128;
            for (int it = bid; it < NCONV; it += G) { const int t0 = it * 128 + wave * 16; const int S = t0 < TP ? SP : SS; const int pos0 = t0 < TP ? (t0 & (SP - 1)) : ((t0 - TP) & (SS - 1));
                conv_wave_item(Pb, P.conv_w + (size_t)l * 3 * 512, Hb, t0, pos0, S, lane); }
            fft_pass1(Pb, Ib, lds, bid, G, tid);
        }
        GSYNC();
        { FRESH(); fft_pass2<7>(Ib, Hb, lds, bid, 1024, G, tid); }
        { FRESH(); fft_pass2s(Ib, Hb, lds, bid, 2048, G, tid); }
        GSYNC();
        { pg8::Gemm g{Hb, Wl + WL_OUT / 2, T, D, D, nullptr, 1 << 20}; pg8::StaticOrder S; S.init(T, D, G, bid); pg8::EpiBf16 E{MFb, D, 0, nullptr, nullptr, 1 << 20};
          pg8::gemm_phase(lds, g, S, E); }
        GSYNC();
        { FRESH();
          for (int t = gw * 8; t < T; t += NGW * 8) row_pass_rows<8>(Xb, MFb, P.g_mix_post + l * D, RSb, nullptr, false, t, lane); }
        GSYNC();
        { pg8::Gemm g{Xb, Wl + WL_UP / 2, T, DFF, D, nullptr, 1 << 20}; pg8::StaticOrder S; S.init(T, DFF, G, bid); pg8::EpiBf16 E{A0b, DFF, 1, nullptr, A1b, TCH / 256};
          pg8::gemm_phase(lds, g, S, E); }
        GSYNC();
        { pg8::Gemm g{A0b, Wl + WL_DN / 2, T, D, DFF, A1b, TCH / 256}; pg8::StaticOrder S; S.init(T, D, G, bid); pg8::EpiBf16 E{MFb, D, 0, nullptr, nullptr, 1 << 20};
          pg8::gemm_phase(lds, g, S, E); }
        GSYNC();
        { FRESH();
          float* outf = (l + 1 < NL) ? nullptr : P.out;
          for (int t = gw * 8; t < T; t += NGW * 8) row_pass_rows<8>(Xb, MFb, P.g_mlp_post + l * D, RSb, outf, true, t, lane); }
        if (l + 1 < NL) GSYNC();
    }
}

extern "C" void kernel_launch(void* const* d_in, const int* in_sizes, int n_in, void* d_out, int out_size, void* d_ws, size_t ws_size, hipStream_t stream) {
    static int grid_blocks = 0;
    if (grid_blocks == 0) {
        if (n_in != 13 || out_size != T * D || ws_size < WS_END) { fprintf(stderr, "kernel_launch: unexpected shapes (n_in %d, out %d, ws %zu, need %zu)\n", n_in, out_size, ws_size, (size_t)WS_END); grid_blocks = -1; return; }
        int dev = 0, cus = 0, per_cu = 0;
        hipGetDevice(&dev);
        hipDeviceGetAttribute(&cus, hipDeviceAttributeMultiprocessorCount, dev);
        if (hipFuncSetAttribute((const void*)fwd_megakernel, hipFuncAttributeMaxDynamicSharedMemorySize, LDS_BYTES) != hipSuccess) { fprintf(stderr, "kernel_launch: hipFuncSetAttribute failed\n"); grid_blocks = -1; return; }
        hipOccupancyMaxActiveBlocksPerMultiprocessor(&per_cu, (const void*)fwd_megakernel, NTHREADS, LDS_BYTES);
        if (per_cu < 1) { fprintf(stderr, "kernel_launch: occupancy query says %d blocks per CU\n", per_cu); per_cu = 1; }
        grid_blocks = cus * per_cu;
    }
    if (grid_blocks < 0) return;
    Params p{};
    p.xp = (const float*)d_in[0]; p.xs = (const float*)d_in[1]; p.g_mix_pre = (const float*)d_in[2]; p.w_in = (const float*)d_in[3]; p.conv_w = (const float*)d_in[4];
    p.g_conv_out = (const float*)d_in[5]; p.g_fourier_out = (const float*)d_in[6]; p.w_out = (const float*)d_in[7]; p.g_mix_post = (const float*)d_in[8];
    p.g_mlp_pre = (const float*)d_in[9]; p.w_up = (const float*)d_in[10]; p.w_down = (const float*)d_in[11]; p.g_mlp_post = (const float*)d_in[12];
    p.out = (float*)d_out; p.ws = (unsigned char*)d_ws;
    if (hipMemsetAsync(d_ws, 0, 16384, stream) != hipSuccess) { fprintf(stderr, "kernel_launch: memset failed\n"); return; }
    void* args[] = {&p};
    hipError_t e = hipLaunchCooperativeKernel((const void*)fwd_megakernel, dim3(grid_blocks), dim3(NTHREADS), args, LDS_BYTES, stream);
    if (e != hipSuccess) fprintf(stderr, "cooperative launch failed: %s (grid %d)\n", hipGetErrorString(e), grid_blocks);
}
```

```cpp
#include <hip/hip_runtime.h>
#include <hip/hip_cooperative_groups.h>
#include <cstdio>
namespace cg = cooperative_groups;

#define LAS __attribute__((address_space(3)))
typedef unsigned short bf16_t;
typedef short bf16x8 __attribute__((ext_vector_type(8)));
typedef float f32x4 __attribute__((ext_vector_type(4)));
typedef float f32x2 __attribute__((ext_vector_type(2)));
typedef unsigned u32x4 __attribute__((ext_vector_type(4)));
typedef unsigned u32x2 __attribute__((ext_vector_type(2)));

constexpr int D = 1024, DIN = 2048, DFF = 4096, NL = 4;
constexpr int PLD = 1536;
constexpr int SP = 16384, BP = 2, SS = 8192, BS = 8;
constexpr int TP = BP * SP, TS = BS * SS, T = TP + TS;
constexpr float EPS = 1e-6f;
constexpr int NCH = 2;
constexpr int TCH = T / NCH;

constexpr size_t MiB = (size_t)1 << 20;
constexpr size_t WS_W = 1 * MiB;
constexpr size_t WL_IN = 0, WL_OUT = 4 * MiB, WL_UP = 6 * MiB, WL_DN = 14 * MiB, WL_SZ = 22 * MiB;
constexpr size_t WS_X = WS_W + NL * WL_SZ;
constexpr size_t WS_H = WS_X + (size_t)T * D * 2;
constexpr size_t WS_INTER = WS_H + (size_t)T * D * 2;
constexpr size_t WS_MF = WS_INTER + (size_t)T * 256 * 8;
constexpr size_t WS_RS = WS_MF + (size_t)T * D * 2;
constexpr size_t WS_END = WS_RS + 1 * MiB;

constexpr int LDS_STAGE = 131072, LDS_MISC = 139264, LDS_BYTES = LDS_MISC + 4096;
constexpr int NTHREADS = 512, NWAVES = 8;

struct Params {
    const float* xp; const float* xs; const float* g_mix_pre; const float* w_in; const float* conv_w;
    const float* g_conv_out; const float* g_fourier_out; const float* w_out; const float* g_mix_post;
    const float* g_mlp_pre; const float* w_up; const float* w_down; const float* g_mlp_post;
    float* out; unsigned char* ws;
};

__device__ __forceinline__ unsigned cvt_pk_bf16(float lo, float hi) { unsigned r; asm volatile("v_cvt_pk_bf16_f32 %0, %1, %2" : "=v"(r) : "v"(lo), "v"(hi)); return r; }
__device__ __forceinline__ float bf_lo(unsigned w) { return __uint_as_float(w << 16); }
__device__ __forceinline__ float bf_hi(unsigned w) { return __uint_as_float(w & 0xffff0000u); }
template <int CTRL> __device__ __forceinline__ float dpp_f(float x) { return __builtin_bit_cast(float, __builtin_amdgcn_update_dpp(0, __builtin_bit_cast(int, x), CTRL, 0xF, 0xF, true)); }
__device__ __forceinline__ float xadd1(float v) { return v + dpp_f<0xB1>(v); }
__device__ __forceinline__ float xadd2(float v) { return v + dpp_f<0x4E>(v); }
__device__ __forceinline__ float xadd4(float v) { return v + dpp_f<0x141>(v); }
__device__ __forceinline__ float xadd8(float v) { return v + dpp_f<0x140>(v); }
__device__ __forceinline__ float xadd16(float v) { float a = v, b = v; asm volatile("s_nop 1\n\tv_permlane16_swap_b32 %0, %1" : "+v"(a), "+v"(b)); return a + b; }
__device__ __forceinline__ float xadd32(float v) { float a = v, b = v; asm volatile("s_nop 1\n\tv_permlane32_swap_b32 %0, %1" : "+v"(a), "+v"(b)); return a + b; }
__device__ __forceinline__ float wave_sum(float v) { return xadd32(xadd16(xadd8(xadd4(xadd2(xadd1(v)))))); }
__device__ __forceinline__ void load8(const bf16_t* ptr, float (&v)[8]) {
    const u32x4 q = *(const u32x4*)ptr;
    v[0] = bf_lo(q.x); v[1] = bf_hi(q.x); v[2] = bf_lo(q.y); v[3] = bf_hi(q.y); v[4] = bf_lo(q.z); v[5] = bf_hi(q.z); v[6] = bf_lo(q.w); v[7] = bf_hi(q.w);
}

namespace pg8 {
constexpr int BM = 256, BK = 64, HALF = 128, HTB = HALF * BK * 2, STAGE_BYTES = 8 * HTB, NXCD = 8, WGM = 8;
__device__ __forceinline__ int lds_byte(int r, int c) { const int st = (r >> 4) * 2 + (c >> 5), rr = r & 15, cc = c & 31, ob = rr * 64 + cc * 2; return st * 1024 + (ob ^ (((ob >> 9) & 1) << 5)); }
__device__ __forceinline__ void stage_rc(int b, int& R, int& C) { const int st = b / 1024, sb = b % 1024, swz = sb ^ (((sb >> 9) & 1) << 5); R = (st >> 1) * 16 + swz / 64; C = (st & 1) * 32 + (swz % 64) / 2; }
__device__ __forceinline__ int perm32(int rho) { const int n = rho >> 4, i = rho & 15; return 8 * (i >> 2) + 4 * n + (i & 3); }

struct Unit { int pm, pn; };
struct Gemm { const bf16_t* A; const bf16_t* Bt; int M, N, K; const bf16_t* A2; int split; };

struct StaticOrder {
    int nM, nN, nwg, G, c;
    __device__ void init(int M, int N, int G_, int c_) { nM = M / BM; nN = N / BM; nwg = nM * nN; G = G_; c = c_; }
    __device__ bool next(int i, Unit& u) const {
        const long L = (long)i * G + c; if (L >= nwg) return false;
        int wgid = (int)L; { const int q = nwg / NXCD, r = nwg % NXCD, xcd = wgid % NXCD, off = wgid / NXCD; wgid = (xcd < r ? xcd * (q + 1) : r * (q + 1) + (xcd - r) * q) + off; }
        const int nig = WGM * nN, gid = wgid / nig, fm = gid * WGM, gsz = (nM - fm) < WGM ? (nM - fm) : WGM;
        u.pm = fm + ((wgid % nig) % gsz); u.pn = (wgid % nig) / gsz; return true;
    }
};

struct EpiBf16 {
    static constexpr bool FUSED = false;
    bf16_t* O; int ldc; int act; const float* rs; bf16_t* O2; int split;
    __device__ __forceinline__ void operator()(const f32x4 (&acc)[2][2][4][2], const Unit& u, int wr, int wc, int fr, int fq) const {
        const bool lo = u.pm < split; bf16_t* Ob = lo ? O : O2;
        const int grow0 = u.pm * BM + wr * 64 + fr, row0 = grow0 - (lo ? 0 : split * BM); const int col0 = u.pn * BM + wc * 32 + 8 * fq;
#pragma unroll
        for (int ai = 0; ai < 2; ++ai)
#pragma unroll
            for (int m = 0; m < 4; ++m) { bf16_t* rowp = Ob + (size_t)(row0 + ai * HALF + m * 16) * ldc + col0; const float sc = rs ? rs[grow0 + ai * HALF + m * 16] : 1.f;
#pragma unroll
                for (int bj = 0; bj < 2; ++bj) { f32x4 v0 = acc[ai][bj][m][0] * sc, v1 = acc[ai][bj][m][1] * sc;
                    if (act) {
#pragma unroll
                        for (int j = 0; j < 4; ++j) { const float a0 = __builtin_amdgcn_fmed3f(v0[j], 0.f, __builtin_inff()), a1 = __builtin_amdgcn_fmed3f(v1[j], 0.f, __builtin_inff()); v0[j] = a0 * a0; v1[j] = a1 * a1; } }
                    u32x4 w; w.x = cvt_pk_bf16(v0[0], v0[1]); w.y = cvt_pk_bf16(v0[2], v0[3]); w.z = cvt_pk_bf16(v1[0], v1[1]); w.w = cvt_pk_bf16(v1[2], v1[3]);
                    *(u32x4*)(rowp + bj * HALF) = w; } }
    }
};


struct EpiInProj {
    static constexpr bool FUSED = false;
    bf16_t* O; const float* rs;
    __device__ __forceinline__ void operator()(const f32x4 (&acc)[2][2][4][2], const Unit& u, int wr, int wc, int fr, int fq) const {
        const int row0 = u.pm * BM + wr * 64 + fr, sub = wc * 32 + 8 * fq;
        const bool isz = (u.pn >= 2 && u.pn < 6);
        const int cbase = isz ? 512 + (u.pn - 2) * 128 + sub : (u.pn < 2 ? u.pn * BM + sub : 1024 + (u.pn - 6) * BM + sub);
#pragma unroll
        for (int ai = 0; ai < 2; ++ai)
#pragma unroll
            for (int m = 0; m < 4; ++m) { const int row = row0 + ai * HALF + m * 16; bf16_t* rowp = O + (size_t)row * PLD + cbase; const float sc = rs[row];
                if (isz) { const float s2 = sc * sc; const f32x4 z0 = acc[ai][0][m][0] * acc[ai][1][m][0] * s2, z1 = acc[ai][0][m][1] * acc[ai][1][m][1] * s2;
                    u32x4 w; w.x = cvt_pk_bf16(z0[0], z0[1]); w.y = cvt_pk_bf16(z0[2], z0[3]); w.z = cvt_pk_bf16(z1[0], z1[1]); w.w = cvt_pk_bf16(z1[2], z1[3]);
                    *(u32x4*)rowp = w; }
                else {
#pragma unroll
                    for (int bj = 0; bj < 2; ++bj) { const f32x4 v0 = acc[ai][bj][m][0] * sc, v1 = acc[ai][bj][m][1] * sc;
                        u32x4 w; w.x = cvt_pk_bf16(v0[0], v0[1]); w.y = cvt_pk_bf16(v0[2], v0[3]); w.z = cvt_pk_bf16(v1[0], v1[1]); w.w = cvt_pk_bf16(v1[2], v1[3]);
                        *(u32x4*)(rowp + bj * HALF) = w; } } }
    }
};

template <class Epi, class Sched>
__device__ __forceinline__ void gemm_phase(LAS unsigned char* lds, const Gemm g, const Sched& S, const Epi& E) {
    int tid_ = threadIdx.x; asm volatile("" : "+v"(tid_));
    const int tid = tid_, wid = __builtin_amdgcn_readfirstlane(tid >> 6), lane = tid & 63, wr = wid >> 2, wc = wid & 3, fr = lane & 15, fq = lane >> 4;
    const int K = g.K, nt = K / BK;
    unsigned voffA[2], voffB[2];
#pragma unroll
    for (int i = 0; i < 2; ++i) { int R, C; stage_rc(tid * 16 + i * 8192, R, C); const int Rb = (R & ~31) + perm32(R & 31);
        voffA[i] = (unsigned)(R * K + C) * 2u; voffB[i] = (unsigned)(Rb * K + C) * 2u; }
    const size_t kstep = (size_t)(BK * 2);
    const size_t hstep = (size_t)HALF * K * 2;
    const size_t tstep = 2 * hstep;
    const unsigned ldsw = (unsigned)wid * 1024u;
    const int aoff = lds_byte(wr * 64 + fr, fq * 8), boff = lds_byte(wc * 32 + fr, fq * 8);
#define PG8_SA(b, h) (((b) * 2 + (h)) * HTB)
#define PG8_SB(b, h) ((4 + (b) * 2 + (h)) * HTB)
#define PG8_STAGE(bufoff, gbase, voff) do { _Pragma("unroll") for (int _i = 0; _i < 2; ++_i) \
        __builtin_amdgcn_global_load_lds((const unsigned*)((const char*)(gbase) + (voff)[_i]), (LAS unsigned*)(lds + (bufoff) + ldsw + _i * 8192), 16, 0, 0); } while (0)
#define PG8_LDA(dst, b, h) do { _Pragma("unroll") for (int m = 0; m < 4; ++m) _Pragma("unroll") for (int k = 0; k < 2; ++k) dst[m][k] = *(const LAS bf16x8*)(lds + PG8_SA(b, h) + aoff + m * 2048 + k * 1024); } while (0)
#define PG8_LDB(dst, b, h) do { _Pragma("unroll") for (int n = 0; n < 2; ++n) _Pragma("unroll") for (int k = 0; k < 2; ++k) dst[n][k] = *(const LAS bf16x8*)(lds + PG8_SB(b, h) + boff + n * 2048 + k * 1024); } while (0)
#define PG8_MMA(ai, bj, At, Bt) do { __builtin_amdgcn_s_setprio(1); _Pragma("unroll") for (int m = 0; m < 4; ++m) _Pragma("unroll") for (int n = 0; n < 2; ++n) _Pragma("unroll") for (int k = 0; k < 2; ++k) \
        acc[ai][bj][m][n] = __builtin_amdgcn_mfma_f32_16x16x32_bf16(Bt[n][k], At[m][k], acc[ai][bj][m][n], 0, 0, 0); __builtin_amdgcn_s_setprio(0); } while (0)
#define PG8_WAIT_V(n) asm volatile("s_waitcnt vmcnt(" #n ")" ::: "memory")
#define PG8_WAIT_L(n) asm volatile("s_waitcnt lgkmcnt(" #n ")" ::: "memory")
#define PG8_BAR __builtin_amdgcn_s_barrier()
#define PG8_SCHED __builtin_amdgcn_sched_barrier(0)
    Unit cur, nxt; int ui = 0;
    if (!S.next(0, cur)) return;
    f32x4 acc[2][2][4][2];
#pragma unroll
    for (int a = 0; a < 2; ++a)
#pragma unroll
        for (int b = 0; b < 2; ++b)
#pragma unroll
            for (int m = 0; m < 4; ++m)
#pragma unroll
                for (int n = 0; n < 2; ++n) acc[a][b][m][n] = (f32x4){0.f, 0.f, 0.f, 0.f};
    bf16x8 At[4][2], B0[2][2], B1[2][2];
#define PG8_APANEL(pm_) ((const char*)(((pm_) < g.split ? (unsigned long long)g.A : (unsigned long long)g.A2 - (unsigned long long)g.split * tstep) + (unsigned long long)(pm_) * tstep))
    const char* cA = PG8_APANEL(cur.pm); const char* cB = (const char*)g.Bt + (size_t)cur.pn * tstep;
    PG8_STAGE(PG8_SB(0, 0), cB, voffB); PG8_STAGE(PG8_SA(0, 0), cA, voffA); PG8_STAGE(PG8_SB(0, 1), cB + hstep, voffB); PG8_STAGE(PG8_SA(0, 1), cA + hstep, voffA);
    if (wr == 1) PG8_BAR;
    PG8_WAIT_V(4); PG8_BAR;
    PG8_STAGE(PG8_SB(1, 0), cB + kstep, voffB); PG8_STAGE(PG8_SA(1, 0), cA + kstep, voffA); PG8_STAGE(PG8_SB(1, 1), cB + hstep + kstep, voffB);
    PG8_WAIT_V(6); PG8_BAR;
    for (;;) {
        const bool has_next = S.next(ui + 1, nxt);
        const char* nA = has_next ? PG8_APANEL(nxt.pm) : cA; const char* nB = has_next ? (const char*)g.Bt + (size_t)nxt.pn * tstep : cB;
        for (int t = 0; t < nt; t += 2) {
            const bool last = (t == nt - 2);
            const char* a1 = cA + (size_t)(t + 1) * kstep;
            const char* a2 = last ? nA : cA + (size_t)(t + 2) * kstep; const char* b2 = last ? nB : cB + (size_t)(t + 2) * kstep;
            const char* a3 = a2 + kstep; const char* b3 = b2 + kstep;
            PG8_LDB(B0, 0, 0); PG8_SCHED; PG8_LDA(At, 0, 0); PG8_STAGE(PG8_SA(1, 1), a1 + hstep, voffA);
            PG8_WAIT_L(8); PG8_BAR; PG8_WAIT_L(0); PG8_MMA(0, 0, At, B0); PG8_BAR; PG8_SCHED;
            PG8_LDB(B1, 0, 1); PG8_STAGE(PG8_SB(0, 0), b2, voffB);
            PG8_BAR; PG8_WAIT_L(0); PG8_MMA(0, 1, At, B1); PG8_BAR;
            PG8_LDA(At, 0, 1); PG8_STAGE(PG8_SA(0, 0), a2, voffA);
            PG8_BAR; PG8_WAIT_L(0); PG8_MMA(1, 0, At, B0); PG8_BAR; PG8_SCHED;
            PG8_STAGE(PG8_SB(0, 1), b2 + hstep, voffB);
            PG8_WAIT_V(6); PG8_BAR; PG8_MMA(1, 1, At, B1); PG8_BAR;
            PG8_LDB(B0, 1, 0); PG8_SCHED; PG8_LDA(At, 1, 0); PG8_STAGE(PG8_SA(0, 1), a2 + hstep, voffA);
            PG8_WAIT_L(8); PG8_BAR; PG8_WAIT_L(0); PG8_MMA(0, 0, At, B0); PG8_BAR; PG8_SCHED;
            PG8_LDB(B1, 1, 1); PG8_STAGE(PG8_SB(1, 0), b3, voffB);
            PG8_BAR; PG8_WAIT_L(0); PG8_MMA(0, 1, At, B1); PG8_BAR;
            PG8_LDA(At, 1, 1); PG8_STAGE(PG8_SA(1, 0), a3, voffA);
            PG8_BAR; PG8_WAIT_L(0); PG8_MMA(1, 0, At, B0); PG8_BAR; PG8_SCHED;
            PG8_STAGE(PG8_SB(1, 1), b3 + hstep, voffB);
            PG8_WAIT_V(6); PG8_BAR; PG8_MMA(1, 1, At, B1); PG8_BAR;
        }
        if (wr == 0) PG8_BAR;
        E(acc, cur, wr, wc, fr, fq);
        if (wr == 1) PG8_BAR;
        if (!has_next) break;
#pragma unroll
        for (int a = 0; a < 2; ++a)
#pragma unroll
            for (int b = 0; b < 2; ++b)
#pragma unroll
                for (int m = 0; m < 4; ++m)
#pragma unroll
                    for (int n = 0; n < 2; ++n) acc[a][b][m][n] = (f32x4){0.f, 0.f, 0.f, 0.f};
        cur = nxt; cA = nA; cB = nB; ++ui;
    }
    PG8_WAIT_V(0);
    if (wr == 0) PG8_BAR;
    PG8_BAR;
#undef PG8_APANEL
#undef PG8_SA
#undef PG8_SB
#undef PG8_STAGE
#undef PG8_LDA
#undef PG8_LDB
#undef PG8_MMA
#undef PG8_WAIT_V
#undef PG8_WAIT_L
#undef PG8_BAR
#undef PG8_SCHED
}
}

template <bool INPROJ = false>
__device__ __forceinline__ void p0_transpose_item(const float* W, int K, int ldN, int nblk, bf16_t* WT, const float* gain, LAS float* scr, int item, int lane) {
    const int kb = item / nblk, nb = item % nblk, k0 = 64 * kb, n0 = 32 * nb;
    const int dn0 = !INPROJ || n0 < 512 ? n0 : (n0 < 1024 ? 512 + ((n0 - 512) >> 7) * 256 + ((n0 - 512) & 127) : 512 + ((n0 - 1024) >> 7) * 256 + 128 + ((n0 - 1024) & 127));
    float wv[32];
#pragma unroll
    for (int i = 0; i < 32; ++i) wv[i] = W[(size_t)(k0 + 2 * i + (lane >> 5)) * ldN + n0 + (lane & 31)];
#pragma unroll
    for (int i = 0; i < 32; ++i) { const int kk = 2 * i + (lane >> 5); const float gk = gain ? gain[k0 + kk] : 1.f;
        scr[kk * 33 + (lane & 31)] = wv[i] * gk; }
    asm volatile("s_waitcnt lgkmcnt(0)" ::: "memory");
    const int c = lane & 7;
#pragma unroll
    for (int j = 0; j < 4; ++j) { const int n = (lane >> 3) + 8 * j; const LAS float* s = scr + (8 * c) * 33 + n;
        u32x4 o; o.x = cvt_pk_bf16(s[0 * 33], s[1 * 33]); o.y = cvt_pk_bf16(s[2 * 33], s[3 * 33]); o.z = cvt_pk_bf16(s[4 * 33], s[5 * 33]); o.w = cvt_pk_bf16(s[6 * 33], s[7 * 33]);
        *(u32x4*)(WT + (size_t)(dn0 + n) * K + k0 + 8 * c) = o; }
    asm volatile("s_waitcnt lgkmcnt(0)" ::: "memory");
}
__device__ __forceinline__ void p0_fold_item(const float* Win  , const float* gpre, bf16_t* WT  , const LAS float* tab, int item, int lane) {
    const int kb = item >> 3, g = item & 7, k = kb * 64 + lane;
    const float gk = gpre[k] * 0.125f;
    const f32x4* src = (const f32x4*)(Win + (size_t)k * DIN + 1536 + g * 64);
    float row[64];
#pragma unroll
    for (int i = 0; i < 16; ++i) { const f32x4 v = src[i]; row[4 * i] = v.x * gk; row[4 * i + 1] = v.y * gk; row[4 * i + 2] = v.z * gk; row[4 * i + 3] = v.w * gk; }
    for (int j = 0; j < 64; ++j) {
        const int cj = (j == 0) ? 0 : (j == 1 ? 32 : (j >> 1)), off = (j >= 2 && (j & 1)) ? 16 : 0;
        float acc = 0.f;
#pragma unroll
        for (int d = 0; d < 64; ++d) acc += row[d] * tab[(cj * d + off) & 63];
        WT[(size_t)(1536 + g * 64 + j) * D + k] = (bf16_t)(cvt_pk_bf16(acc, 0.f) & 0xffffu);
    }
}
template <int NR>
__device__ __forceinline__ void x_rows_init(const float* xrow0, bf16_t* orow0, float* rs, int lane) {
    f32x4 v[NR][4];
#pragma unroll
    for (int r = 0; r < NR; ++r) { const f32x4* xr = (const f32x4*)(xrow0 + (size_t)r * D) + lane;
#pragma unroll
        for (int j = 0; j < 4; ++j) v[r][j] = xr[64 * j]; }
#pragma unroll
    for (int r = 0; r < NR; ++r) { float s = 0.f;
#pragma unroll
        for (int j = 0; j < 4; ++j) s += (v[r][j].x * v[r][j].x + v[r][j].y * v[r][j].y) + (v[r][j].z * v[r][j].z + v[r][j].w * v[r][j].w);
        const float rstd = rsqrtf(wave_sum(s) * (1.f / D) + EPS);
        u32x2* o8 = (u32x2*)(orow0 + (size_t)r * D) + lane;
#pragma unroll
        for (int j = 0; j < 4; ++j) { u32x2 w; w.x = cvt_pk_bf16(v[r][j].x, v[r][j].y); w.y = cvt_pk_bf16(v[r][j].z, v[r][j].w); o8[64 * j] = w; }
        if (lane == 0) rs[r] = rstd; }
}

template <int NR>
__device__ __forceinline__ void row_pass_rows(bf16_t* X, const bf16_t* MF, const float* gain, float* rs, float* outf, bool unscaled, int t0, int lane) {
    u32x4 xa[NR][2], ma[NR][2];
#pragma unroll
    for (int r = 0; r < NR; ++r) { const u32x4* xr = (const u32x4*)(X + (size_t)(t0 + r) * D); const u32x4* mr = (const u32x4*)(MF + (size_t)(t0 + r) * D);
        xa[r][0] = xr[lane]; xa[r][1] = xr[64 + lane]; ma[r][0] = mr[lane]; ma[r][1] = mr[64 + lane]; }
    float g[16];
    { const f32x4* g0 = (const f32x4*)(gain + lane * 8); const f32x4* g1 = (const f32x4*)(gain + 512 + lane * 8);
#pragma unroll
      for (int h = 0; h < 2; ++h) { const f32x4 a = g0[h], b = g1[h];
#pragma unroll
        for (int k = 0; k < 4; ++k) { g[4 * h + k] = a[k]; g[8 + 4 * h + k] = b[k]; } } }
#pragma unroll
    for (int r = 0; r < NR; ++r) {
        float x[16], m[16];
#pragma unroll
        for (int h = 0; h < 2; ++h) { const u32x4 xq = xa[r][h], mq = ma[r][h];
            x[8 * h + 0] = bf_lo(xq.x); x[8 * h + 1] = bf_hi(xq.x); x[8 * h + 2] = bf_lo(xq.y); x[8 * h + 3] = bf_hi(xq.y); x[8 * h + 4] = bf_lo(xq.z); x[8 * h + 5] = bf_hi(xq.z); x[8 * h + 6] = bf_lo(xq.w); x[8 * h + 7] = bf_hi(xq.w);
            m[8 * h + 0] = bf_lo(mq.x); m[8 * h + 1] = bf_hi(mq.x); m[8 * h + 2] = bf_lo(mq.y); m[8 * h + 3] = bf_hi(mq.y); m[8 * h + 4] = bf_lo(mq.z); m[8 * h + 5] = bf_hi(mq.z); m[8 * h + 6] = bf_lo(mq.w); m[8 * h + 7] = bf_hi(mq.w); }
        float sm = 0.f;
#pragma unroll
        for (int k = 0; k < 16; ++k) sm += m[k] * m[k];
        float eps_eff = EPS; if (unscaled) { const float rr = rs[t0 + r], r2 = rr * rr; eps_eff = EPS / (r2 * r2); }
        const float rm = rsqrtf(wave_sum(sm) * (1.f / D) + eps_eff);
        float s1 = 0.f;
#pragma unroll
        for (int k = 0; k < 16; ++k) { x[k] = x[k] + m[k] * rm * g[k]; s1 += x[k] * x[k]; }
        if (outf) {
            f32x4* o = (f32x4*)(outf + (size_t)(t0 + r) * D);
            o[lane * 2] = (f32x4){x[0], x[1], x[2], x[3]}; o[lane * 2 + 1] = (f32x4){x[4], x[5], x[6], x[7]};
            o[128 + lane * 2] = (f32x4){x[8], x[9], x[10], x[11]}; o[128 + lane * 2 + 1] = (f32x4){x[12], x[13], x[14], x[15]};
        } else {
            const float r1 = rsqrtf(wave_sum(s1) * (1.f / D) + EPS);
            u32x4* xo = (u32x4*)(X + (size_t)(t0 + r) * D);
            u32x4 w0, w1;
            w0.x = cvt_pk_bf16(x[0], x[1]); w0.y = cvt_pk_bf16(x[2], x[3]); w0.z = cvt_pk_bf16(x[4], x[5]); w0.w = cvt_pk_bf16(x[6], x[7]);
            w1.x = cvt_pk_bf16(x[8], x[9]); w1.y = cvt_pk_bf16(x[10], x[11]); w1.z = cvt_pk_bf16(x[12], x[13]); w1.w = cvt_pk_bf16(x[14], x[15]);
            xo[lane] = w0; xo[64 + lane] = w1;
            if (lane == 0) rs[t0 + r] = r1;
        }
    }
}

__device__ __forceinline__ void conv_wave_item(const bf16_t* p, const float* cw, bf16_t* Hm, int t0, int pos0, int S, int lane) {
    float w0[8], w1[8], w2[8];
    { const f32x4* a = (const f32x4*)(cw + lane * 8); const f32x4* b = (const f32x4*)(cw + 512 + lane * 8); const f32x4* c = (const f32x4*)(cw + 1024 + lane * 8);
#pragma unroll
      for (int h = 0; h < 2; ++h) { const f32x4 va = a[h], vb = b[h], vc = c[h];
#pragma unroll
        for (int k = 0; k < 4; ++k) { w0[4 * h + k] = va[k]; w1[4 * h + k] = vb[k]; w2[4 * h + k] = vc[k]; } } }
    float zp[8], zc[8], zn[8], gb[8];
    const bf16_t* base = p + (size_t)t0 * PLD + lane * 8;
    if (pos0 == 0) {
#pragma unroll
        for (int k = 0; k < 8; ++k) zp[k] = 0.f;
    } else load8(base - PLD + 512, zp);
    load8(base + 512, zc);
#pragma unroll 8
    for (int i = 0; i < 16; ++i) {
        const bf16_t* r = base + (size_t)i * PLD;
        if (pos0 + i + 1 == S) {
#pragma unroll
            for (int k = 0; k < 8; ++k) zn[k] = 0.f;
        } else load8(r + PLD + 512, zn);
        load8(r, gb);
        float y[8], ss = 0.f;
#pragma unroll
        for (int k = 0; k < 8; ++k) { y[k] = gb[k] * (zp[k] * w0[k] + zc[k] * w1[k] + zn[k] * w2[k]); ss += y[k] * y[k]; }
        ss = xadd4(xadd2(xadd1(ss)));
        const float rs = rsqrtf(ss * (1.f / 64.f) + EPS);
        u32x4 o; o.x = cvt_pk_bf16(y[0] * rs, y[1] * rs); o.y = cvt_pk_bf16(y[2] * rs, y[3] * rs); o.z = cvt_pk_bf16(y[4] * rs, y[5] * rs); o.w = cvt_pk_bf16(y[6] * rs, y[7] * rs);
        *(u32x4*)(Hm + (size_t)(t0 + i) * D + lane * 8) = o;
#pragma unroll
        for (int k = 0; k < 8; ++k) { zp[k] = zc[k]; zc[k] = zn[k]; }
    }
}

constexpr int XSTR = 272;
constexpr int RSTR = 34;
constexpr int LDS_XT = 0, LDS_R = 36864, LDS_OST = 106496;
#define LBAR() do { asm volatile("s_waitcnt lgkmcnt(0)" ::: "memory"); __builtin_amdgcn_s_barrier(); asm volatile("" ::: "memory"); } while (0)
__device__ __forceinline__ int seq_base(int bs) { return bs < BP ? bs * SP : TP + (bs - BP) * SS; }

__device__ __forceinline__ void dft_frags(bf16x8 (&Br)[4], bf16x8 (&Bi)[4], int log2n, int kt, int lane) {
    const int N = 1 << log2n, k = 16 * kt + (lane & 15); const float sc = 2.f / (float)N;
#pragma unroll
    for (int ks = 0; ks < 4; ++ks) { u32x4 wr, wi;
#pragma unroll
        for (int e2 = 0; e2 < 4; ++e2) { float c0, s0, c1, s1; const int n0 = 32 * ks + 8 * (lane >> 4) + 2 * e2;
            sincospif(-(float)((n0 * k) & (N - 1)) * sc, &s0, &c0); sincospif(-(float)(((n0 + 1) * k) & (N - 1)) * sc, &s1, &c1);
            wr[e2] = cvt_pk_bf16(c0, c1); wi[e2] = cvt_pk_bf16(s0, s1); }
        Br[ks] = __builtin_bit_cast(bf16x8, wr); Bi[ks] = __builtin_bit_cast(bf16x8, wi); }
}
template <int XS = XSTR>
__device__ __forceinline__ void xt_write(LAS unsigned char* xt, int rp, int ch, const u32x4 va, const u32x4 vb) {
    LAS unsigned char* base = xt + (8 * ch) * XS + ((((rp >> 2) ^ ch) << 4) + (rp & 3) * 4);
#pragma unroll
    for (int e2 = 0; e2 < 4; ++e2) {
        *(LAS unsigned*)(base + (2 * e2) * XS) = (va[e2] & 0xffffu) | (vb[e2] << 16);
        *(LAS unsigned*)(base + (2 * e2 + 1) * XS) = (va[e2] >> 16) | (vb[e2] & 0xffff0000u); }
}
template <int XS = XSTR>
__device__ __forceinline__ void dft_mfma(const LAS unsigned char* xt, int log2n, const bf16x8 (&Br)[4], const bf16x8 (&Bi)[4], f32x4 (&Pa)[4], f32x4 (&Qa)[4], int lane) {
#pragma unroll
    for (int it = 0; it < 4; ++it) { Pa[it] = (f32x4){0.f, 0.f, 0.f, 0.f}; Qa[it] = (f32x4){0.f, 0.f, 0.f, 0.f}; }
#pragma unroll
    for (int ks = 0; ks < 4; ++ks) if (ks < (1 << (log2n - 5))) {
#pragma unroll
        for (int it = 0; it < 4; ++it) { const int col = 16 * it + (lane & 15), gr = 4 * ks + (lane >> 4);
            const bf16x8 a = *(const LAS bf16x8*)(xt + col * XS + ((gr ^ (col >> 3)) << 4));
            Pa[it] = __builtin_amdgcn_mfma_f32_16x16x32_bf16(a, Br[ks], Pa[it], 0, 0, 0);
            Qa[it] = __builtin_amdgcn_mfma_f32_16x16x32_bf16(a, Bi[ks], Qa[it], 0, 0, 0); } }
}

__device__ __forceinline__ void p1_decode(int item, int& bs, int& g, int& n2, int& S, int& log2N2) {
    if (item < 2048) { bs = item >> 10; const int r = item & 1023; n2 = r >> 3; g = r & 7; S = SP; log2N2 = 7; }
    else { const int it = item - 2048; bs = BP + (it >> 9); const int r = it & 511; n2 = r >> 3; g = r & 7; S = SS; log2N2 = 6; }
}
__device__ __forceinline__ void p1_load(const bf16_t* p, int item, int rp, int ch, u32x4& va, u32x4& vb) {
    int bs, g, n2, S, l2; p1_decode(item, bs, g, n2, S, l2);
    const bf16_t* src = p + (size_t)(seq_base(bs) + ((2 * rp) << l2) + n2) * PLD + 1024 + g * 64 + ch * 8;
    va = *(const u32x4*)src; vb = *(const u32x4*)(src + ((size_t)PLD << l2));
}
__device__ __forceinline__ void fft_pass1(const bf16_t* p, bf16_t* inter, LAS unsigned char* lds, int bid, int G, int tid) {
    constexpr int NP1 = 2048 + 4096;
    const int lane = tid & 63, wave = __builtin_amdgcn_readfirstlane(tid >> 6), rp = tid >> 3, ch = tid & 7;
    bf16x8 Br[4], Bi[4]; dft_frags(Br, Bi, 7, wave, lane);
    u32x4 va, vb;
    if (bid < NP1) p1_load(p, bid, rp, ch, va, vb);
    int par = 0;
    for (int item = bid; item < NP1; item += G, par ^= 1) {
        LAS unsigned char* xt = lds + LDS_XT + par * (64 * XSTR);
        xt_write(xt, rp, ch, va, vb);
        if (item + G < NP1) p1_load(p, item + G, rp, ch, va, vb);
        LBAR();
        f32x4 Pa[4], Qa[4]; dft_mfma(xt, 7, Br, Bi, Pa, Qa, lane);
        int bs, g, n2, S, l2; p1_decode(item, bs, g, n2, S, l2);
        const int k1 = 16 * wave + (lane & 15), quad = lane >> 4;
        float sn, cs; sincospif(-2.0f * (float)(n2 * k1) / (float)S, &sn, &cs);
        bf16_t* dst = inter + ((size_t)seq_base(bs) * 8 + (size_t)g * S + ((size_t)k1 << l2) + n2) * 64 + 4 * quad;
#pragma unroll
        for (int it = 0; it < 4; ++it) {
            const float r0 = Pa[it][0] - Qa[it][1], i0 = Pa[it][1] + Qa[it][0], r1 = Pa[it][2] - Qa[it][3], i1 = Pa[it][3] + Qa[it][2];
            u32x2 w; w.x = cvt_pk_bf16(r0 * cs - i0 * sn, r0 * sn + i0 * cs); w.y = cvt_pk_bf16(r1 * cs - i1 * sn, r1 * sn + i1 * cs);
            *(u32x2*)(dst + 16 * it) = w; }
    }
    LBAR();
}

__device__ __forceinline__ void p2_decode(int item, int& bs, int& g, int& k1a, int& k1b, int& ip) {
    int r;
    if (item < 1024) { bs = item >> 9; r = item & 511; } else { const int it = item - 1024; bs = BP + (it >> 9); r = it & 511; }
    g = r >> 6; ip = r & 63; k1a = ip; k1b = ip == 0 ? 64 : 128 - ip;
}
template <int LOG2N>
__device__ __forceinline__ void fft_pass2(const bf16_t* inter, bf16_t* Hm, LAS unsigned char* lds, int item0, int item_end, int G, int tid) {
    constexpr int N2 = 1 << LOG2N, NTASK = N2 / 64, S = (LOG2N == 7) ? SP : SS;
    const int lane = tid & 63, wave = __builtin_amdgcn_readfirstlane(tid >> 6);
    bf16x8 Br[4], Bi[4]; dft_frags(Br, Bi, LOG2N, LOG2N == 7 ? wave : (wave & 3), lane);
    u32x4 va[NTASK], vb[NTASK];
#define P2_LOAD(item_) do { int bs_, g_, ka_, kb_, ip_; p2_decode(item_, bs_, g_, ka_, kb_, ip_); \
        const bf16_t* ib_ = inter + ((size_t)seq_base(bs_) * 8 + (size_t)g_ * S) * 64; \
        _Pragma("unroll") for (int j = 0; j < NTASK; ++j) { const int q = tid + NTHREADS * j, h = q / (4 * N2), r = q % (4 * N2), rp = r >> 3, ch = r & 7; \
            const bf16_t* src = ib_ + ((size_t)((h ? kb_ : ka_) * N2 + 2 * rp)) * 64 + ch * 8; va[j] = *(const u32x4*)src; vb[j] = *(const u32x4*)(src + 64); } } while (0)
    if (item0 < item_end) P2_LOAD(item0);
    LAS f32x2* R = (LAS f32x2*)(lds + LDS_R);
    LAS bf16_t* Ost = (LAS bf16_t*)(lds + LDS_OST);
    const float sc = rsqrtf((float)S);
    for (int item = item0; item < item_end; item += G) {
#pragma unroll
        for (int j = 0; j < NTASK; ++j) { const int q = tid + NTHREADS * j, h = q / (4 * N2), r = q % (4 * N2);
            xt_write(lds + LDS_XT + h * (64 * XSTR), r >> 3, r & 7, va[j], vb[j]); }
        if (item + G < item_end) P2_LOAD(item + G);
        LBAR();
        {
            f32x4 Pa[4], Qa[4]; const int quad = lane >> 4;
#pragma unroll
            for (int hh = 0; hh < (LOG2N == 7 ? 2 : 1); ++hh) {
                const int h = (LOG2N == 7) ? hh : (wave >> 2), kt = (LOG2N == 7) ? wave : (wave & 3);
                dft_mfma(lds + LDS_XT + h * (64 * XSTR), LOG2N, Br, Bi, Pa, Qa, lane);
                LAS f32x2* Rr = R + (h * N2 + 16 * kt + (lane & 15)) * RSTR + 2 * quad;
#pragma unroll
                for (int it = 0; it < 4; ++it)
                    *(LAS f32x4*)(Rr + 8 * it) = (f32x4){Pa[it][0] - Qa[it][1], Pa[it][1] + Qa[it][0], Pa[it][2] - Qa[it][3], Pa[it][3] + Qa[it][2]};
            }
        }
        LBAR();
        int bs, g, k1a, k1b, ip; p2_decode(item, bs, g, k1a, k1b, ip);
        const int tb = seq_base(bs);
        for (int idx = tid; idx < 2 * N2 * 32; idx += NTHREADS) {
            const int c = idx & 31, tl = idx >> 5, h = tl >> LOG2N, k2 = tl & (N2 - 1);
            const int ph = (ip == 0) ? h : 1 - h;
            const int k2p = (ip == 0 && h == 0) ? ((N2 - k2) & (N2 - 1)) : (N2 - 1 - k2);
            const f32x2 own = R[(h * N2 + k2) * RSTR + c], par = R[(ph * N2 + k2p) * RSTR + c];
            float v1 = (c == 0) ? 0.5f * (own.x + par.x) : own.x, v2 = (c == 0) ? 0.5f * (own.y + par.y) : par.x;
            v1 *= sc; v2 *= sc;
            float ss = v1 * v1 + v2 * v2;
            ss = xadd16(xadd8(xadd4(xadd2(xadd1(ss)))));
            const float rs = rsqrtf(ss * (1.f / 64.f) + EPS);
            Ost[tl * 64 + c] = (bf16_t)(cvt_pk_bf16(v1 * rs, 0.f) & 0xffffu);
            Ost[tl * 64 + (c == 0 ? 32 : 64 - c)] = (bf16_t)(cvt_pk_bf16(v2 * rs, 0.f) & 0xffffu);
        }
        LBAR();
        for (int idx = tid; idx < 2 * N2 * 8; idx += NTHREADS) {
            const int tl = idx >> 3, ch = idx & 7, h = tl >> LOG2N, k2 = tl & (N2 - 1);
            const int tok = tb + (h ? k1b : k1a) + 128 * k2;
            *(u32x4*)(Hm + (size_t)tok * D + 512 + g * 64 + ch * 8) = ((const LAS u32x4*)Ost)[idx];
        }
    }
    LBAR();
#undef P2_LOAD
}

__device__ __forceinline__ void fft_pass2s(const bf16_t* inter, bf16_t* Hm, LAS unsigned char* lds, int item0, int item_end, int G, int tid) {
    constexpr int N2 = 64, XS6 = 144, S = SS;
    const int lane = tid & 63, wave = __builtin_amdgcn_readfirstlane(tid >> 6);
    bf16x8 Br[4], Bi[4]; dft_frags(Br, Bi, 6, wave & 3, lane);
    u32x4 va[2], vb[2];
#define P2S_K1(ip_, hl_) ((hl_) == 0 ? (ip_) : ((ip_) == 0 ? 64 : 128 - (ip_)))
#define P2S_LOAD(item_) do { const int bs_ = BP + ((item_) >> 8), r_ = (item_) & 255, g_ = r_ >> 5, jp_ = r_ & 31; \
        const bf16_t* ib_ = inter + ((size_t)seq_base(bs_) * 8 + (size_t)g_ * S) * 64; \
        _Pragma("unroll") for (int j = 0; j < 2; ++j) { const int q = tid + NTHREADS * j, h = q >> 8, r = q & 255, rp = r >> 3, ch = r & 7, ip_ = 2 * jp_ + (h >> 1); \
            const bf16_t* src = ib_ + ((size_t)(P2S_K1(ip_, h & 1) * N2 + 2 * rp)) * 64 + ch * 8; va[j] = *(const u32x4*)src; vb[j] = *(const u32x4*)(src + 64); } } while (0)
    if (item0 < item_end) P2S_LOAD(item0);
    LAS f32x2* R = (LAS f32x2*)(lds + LDS_R);
    LAS bf16_t* Ost = (LAS bf16_t*)(lds + LDS_OST);
    const float sc = rsqrtf((float)S);
    for (int item = item0; item < item_end; item += G) {
#pragma unroll
        for (int j = 0; j < 2; ++j) { const int q = tid + NTHREADS * j, h = q >> 8, r = q & 255;
            xt_write<XS6>(lds + LDS_XT + h * (64 * XS6), r >> 3, r & 7, va[j], vb[j]); }
        if (item + G < item_end) P2S_LOAD(item + G);
        LBAR();
        {
            f32x4 Pa[4], Qa[4]; const int quad = lane >> 4, kt = wave & 3;
#pragma unroll
            for (int hh = 0; hh < 2; ++hh) { const int h = (wave >> 2) + 2 * hh;
                dft_mfma<XS6>(lds + LDS_XT + h * (64 * XS6), 6, Br, Bi, Pa, Qa, lane);
                LAS f32x2* Rr = R + (h * N2 + 16 * kt + (lane & 15)) * RSTR + 2 * quad;
#pragma unroll
                for (int it = 0; it < 4; ++it)
                    *(LAS f32x4*)(Rr + 8 * it) = (f32x4){Pa[it][0] - Qa[it][1], Pa[it][1] + Qa[it][0], Pa[it][2] - Qa[it][3], Pa[it][3] + Qa[it][2]};
            }
        }
        LBAR();
        const int bs = BP + (item >> 8), rr = item & 255, g = rr >> 5, jp = rr & 31, tb = seq_base(bs);
        for (int idx = tid; idx < 4 * N2 * 32; idx += NTHREADS) {
            const int c = idx & 31, tl = idx >> 5, h = tl >> 6, k2 = tl & (N2 - 1), ip = 2 * jp + (h >> 1);
            const int ph = (ip == 0) ? h : (h ^ 1);
            const int k2p = (ip == 0 && (h & 1) == 0) ? ((N2 - k2) & (N2 - 1)) : (N2 - 1 - k2);
            const f32x2 own = R[(h * N2 + k2) * RSTR + c], par = R[(ph * N2 + k2p) * RSTR + c];
            float v1 = (c == 0) ? 0.5f * (own.x + par.x) : own.x, v2 = (c == 0) ? 0.5f * (own.y + par.y) : par.x;
            v1 *= sc; v2 *= sc;
            float ss = v1 * v1 + v2 * v2;
            ss = xadd16(xadd8(xadd4(xadd2(xadd1(ss)))));
            const float rs = rsqrtf(ss * (1.f / 64.f) + EPS);
            Ost[tl * 64 + c] = (bf16_t)(cvt_pk_bf16(v1 * rs, 0.f) & 0xffffu);
            Ost[tl * 64 + (c == 0 ? 32 : 64 - c)] = (bf16_t)(cvt_pk_bf16(v2 * rs, 0.f) & 0xffffu);
        }
        LBAR();
        for (int idx = tid; idx < 4 * N2 * 8; idx += NTHREADS) {
            const int tl = idx >> 3, ch = idx & 7, h = tl >> 6, k2 = tl & (N2 - 1), ip = 2 * jp + (h >> 1);
            const int tok = tb + P2S_K1(ip, h & 1) + 128 * k2;
            *(u32x4*)(Hm + (size_t)tok * D + 512 + g * 64 + ch * 8) = ((const LAS u32x4*)Ost)[idx];
        }
    }
    LBAR();
#undef P2S_LOAD
#undef P2S_K1
}

#define XB_TMO      128
#define XB_XCNT(j)  (256  + 64 * (j))
#define XB_XSUB(j)  (1280 + 64 * (j))
#define XB_XGEN(j)  (2304 + 64 * (j))
#define XB_TOP      3328
#define XB_TOPGEN   3392
#define XCD_BAR_WORDS 3456
#define XB_SPIN_CAP (1u << 20)
__device__ __forceinline__ unsigned xb_ld(unsigned* p)              { return __hip_atomic_load(p, __ATOMIC_RELAXED, __HIP_MEMORY_SCOPE_AGENT); }
__device__ __forceinline__ unsigned xb_add(unsigned* p, unsigned v) { return __hip_atomic_fetch_add(p, v, __ATOMIC_RELAXED, __HIP_MEMORY_SCOPE_AGENT); }
__device__ __forceinline__ unsigned xb_xcc_id() { return (unsigned)__builtin_amdgcn_s_getreg((3 << 11) | 20) & 0xFu; }
#define XB_SPIN(cond, bar) do { unsigned _sp = 0; while (cond) { __builtin_amdgcn_s_sleep(1); \
    if ((++_sp & 255u) == 0u) { if (xb_ld(&(bar)[XB_TMO])) break; if (_sp > XB_SPIN_CAP) { atomicAdd(&(bar)[XB_TMO], 1u); break; } } } } while (0)
struct XcdBarrier { unsigned* bar; unsigned x; volatile LAS unsigned* st; };
__device__ __forceinline__ XcdBarrier xcd_barrier_post(unsigned* bar, volatile LAS unsigned* st) {
    XcdBarrier b; b.bar = bar; b.x = xb_xcc_id(); b.st = st;
    if (threadIdx.x == 0) (void)xb_add(&bar[XB_XCNT(b.x)], 1u);
    return b;
}
__device__ __forceinline__ void xcd_barrier_complete(unsigned* bar, unsigned x, unsigned& nloc, unsigned& nx) {
    const unsigned G = gridDim.x * gridDim.y * gridDim.z;
    unsigned sum, cnt, mine, sp = 0u;
    for (;;) {
        sum = 0u; cnt = 0u; mine = 0u;
#pragma unroll
        for (unsigned j = 0; j < 16; ++j) { const unsigned c = xb_ld(&bar[XB_XCNT(j)]); sum += c; cnt += (c > 0u) ? 1u : 0u; mine = (j == x) ? c : mine; }
        if (sum == G) break;
        __builtin_amdgcn_s_sleep(1);
        if ((++sp & 255u) == 0u) { if (xb_ld(&bar[XB_TMO])) break; if (sp > XB_SPIN_CAP) { atomicAdd(&bar[XB_TMO], 1u); break; } }
    }
    nloc = mine > 0u ? mine : 1u; nx = cnt > 0u ? cnt : 1u;
}
__device__ __forceinline__ void xcd_barrier(const XcdBarrier& b) {
    asm volatile("s_waitcnt vmcnt(0)" ::: "memory");
    __syncthreads();
    if (threadIdx.x == 0) {
        unsigned* bar = b.bar;
        __builtin_amdgcn_s_waitcnt(0);
        unsigned nloc = b.st[0], nx = b.st[1];
        if (nloc == 0u) { xcd_barrier_complete(bar, b.x, nloc, nx); b.st[0] = nloc; b.st[1] = nx; }
        const unsigned old = xb_add(&bar[XB_XSUB(b.x)], 1u);
        const unsigned gen = old / nloc;
        if (old + 1u == (gen + 1u) * nloc) {
            __builtin_amdgcn_fence(__ATOMIC_RELEASE, "agent");
            asm volatile("s_waitcnt vmcnt(0)" ::: "memory");
            const unsigned og = xb_add(&bar[XB_TOP], 1u);
            const unsigned tg = og / nx;
            if (og + 1u == (tg + 1u) * nx) xb_add(&bar[XB_TOPGEN], 1u);
            else XB_SPIN(xb_ld(&bar[XB_TOPGEN]) == tg, bar);
            __builtin_amdgcn_fence(__ATOMIC_ACQUIRE, "agent");
            xb_add(&bar[XB_XGEN(b.x)], 1u);
            asm volatile("s_waitcnt vmcnt(0)" ::: "memory");
        } else {
            XB_SPIN(xb_ld(&bar[XB_XGEN(b.x)]) == gen, bar);
            __builtin_amdgcn_fence(__ATOMIC_ACQUIRE, "agent");
            asm volatile("s_waitcnt vmcnt(0)" ::: "memory");
        }
    }
    __syncthreads();
}

__global__ void __launch_bounds__(NTHREADS, 2) fwd_megakernel(Params P) {
    extern __shared__ __attribute__((aligned(16))) unsigned char shm[];
    cg::grid_group grid = cg::this_grid();
    LAS unsigned char* lds = (LAS unsigned char*)shm;
    const int G = gridDim.x, bid = blockIdx.x, NGW = G * NWAVES;
#define FRESH() int tid = threadIdx.x; asm volatile("" : "+v"(tid)); const int lane = tid & 63, wave = __builtin_amdgcn_readfirstlane(tid >> 6), gw = bid * NWAVES + wave; (void)lane; (void)gw
#define TAB ((LAS float*)(lds + LDS_MISC))
    { FRESH();
      if (tid < 64) TAB[tid] = cospif((float)tid * (1.f / 32.f));
      if (tid < 4) ((volatile LAS unsigned*)(lds + LDS_MISC + 1024))[tid] = 0u; }
    __syncthreads();
    const XcdBarrier xbar = xcd_barrier_post((unsigned*)P.ws, (volatile LAS unsigned*)(lds + LDS_MISC + 1024));
#define GSYNC() xcd_barrier(xbar)

    unsigned char* ws = P.ws;
#define Xb ((bf16_t*)(ws + WS_X))
#define Hb ((bf16_t*)(ws + WS_H))
#define Pb ((bf16_t*)P.out)
#define Ib ((bf16_t*)(ws + WS_INTER))
#define MFb ((bf16_t*)(ws + WS_MF))
#define A0b ((bf16_t*)(ws + WS_H))
#define A1b ((bf16_t*)P.out)
#define RSb ((float*)(ws + WS_RS))

    {
        FRESH();
        LAS float* scr = (LAS float*)(lds + wave * 8704);
        constexpr int I_IN = 16 * 48, I_OUT = 16 * 32, I_UP = 16 * 128, I_DN = 64 * 32, I_F = 128, I_L = I_IN + I_OUT + I_UP + I_DN + I_F;
        for (int it = gw; it < NL * I_L; it += NGW) {
            const int l = it / I_L; int r = it % I_L;
            bf16_t* Wl = (bf16_t*)(ws + WS_W + (size_t)l * WL_SZ);
            const float* win = P.w_in + (size_t)l * D * DIN;
            if (r < I_IN) { p0_transpose_item<true>(win, D, DIN, 48, Wl + WL_IN / 2, P.g_mix_pre + l * D, scr, r, lane); continue; } r -= I_IN;
            if (r < I_OUT) {
                const int kb = r / 32; const float* gsrc = kb < 8 ? P.g_conv_out + l * 512 : P.g_fourier_out + l * 512 - 512;
                p0_transpose_item(P.w_out + (size_t)l * D * D, D, D, 32, Wl + WL_OUT / 2, gsrc, scr, r, lane); continue; } r -= I_OUT;
            if (r < I_UP) { p0_transpose_item(P.w_up + (size_t)l * D * DFF, D, DFF, 128, Wl + WL_UP / 2, P.g_mlp_pre + l * D, scr, r, lane); continue; } r -= I_UP;
            if (r < I_DN) { p0_transpose_item(P.w_down + (size_t)l * DFF * D, DFF, D, 32, Wl + WL_DN / 2, nullptr, scr, r, lane); continue; } r -= I_DN;
            p0_fold_item(win, P.g_mix_pre + l * D, Wl + WL_IN / 2, TAB, r, lane);
        }
        for (int t = gw * 4; t < T; t += NGW * 4) x_rows_init<4>(t < TP ? P.xp + (size_t)t * D : P.xs + (size_t)(t - TP) * D, Xb + (size_t)t * D, RSb + t, lane);
    }
    grid.sync();

    for (int l = 0; l < NL; ++l) {
        const bf16_t* Wl = (const bf16_t*)(ws + WS_W + (size_t)l * WL_SZ);
        { pg8::Gemm g{Xb, Wl + WL_IN / 2, T, DIN, D, nullptr, 1 << 20}; pg8::StaticOrder S; S.init(T, DIN, G, bid); pg8::EpiInProj E{Pb, RSb};
          pg8::gemm_phase(lds, g, S, E); }
        GSYNC();
        {
            FRESH();
            constexpr int NCONV = T / 128;
            for (int it = bid; it < NCONV; it += G) { const int t0 = it * 128 + wave * 16; const int S = t0 < TP ? SP : SS; const int pos0 = t0 < TP ? (t0 & (SP - 1)) : ((t0 - TP) & (SS - 1));
                conv_wave_item(Pb, P.conv_w + (size_t)l * 3 * 512, Hb, t0, pos0, S, lane); }
            fft_pass1(Pb, Ib, lds, bid, G, tid);
        }
        GSYNC();
        { FRESH(); fft_pass2<7>(Ib, Hb, lds, bid, 1024, G, tid); }
        { FRESH(); fft_pass2s(Ib, Hb, lds, bid, 2048, G, tid); }
        GSYNC();
        { pg8::Gemm g{Hb, Wl + WL_OUT / 2, T, D, D, nullptr, 1 << 20}; pg8::StaticOrder S; S.init(T, D, G, bid); pg8::EpiBf16 E{MFb, D, 0, nullptr, nullptr, 1 << 20};
          pg8::gemm_phase(lds, g, S, E); }
        GSYNC();
        { FRESH();
          for (int t = gw * 8; t < T; t += NGW * 8) row_pass_rows<8>(Xb, MFb, P.g_mix_post + l * D, RSb, nullptr, false, t, lane); }
        GSYNC();
        { pg8::Gemm g{Xb, Wl + WL_UP / 2, T, DFF, D, nullptr, 1 << 20}; pg8::StaticOrder S; S.init(T, DFF, G, bid); pg8::EpiBf16 E{A0b, DFF, 1, nullptr, A1b, TCH / 256};
          pg8::gemm_phase(lds, g, S, E); }
        GSYNC();
        { pg8::Gemm g{A0b, Wl + WL_DN / 2, T, D, DFF, A1b, TCH / 256}; pg8::StaticOrder S; S.init(T, D, G, bid); pg8::EpiBf16 E{MFb, D, 0, nullptr, nullptr, 1 << 20};
          pg8::gemm_phase(lds, g, S, E); }
        GSYNC();
        { FRESH();
          float* outf = (l + 1 < NL) ? nullptr : P.out;
          for (int t = gw * 8; t < T; t += NGW * 8) row_pass_rows<8>(Xb, MFb, P.g_mlp_post + l * D, RSb, outf, true, t, lane); }
        if (l + 1 < NL) GSYNC();
    }
}

extern "C" void kernel_launch(void* const* d_in, const int* in_sizes, int n_in, void* d_out, int out_size, void* d_ws, size_t ws_size, hipStream_t stream) {
    static int grid_blocks = 0;
    if (grid_blocks == 0) {
        if (n_in != 13 || out_size != T * D || ws_size < WS_END) { fprintf(stderr, "kernel_launch: unexpected shapes (n_in %d, out %d, ws %zu, need %zu)\n", n_in, out_size, ws_size, (size_t)WS_END); grid_blocks = -1; return; }
        int dev = 0, cus = 0, per_cu = 0;
        hipGetDevice(&dev);
        hipDeviceGetAttribute(&cus, hipDeviceAttributeMultiprocessorCount, dev);
        if (hipFuncSetAttribute((const void*)fwd_megakernel, hipFuncAttributeMaxDynamicSharedMemorySize, LDS_BYTES) != hipSuccess) { fprintf(stderr, "kernel_launch: hipFuncSetAttribute failed\n"); grid_blocks = -1; return; }
        hipOccupancyMaxActiveBlocksPerMultiprocessor(&per_cu, (const void*)fwd_megakernel, NTHREADS, LDS_BYTES);
        if (per_cu < 1) { fprintf(stderr, "kernel_launch: occupancy query says %d blocks per CU\n", per_cu); per_cu = 1; }
        grid_blocks = cus * per_cu;
    }
    if (grid_blocks < 0) return;
    Params p{};
    p.xp = (const float*)d_in[0]; p.xs = (const float*)d_in[1]; p.g_mix_pre = (const float*)d_in[2]; p.w_in = (const float*)d_in[3]; p.conv_w = (const float*)d_in[4];
    p.g_conv_out = (const float*)d_in[5]; p.g_fourier_out = (const float*)d_in[6]; p.w_out = (const float*)d_in[7]; p.g_mix_post = (const float*)d_in[8];
    p.g_mlp_pre = (const float*)d_in[9]; p.w_up = (const float*)d_in[10]; p.w_down = (const float*)d_in[11]; p.g_mlp_post = (const float*)d_in[12];
    p.out = (float*)d_out; p.ws = (unsigned char*)d_ws;
    if (hipMemsetAsync(d_ws, 0, 16384, stream) != hipSuccess) { fprintf(stderr, "kernel_launch: memset failed\n"); return; }
    void* args[] = {&p};
    hipError_t e = hipLaunchCooperativeKernel((const void*)fwd_megakernel, dim3(grid_blocks), dim3(NTHREADS), args, LDS_BYTES, stream);
    if (e != hipSuccess) fprintf(stderr, "cooperative launch failed: %s (grid %d)\n", hipGetErrorString(e), grid_blocks);
}
```

```cpp
#include <hip/hip_runtime.h>
#include <hip/hip_cooperative_groups.h>
#include <cstdio>
namespace cg = cooperative_groups;

#define LAS __attribute__((address_space(3)))
typedef unsigned short bf16_t;
typedef short bf16x8 __attribute__((ext_vector_type(8)));
typedef float f32x4 __attribute__((ext_vector_type(4)));
typedef float f32x2 __attribute__((ext_vector_type(2)));
typedef unsigned u32x4 __attribute__((ext_vector_type(4)));
typedef unsigned u32x2 __attribute__((ext_vector_type(2)));

constexpr int D = 1024, DIN = 2048, DFF = 4096, NL = 4;
constexpr int PLD = 1536;
constexpr int SP = 16384, BP = 2, SS = 8192, BS = 8;
constexpr int TP = BP * SP, TS = BS * SS, T = TP + TS;
constexpr float EPS = 1e-6f;
constexpr int NCH = 2;
constexpr int TCH = T / NCH;

constexpr size_t MiB = (size_t)1 << 20;
constexpr size_t WS_W = 1 * MiB;
constexpr size_t WL_IN = 0, WL_OUT = 4 * MiB, WL_UP = 6 * MiB, WL_DN = 14 * MiB, WL_SZ = 22 * MiB;
constexpr size_t WS_X = WS_W + NL * WL_SZ;
constexpr size_t WS_H = WS_X + (size_t)T * D * 2;
constexpr size_t WS_INTER = WS_H + (size_t)T * D * 2;
constexpr size_t WS_MF = WS_INTER + (size_t)T * 256 * 8;
constexpr size_t WS_RS = WS_MF + (size_t)T * D * 2;
constexpr size_t WS_END = WS_RS + 1 * MiB;

constexpr int LDS_STAGE = 131072, LDS_MISC = 139264, LDS_BYTES = LDS_MISC + 4096;
constexpr int NTHREADS = 512, NWAVES = 8;

struct Params {
    const float* xp; const float* xs; const float* g_mix_pre; const float* w_in; const float* conv_w;
    const float* g_conv_out; const float* g_fourier_out; const float* w_out; const float* g_mix_post;
    const float* g_mlp_pre; const float* w_up; const float* w_down; const float* g_mlp_post;
    float* out; unsigned char* ws;
};

__device__ __forceinline__ unsigned cvt_pk_bf16(float lo, float hi) { unsigned r; asm volatile("v_cvt_pk_bf16_f32 %0, %1, %2" : "=v"(r) : "v"(lo), "v"(hi)); return r; }
__device__ __forceinline__ float bf_lo(unsigned w) { return __uint_as_float(w << 16); }
__device__ __forceinline__ float bf_hi(unsigned w) { return __uint_as_float(w & 0xffff0000u); }
template <int CTRL> __device__ __forceinline__ float dpp_f(float x) { return __builtin_bit_cast(float, __builtin_amdgcn_update_dpp(0, __builtin_bit_cast(int, x), CTRL, 0xF, 0xF, true)); }
__device__ __forceinline__ float xadd1(float v) { return v + dpp_f<0xB1>(v); }
__device__ __forceinline__ float xadd2(float v) { return v + dpp_f<0x4E>(v); }
__device__ __forceinline__ float xadd4(float v) { return v + dpp_f<0x141>(v); }
__device__ __forceinline__ float xadd8(float v) { return v + dpp_f<0x140>(v); }
__device__ __forceinline__ float xadd16(float v) { float a = v, b = v; asm volatile("s_nop 1\n\tv_permlane16_swap_b32 %0, %1" : "+v"(a), "+v"(b)); return a + b; }
__device__ __forceinline__ float xadd32(float v) { float a = v, b = v; asm volatile("s_nop 1\n\tv_permlane32_swap_b32 %0, %1" : "+v"(a), "+v"(b)); return a + b; }
__device__ __forceinline__ float wave_sum(float v) { return xadd32(xadd16(xadd8(xadd4(xadd2(xadd1(v)))))); }
__device__ __forceinline__ void load8(const bf16_t* ptr, float (&v)[8]) {
    const u32x4 q = *(const u32x4*)ptr;
    v[0] = bf_lo(q.x); v[1] = bf_hi(q.x); v[2] = bf_lo(q.y); v[3] = bf_hi(q.y); v[4] = bf_lo(q.z); v[5] = bf_hi(q.z); v[6] = bf_lo(q.w); v[7] = bf_hi(q.w);
}

namespace pg8 {
constexpr int BM = 256, BK = 64, HALF = 128, HTB = HALF * BK * 2, STAGE_BYTES = 8 * HTB, NXCD = 8, WGM = 8;
__device__ __forceinline__ int lds_byte(int r, int c) { const int st = (r >> 4) * 2 + (c >> 5), rr = r & 15, cc = c & 31, ob = rr * 64 + cc * 2; return st * 1024 + (ob ^ (((ob >> 9) & 1) << 5)); }
__device__ __forceinline__ void stage_rc(int b, int& R, int& C) { const int st = b / 1024, sb = b % 1024, swz = sb ^ (((sb >> 9) & 1) << 5); R = (st >> 1) * 16 + swz / 64; C = (st & 1) * 32 + (swz % 64) / 2; }
__device__ __forceinline__ int perm32(int rho) { const int n = rho >> 4, i = rho & 15; return 8 * (i >> 2) + 4 * n + (i & 3); }

struct Unit { int pm, pn; };
struct Gemm { const bf16_t* A; const bf16_t* Bt; int M, N, K; const bf16_t* A2; int split; };

struct StaticOrder {
    int nM, nN, nwg, G, c;
    __device__ void init(int M, int N, int G_, int c_) { nM = M / BM; nN = N / BM; nwg = nM * nN; G = G_; c = c_; }
    __device__ bool next(int i, Unit& u) const {
        const long L = (long)i * G + c; if (L >= nwg) return false;
        int wgid = (int)L; { const int q = nwg / NXCD, r = nwg % NXCD, xcd = wgid % NXCD, off = wgid / NXCD; wgid = (xcd < r ? xcd * (q + 1) : r * (q + 1) + (xcd - r) * q) + off; }
        const int nig = WGM * nN, gid = wgid / nig, fm = gid * WGM, gsz = (nM - fm) < WGM ? (nM - fm) : WGM;
        u.pm = fm + ((wgid % nig) % gsz); u.pn = (wgid % nig) / gsz; return true;
    }
};

struct EpiBf16 {
    static constexpr bool FUSED = false;
    bf16_t* O; int ldc; int act; const float* rs; bf16_t* O2; int split;
    __device__ __forceinline__ void operator()(const f32x4 (&acc)[2][2][4][2], const Unit& u, int wr, int wc, int fr, int fq) const {
        const bool lo = u.pm < split; bf16_t* Ob = lo ? O : O2;
        const int grow0 = u.pm * BM + wr * 64 + fr, row0 = grow0 - (lo ? 0 : split * BM); const int col0 = u.pn * BM + wc * 32 + 8 * fq;
#pragma unroll
        for (int ai = 0; ai < 2; ++ai)
#pragma unroll
            for (int m = 0; m < 4; ++m) { bf16_t* rowp = Ob + (size_t)(row0 + ai * HALF + m * 16) * ldc + col0; const float sc = rs ? rs[grow0 + ai * HALF + m * 16] : 1.f;
#pragma unroll
                for (int bj = 0; bj < 2; ++bj) { f32x4 v0 = acc[ai][bj][m][0] * sc, v1 = acc[ai][bj][m][1] * sc;
                    if (act) {
#pragma unroll
                        for (int j = 0; j < 4; ++j) { float a0, a1; asm("v_max_f32 %0, 0, %1" : "=v"(a0) : "v"(v0[j])); asm("v_max_f32 %0, 0, %1" : "=v"(a1) : "v"(v1[j])); v0[j] = a0; v1[j] = a1; }
                        f32x2 p0 = (f32x2){v0[0], v0[1]}, p1 = (f32x2){v0[2], v0[3]}, p2 = (f32x2){v1[0], v1[1]}, p3 = (f32x2){v1[2], v1[3]};
                        p0 = p0 * p0; p1 = p1 * p1; p2 = p2 * p2; p3 = p3 * p3;
                        v0 = (f32x4){p0.x, p0.y, p1.x, p1.y}; v1 = (f32x4){p2.x, p2.y, p3.x, p3.y}; }
                    u32x4 w; w.x = cvt_pk_bf16(v0[0], v0[1]); w.y = cvt_pk_bf16(v0[2], v0[3]); w.z = cvt_pk_bf16(v1[0], v1[1]); w.w = cvt_pk_bf16(v1[2], v1[3]);
                    *(u32x4*)(rowp + bj * HALF) = w; } }
    }
};


struct EpiInProj {
    static constexpr bool FUSED = false;
    bf16_t* O; const float* rs;
    __device__ __forceinline__ void operator()(const f32x4 (&acc)[2][2][4][2], const Unit& u, int wr, int wc, int fr, int fq) const {
        const int row0 = u.pm * BM + wr * 64 + fr, sub = wc * 32 + 8 * fq;
        const bool isz = (u.pn >= 2 && u.pn < 6);
        const int cbase = isz ? 512 + (u.pn - 2) * 128 + sub : (u.pn < 2 ? u.pn * BM + sub : 1024 + (u.pn - 6) * BM + sub);
#pragma unroll
        for (int ai = 0; ai < 2; ++ai)
#pragma unroll
            for (int m = 0; m < 4; ++m) { const int row = row0 + ai * HALF + m * 16; bf16_t* rowp = O + (size_t)row * PLD + cbase; const float sc = rs[row];
                if (isz) { const float s2 = sc * sc; const f32x4 z0 = acc[ai][0][m][0] * acc[ai][1][m][0] * s2, z1 = acc[ai][0][m][1] * acc[ai][1][m][1] * s2;
                    u32x4 w; w.x = cvt_pk_bf16(z0[0], z0[1]); w.y = cvt_pk_bf16(z0[2], z0[3]); w.z = cvt_pk_bf16(z1[0], z1[1]); w.w = cvt_pk_bf16(z1[2], z1[3]);
                    *(u32x4*)rowp = w; }
                else {
#pragma unroll
                    for (int bj = 0; bj < 2; ++bj) { const f32x4 v0 = acc[ai][bj][m][0] * sc, v1 = acc[ai][bj][m][1] * sc;
                        u32x4 w; w.x = cvt_pk_bf16(v0[0], v0[1]); w.y = cvt_pk_bf16(v0[2], v0[3]); w.z = cvt_pk_bf16(v1[0], v1[1]); w.w = cvt_pk_bf16(v1[2], v1[3]);
                        *(u32x4*)(rowp + bj * HALF) = w; } } }
    }
};

template <class Epi, class Sched>
__device__ __forceinline__ void gemm_phase(LAS unsigned char* lds, const Gemm g, const Sched& S, const Epi& E) {
    int tid_ = threadIdx.x; asm volatile("" : "+v"(tid_));
    const int tid = tid_, wid = __builtin_amdgcn_readfirstlane(tid >> 6), lane = tid & 63, wr = wid >> 2, wc = wid & 3, fr = lane & 15, fq = lane >> 4;
    const int K = g.K, nt = K / BK;
    unsigned voffA[2], voffB[2];
#pragma unroll
    for (int i = 0; i < 2; ++i) { int R, C; stage_rc(tid * 16 + i * 8192, R, C); const int Rb = (R & ~31) + perm32(R & 31);
        voffA[i] = (unsigned)(R * K + C) * 2u; voffB[i] = (unsigned)(Rb * K + C) * 2u; }
    const size_t kstep = (size_t)(BK * 2);
    const size_t hstep = (size_t)HALF * K * 2;
    const size_t tstep = 2 * hstep;
    const unsigned ldsw = (unsigned)wid * 1024u;
    const int aoff = lds_byte(wr * 64 + fr, fq * 8), boff = lds_byte(wc * 32 + fr, fq * 8);
#define PG8_SA(b, h) (((b) * 2 + (h)) * HTB)
#define PG8_SB(b, h) ((4 + (b) * 2 + (h)) * HTB)
#define PG8_STAGE(bufoff, gbase, voff) do { _Pragma("unroll") for (int _i = 0; _i < 2; ++_i) \
        __builtin_amdgcn_global_load_lds((const unsigned*)((const char*)(gbase) + (voff)[_i]), (LAS unsigned*)(lds + (bufoff) + ldsw + _i * 8192), 16, 0, 0); } while (0)
#define PG8_LDA(dst, b, h) do { _Pragma("unroll") for (int m = 0; m < 4; ++m) _Pragma("unroll") for (int k = 0; k < 2; ++k) dst[m][k] = *(const LAS bf16x8*)(lds + PG8_SA(b, h) + aoff + m * 2048 + k * 1024); } while (0)
#define PG8_LDB(dst, b, h) do { _Pragma("unroll") for (int n = 0; n < 2; ++n) _Pragma("unroll") for (int k = 0; k < 2; ++k) dst[n][k] = *(const LAS bf16x8*)(lds + PG8_SB(b, h) + boff + n * 2048 + k * 1024); } while (0)
#define PG8_MMA(ai, bj, At, Bt) do { __builtin_amdgcn_s_setprio(1); _Pragma("unroll") for (int m = 0; m < 4; ++m) _Pragma("unroll") for (int n = 0; n < 2; ++n) _Pragma("unroll") for (int k = 0; k < 2; ++k) \
        acc[ai][bj][m][n] = __builtin_amdgcn_mfma_f32_16x16x32_bf16(Bt[n][k], At[m][k], acc[ai][bj][m][n], 0, 0, 0); __builtin_amdgcn_s_setprio(0); } while (0)
#define PG8_WAIT_V(n) asm volatile("s_waitcnt vmcnt(" #n ")" ::: "memory")
#define PG8_WAIT_L(n) asm volatile("s_waitcnt lgkmcnt(" #n ")" ::: "memory")
#define PG8_BAR __builtin_amdgcn_s_barrier()
#define PG8_SCHED __builtin_amdgcn_sched_barrier(0)
    Unit cur, nxt; int ui = 0;
    if (!S.next(0, cur)) return;
    f32x4 acc[2][2][4][2];
#pragma unroll
    for (int a = 0; a < 2; ++a)
#pragma unroll
        for (int b = 0; b < 2; ++b)
#pragma unroll
            for (int m = 0; m < 4; ++m)
#pragma unroll
                for (int n = 0; n < 2; ++n) acc[a][b][m][n] = (f32x4){0.f, 0.f, 0.f, 0.f};
    bf16x8 At[4][2], B0[2][2], B1[2][2];
#define PG8_APANEL(pm_) ((const char*)(((pm_) < g.split ? (unsigned long long)g.A : (unsigned long long)g.A2 - (unsigned long long)g.split * tstep) + (unsigned long long)(pm_) * tstep))
    const char* cA = PG8_APANEL(cur.pm); const char* cB = (const char*)g.Bt + (size_t)cur.pn * tstep;
    PG8_STAGE(PG8_SB(0, 0), cB, voffB); PG8_STAGE(PG8_SA(0, 0), cA, voffA); PG8_STAGE(PG8_SB(0, 1), cB + hstep, voffB); PG8_STAGE(PG8_SA(0, 1), cA + hstep, voffA);
    if (wr == 1) PG8_BAR;
    PG8_WAIT_V(4); PG8_BAR;
    PG8_STAGE(PG8_SB(1, 0), cB + kstep, voffB); PG8_STAGE(PG8_SA(1, 0), cA + kstep, voffA); PG8_STAGE(PG8_SB(1, 1), cB + hstep + kstep, voffB);
    PG8_WAIT_V(6); PG8_BAR;
    for (;;) {
        const bool has_next = S.next(ui + 1, nxt);
        const char* nA = has_next ? PG8_APANEL(nxt.pm) : cA; const char* nB = has_next ? (const char*)g.Bt + (size_t)nxt.pn * tstep : cB;
        for (int t = 0; t < nt; t += 2) {
            const bool last = (t == nt - 2);
            const char* a1 = cA + (size_t)(t + 1) * kstep;
            const char* a2 = last ? nA : cA + (size_t)(t + 2) * kstep; const char* b2 = last ? nB : cB + (size_t)(t + 2) * kstep;
            const char* a3 = a2 + kstep; const char* b3 = b2 + kstep;
            PG8_LDB(B0, 0, 0); PG8_SCHED; PG8_LDA(At, 0, 0); PG8_STAGE(PG8_SA(1, 1), a1 + hstep, voffA);
            PG8_WAIT_L(8); PG8_BAR; PG8_WAIT_L(0); PG8_MMA(0, 0, At, B0); PG8_BAR; PG8_SCHED;
            PG8_LDB(B1, 0, 1); PG8_STAGE(PG8_SB(0, 0), b2, voffB);
            PG8_BAR; PG8_WAIT_L(0); PG8_MMA(0, 1, At, B1); PG8_BAR;
            PG8_LDA(At, 0, 1); PG8_STAGE(PG8_SA(0, 0), a2, voffA);
            PG8_BAR; PG8_WAIT_L(0); PG8_MMA(1, 0, At, B0); PG8_BAR; PG8_SCHED;
            PG8_STAGE(PG8_SB(0, 1), b2 + hstep, voffB);
            PG8_WAIT_V(6); PG8_BAR; PG8_MMA(1, 1, At, B1); PG8_BAR;
            PG8_LDB(B0, 1, 0); PG8_SCHED; PG8_LDA(At, 1, 0); PG8_STAGE(PG8_SA(0, 1), a2 + hstep, voffA);
            PG8_WAIT_L(8); PG8_BAR; PG8_WAIT_L(0); PG8_MMA(0, 0, At, B0); PG8_BAR; PG8_SCHED;
            PG8_LDB(B1, 1, 1); PG8_STAGE(PG8_SB(1, 0), b3, voffB);
            PG8_BAR; PG8_WAIT_L(0); PG8_MMA(0, 1, At, B1); PG8_BAR;
            PG8_LDA(At, 1, 1); PG8_STAGE(PG8_SA(1, 0), a3, voffA);
            PG8_BAR; PG8_WAIT_L(0); PG8_MMA(1, 0, At, B0); PG8_BAR; PG8_SCHED;
            PG8_STAGE(PG8_SB(1, 1), b3 + hstep, voffB);
            PG8_WAIT_V(6); PG8_BAR; PG8_MMA(1, 1, At, B1); PG8_BAR;
        }
        if (wr == 0) PG8_BAR;
        E(acc, cur, wr, wc, fr, fq);
        if (wr == 1) PG8_BAR;
        if (!has_next) break;
#pragma unroll
        for (int a = 0; a < 2; ++a)
#pragma unroll
            for (int b = 0; b < 2; ++b)
#pragma unroll
                for (int m = 0; m < 4; ++m)
#pragma unroll
                    for (int n = 0; n < 2; ++n) acc[a][b][m][n] = (f32x4){0.f, 0.f, 0.f, 0.f};
        cur = nxt; cA = nA; cB = nB; ++ui;
    }
    PG8_WAIT_V(0);
    if (wr == 0) PG8_BAR;
    PG8_BAR;
#undef PG8_APANEL
#undef PG8_SA
#undef PG8_SB
#undef PG8_STAGE
#undef PG8_LDA
#undef PG8_LDB
#undef PG8_MMA
#undef PG8_WAIT_V
#undef PG8_WAIT_L
#undef PG8_BAR
#undef PG8_SCHED
}
}

template <bool INPROJ = false>
__device__ __forceinline__ void p0_transpose_item(const float* W, int K, int ldN, int nblk, bf16_t* WT, const float* gain, LAS float* scr, int item, int lane) {
    const int kb = item / nblk, nb = item % nblk, k0 = 64 * kb, n0 = 32 * nb;
    const int dn0 = !INPROJ || n0 < 512 ? n0 : (n0 < 1024 ? 512 + ((n0 - 512) >> 7) * 256 + ((n0 - 512) & 127) : 512 + ((n0 - 1024) >> 7) * 256 + 128 + ((n0 - 1024) & 127));
    float wv[32];
#pragma unroll
    for (int i = 0; i < 32; ++i) wv[i] = W[(size_t)(k0 + 2 * i + (lane >> 5)) * ldN + n0 + (lane & 31)];
#pragma unroll
    for (int i = 0; i < 32; ++i) { const int kk = 2 * i + (lane >> 5); const float gk = gain ? gain[k0 + kk] : 1.f;
        scr[kk * 33 + (lane & 31)] = wv[i] * gk; }
    asm volatile("s_waitcnt lgkmcnt(0)" ::: "memory");
    const int c = lane & 7;
#pragma unroll
    for (int j = 0; j < 4; ++j) { const int n = (lane >> 3) + 8 * j; const LAS float* s = scr + (8 * c) * 33 + n;
        u32x4 o; o.x = cvt_pk_bf16(s[0 * 33], s[1 * 33]); o.y = cvt_pk_bf16(s[2 * 33], s[3 * 33]); o.z = cvt_pk_bf16(s[4 * 33], s[5 * 33]); o.w = cvt_pk_bf16(s[6 * 33], s[7 * 33]);
        *(u32x4*)(WT + (size_t)(dn0 + n) * K + k0 + 8 * c) = o; }
    asm volatile("s_waitcnt lgkmcnt(0)" ::: "memory");
}
__device__ __forceinline__ void p0_fold_item(const float* Win  , const float* gpre, bf16_t* WT  , const LAS float* tab, int item, int lane) {
    const int kb = item >> 3, g = item & 7, k = kb * 64 + lane;
    const float gk = gpre[k] * 0.125f;
    const f32x4* src = (const f32x4*)(Win + (size_t)k * DIN + 1536 + g * 64);
    float row[64];
#pragma unroll
    for (int i = 0; i < 16; ++i) { const f32x4 v = src[i]; row[4 * i] = v.x * gk; row[4 * i + 1] = v.y * gk; row[4 * i + 2] = v.z * gk; row[4 * i + 3] = v.w * gk; }
    for (int j = 0; j < 64; ++j) {
        const int cj = (j == 0) ? 0 : (j == 1 ? 32 : (j >> 1)), off = (j >= 2 && (j & 1)) ? 16 : 0;
        float acc = 0.f;
#pragma unroll
        for (int d = 0; d < 64; ++d) acc += row[d] * tab[(cj * d + off) & 63];
        WT[(size_t)(1536 + g * 64 + j) * D + k] = (bf16_t)(cvt_pk_bf16(acc, 0.f) & 0xffffu);
    }
}
template <int NR>
__device__ __forceinline__ void x_rows_init(const float* xrow0, bf16_t* orow0, float* rs, int lane) {
    f32x4 v[NR][4];
#pragma unroll
    for (int r = 0; r < NR; ++r) { const f32x4* xr = (const f32x4*)(xrow0 + (size_t)r * D) + lane;
#pragma unroll
        for (int j = 0; j < 4; ++j) v[r][j] = xr[64 * j]; }
#pragma unroll
    for (int r = 0; r < NR; ++r) { float s = 0.f;
#pragma unroll
        for (int j = 0; j < 4; ++j) s += (v[r][j].x * v[r][j].x + v[r][j].y * v[r][j].y) + (v[r][j].z * v[r][j].z + v[r][j].w * v[r][j].w);
        const float rstd = rsqrtf(wave_sum(s) * (1.f / D) + EPS);
        u32x2* o8 = (u32x2*)(orow0 + (size_t)r * D) + lane;
#pragma unroll
        for (int j = 0; j < 4; ++j) { u32x2 w; w.x = cvt_pk_bf16(v[r][j].x, v[r][j].y); w.y = cvt_pk_bf16(v[r][j].z, v[r][j].w); o8[64 * j] = w; }
        if (lane == 0) rs[r] = rstd; }
}

template <int NR>
__device__ __forceinline__ void row_pass_rows(bf16_t* X, const bf16_t* MF, const float* gain, float* rs, float* outf, bool unscaled, int t0, int lane) {
    u32x4 xa[NR][2], ma[NR][2];
#pragma unroll
    for (int r = 0; r < NR; ++r) { const u32x4* xr = (const u32x4*)(X + (size_t)(t0 + r) * D); const u32x4* mr = (const u32x4*)(MF + (size_t)(t0 + r) * D);
        xa[r][0] = xr[lane]; xa[r][1] = xr[64 + lane]; ma[r][0] = mr[lane]; ma[r][1] = mr[64 + lane]; }
    float g[16];
    { const f32x4* g0 = (const f32x4*)(gain + lane * 8); const f32x4* g1 = (const f32x4*)(gain + 512 + lane * 8);
#pragma unroll
      for (int h = 0; h < 2; ++h) { const f32x4 a = g0[h], b = g1[h];
#pragma unroll
        for (int k = 0; k < 4; ++k) { g[4 * h + k] = a[k]; g[8 + 4 * h + k] = b[k]; } } }
#pragma unroll
    for (int r = 0; r < NR; ++r) {
        float x[16], m[16];
#pragma unroll
        for (int h = 0; h < 2; ++h) { const u32x4 xq = xa[r][h], mq = ma[r][h];
            x[8 * h + 0] = bf_lo(xq.x); x[8 * h + 1] = bf_hi(xq.x); x[8 * h + 2] = bf_lo(xq.y); x[8 * h + 3] = bf_hi(xq.y); x[8 * h + 4] = bf_lo(xq.z); x[8 * h + 5] = bf_hi(xq.z); x[8 * h + 6] = bf_lo(xq.w); x[8 * h + 7] = bf_hi(xq.w);
            m[8 * h + 0] = bf_lo(mq.x); m[8 * h + 1] = bf_hi(mq.x); m[8 * h + 2] = bf_lo(mq.y); m[8 * h + 3] = bf_hi(mq.y); m[8 * h + 4] = bf_lo(mq.z); m[8 * h + 5] = bf_hi(mq.z); m[8 * h + 6] = bf_lo(mq.w); m[8 * h + 7] = bf_hi(mq.w); }
        float sm = 0.f;
#pragma unroll
        for (int k = 0; k < 16; ++k) sm += m[k] * m[k];
        float eps_eff = EPS; if (unscaled) { const float rr = rs[t0 + r], r2 = rr * rr; eps_eff = EPS / (r2 * r2); }
        const float rm = rsqrtf(wave_sum(sm) * (1.f / D) + eps_eff);
        float s1 = 0.f;
#pragma unroll
        for (int k = 0; k < 16; ++k) { x[k] = x[k] + m[k] * rm * g[k]; s1 += x[k] * x[k]; }
        if (outf) {
            f32x4* o = (f32x4*)(outf + (size_t)(t0 + r) * D);
            o[lane * 2] = (f32x4){x[0], x[1], x[2], x[3]}; o[lane * 2 + 1] = (f32x4){x[4], x[5], x[6], x[7]};
            o[128 + lane * 2] = (f32x4){x[8], x[9], x[10], x[11]}; o[128 + lane * 2 + 1] = (f32x4){x[12], x[13], x[14], x[15]};
        } else {
            const float r1 = rsqrtf(wave_sum(s1) * (1.f / D) + EPS);
            u32x4* xo = (u32x4*)(X + (size_t)(t0 + r) * D);
            u32x4 w0, w1;
            w0.x = cvt_pk_bf16(x[0], x[1]); w0.y = cvt_pk_bf16(x[2], x[3]); w0.z = cvt_pk_bf16(x[4], x[5]); w0.w = cvt_pk_bf16(x[6], x[7]);
            w1.x = cvt_pk_bf16(x[8], x[9]); w1.y = cvt_pk_bf16(x[10], x[11]); w1.z = cvt_pk_bf16(x[12], x[13]); w1.w = cvt_pk_bf16(x[14], x[15]);
            xo[lane] = w0; xo[64 + lane] = w1;
            if (lane == 0) rs[t0 + r] = r1;
        }
    }
}

__device__ __forceinline__ void conv_wave_item(const bf16_t* p, const float* cw, bf16_t* Hm, int t0, int pos0, int S, int lane) {
    float w0[8], w1[8], w2[8];
    { const f32x4* a = (const f32x4*)(cw + lane * 8); const f32x4* b = (const f32x4*)(cw + 512 + lane * 8); const f32x4* c = (const f32x4*)(cw + 1024 + lane * 8);
#pragma unroll
      for (int h = 0; h < 2; ++h) { const f32x4 va = a[h], vb = b[h], vc = c[h];
#pragma unroll
        for (int k = 0; k < 4; ++k) { w0[4 * h + k] = va[k]; w1[4 * h + k] = vb[k]; w2[4 * h + k] = vc[k]; } } }
    float zp[8], zc[8], zn[8], gb[8];
    const bf16_t* base = p + (size_t)t0 * PLD + lane * 8;
    if (pos0 == 0) {
#pragma unroll
        for (int k = 0; k < 8; ++k) zp[k] = 0.f;
    } else load8(base - PLD + 512, zp);
    load8(base + 512, zc);
#pragma unroll 8
    for (int i = 0; i < 16; ++i) {
        const bf16_t* r = base + (size_t)i * PLD;
        if (pos0 + i + 1 == S) {
#pragma unroll
            for (int k = 0; k < 8; ++k) zn[k] = 0.f;
        } else load8(r + PLD + 512, zn);
        load8(r, gb);
        float y[8], ss = 0.f;
#pragma unroll
        for (int k = 0; k < 8; ++k) { y[k] = gb[k] * (zp[k] * w0[k] + zc[k] * w1[k] + zn[k] * w2[k]); ss += y[k] * y[k]; }
        ss = xadd4(xadd2(xadd1(ss)));
        const float rs = rsqrtf(ss * (1.f / 64.f) + EPS);
        u32x4 o; o.x = cvt_pk_bf16(y[0] * rs, y[1] * rs); o.y = cvt_pk_bf16(y[2] * rs, y[3] * rs); o.z = cvt_pk_bf16(y[4] * rs, y[5] * rs); o.w = cvt_pk_bf16(y[6] * rs, y[7] * rs);
        *(u32x4*)(Hm + (size_t)(t0 + i) * D + lane * 8) = o;
#pragma unroll
        for (int k = 0; k < 8; ++k) { zp[k] = zc[k]; zc[k] = zn[k]; }
    }
}

constexpr int XSTR = 272;
constexpr int RSTR = 34;
constexpr int LDS_XT = 0, LDS_R = 36864, LDS_OST = 106496;
#define LBAR() do { asm volatile("s_waitcnt lgkmcnt(0)" ::: "memory"); __builtin_amdgcn_s_barrier(); asm volatile("" ::: "memory"); } while (0)
__device__ __forceinline__ int seq_base(int bs) { return bs < BP ? bs * SP : TP + (bs - BP) * SS; }

__device__ __forceinline__ void dft_frags(bf16x8 (&Br)[4], bf16x8 (&Bi)[4], int log2n, int kt, int lane) {
    const int N = 1 << log2n, k = 16 * kt + (lane & 15); const float sc = 2.f / (float)N;
#pragma unroll
    for (int ks = 0; ks < 4; ++ks) { u32x4 wr, wi;
#pragma unroll
        for (int e2 = 0; e2 < 4; ++e2) { float c0, s0, c1, s1; const int n0 = 32 * ks + 8 * (lane >> 4) + 2 * e2;
            sincospif(-(float)((n0 * k) & (N - 1)) * sc, &s0, &c0); sincospif(-(float)(((n0 + 1) * k) & (N - 1)) * sc, &s1, &c1);
            wr[e2] = cvt_pk_bf16(c0, c1); wi[e2] = cvt_pk_bf16(s0, s1); }
        Br[ks] = __builtin_bit_cast(bf16x8, wr); Bi[ks] = __builtin_bit_cast(bf16x8, wi); }
}
template <int XS = XSTR>
__device__ __forceinline__ void xt_write(LAS unsigned char* xt, int rp, int ch, const u32x4 va, const u32x4 vb) {
    LAS unsigned char* base = xt + (8 * ch) * XS + ((((rp >> 2) ^ ch) << 4) + (rp & 3) * 4);
#pragma unroll
    for (int e2 = 0; e2 < 4; ++e2) {
        *(LAS unsigned*)(base + (2 * e2) * XS) = (va[e2] & 0xffffu) | (vb[e2] << 16);
        *(LAS unsigned*)(base + (2 * e2 + 1) * XS) = (va[e2] >> 16) | (vb[e2] & 0xffff0000u); }
}
template <int XS = XSTR>
__device__ __forceinline__ void dft_mfma(const LAS unsigned char* xt, int log2n, const bf16x8 (&Br)[4], const bf16x8 (&Bi)[4], f32x4 (&Pa)[4], f32x4 (&Qa)[4], int lane) {
#pragma unroll
    for (int it = 0; it < 4; ++it) { Pa[it] = (f32x4){0.f, 0.f, 0.f, 0.f}; Qa[it] = (f32x4){0.f, 0.f, 0.f, 0.f}; }
#pragma unroll
    for (int ks = 0; ks < 4; ++ks) if (ks < (1 << (log2n - 5))) {
#pragma unroll
        for (int it = 0; it < 4; ++it) { const int col = 16 * it + (lane & 15), gr = 4 * ks + (lane >> 4);
            const bf16x8 a = *(const LAS bf16x8*)(xt + col * XS + ((gr ^ (col >> 3)) << 4));
            Pa[it] = __builtin_amdgcn_mfma_f32_16x16x32_bf16(a, Br[ks], Pa[it], 0, 0, 0);
            Qa[it] = __builtin_amdgcn_mfma_f32_16x16x32_bf16(a, Bi[ks], Qa[it], 0, 0, 0); } }
}

__device__ __forceinline__ void p1_decode(int item, int& bs, int& g, int& n2, int& S, int& log2N2) {
    if (item < 2048) { bs = item >> 10; const int r = item & 1023; n2 = r >> 3; g = r & 7; S = SP; log2N2 = 7; }
    else { const int it = item - 2048; bs = BP + (it >> 9); const int r = it & 511; n2 = r >> 3; g = r & 7; S = SS; log2N2 = 6; }
}
__device__ __forceinline__ void p1_load(const bf16_t* p, int item, int rp, int ch, u32x4& va, u32x4& vb) {
    int bs, g, n2, S, l2; p1_decode(item, bs, g, n2, S, l2);
    const bf16_t* src = p + (size_t)(seq_base(bs) + ((2 * rp) << l2) + n2) * PLD + 1024 + g * 64 + ch * 8;
    va = *(const u32x4*)src; vb = *(const u32x4*)(src + ((size_t)PLD << l2));
}
__device__ __forceinline__ void fft_pass1(const bf16_t* p, bf16_t* inter, LAS unsigned char* lds, int bid, int G, int tid) {
    constexpr int NP1 = 2048 + 4096;
    const int lane = tid & 63, wave = __builtin_amdgcn_readfirstlane(tid >> 6), rp = tid >> 3, ch = tid & 7;
    bf16x8 Br[4], Bi[4]; dft_frags(Br, Bi, 7, wave, lane);
    u32x4 va, vb;
    if (bid < NP1) p1_load(p, bid, rp, ch, va, vb);
    int par = 0;
    for (int item = bid; item < NP1; item += G, par ^= 1) {
        LAS unsigned char* xt = lds + LDS_XT + par * (64 * XSTR);
        xt_write(xt, rp, ch, va, vb);
        if (item + G < NP1) p1_load(p, item + G, rp, ch, va, vb);
        LBAR();
        f32x4 Pa[4], Qa[4]; dft_mfma(xt, 7, Br, Bi, Pa, Qa, lane);
        int bs, g, n2, S, l2; p1_decode(item, bs, g, n2, S, l2);
        const int k1 = 16 * wave + (lane & 15), quad = lane >> 4;
        float sn, cs; sincospif(-2.0f * (float)(n2 * k1) / (float)S, &sn, &cs);
        bf16_t* dst = inter + ((size_t)seq_base(bs) * 8 + (size_t)g * S + ((size_t)k1 << l2) + n2) * 64 + 4 * quad;
#pragma unroll
        for (int it = 0; it < 4; ++it) {
            const float r0 = Pa[it][0] - Qa[it][1], i0 = Pa[it][1] + Qa[it][0], r1 = Pa[it][2] - Qa[it][3], i1 = Pa[it][3] + Qa[it][2];
            u32x2 w; w.x = cvt_pk_bf16(r0 * cs - i0 * sn, r0 * sn + i0 * cs); w.y = cvt_pk_bf16(r1 * cs - i1 * sn, r1 * sn + i1 * cs);
            *(u32x2*)(dst + 16 * it) = w; }
    }
    LBAR();
}

__device__ __forceinline__ void p2_decode(int item, int& bs, int& g, int& k1a, int& k1b, int& ip) {
    int r;
    if (item < 1024) { bs = item >> 9; r = item & 511; } else { const int it = item - 1024; bs = BP + (it >> 9); r = it & 511; }
    g = r >> 6; ip = r & 63; k1a = ip; k1b = ip == 0 ? 64 : 128 - ip;
}
template <int LOG2N>
__device__ __forceinline__ void fft_pass2(const bf16_t* inter, bf16_t* Hm, LAS unsigned char* lds, int item0, int item_end, int G, int tid) {
    constexpr int N2 = 1 << LOG2N, NTASK = N2 / 64, S = (LOG2N == 7) ? SP : SS;
    const int lane = tid & 63, wave = __builtin_amdgcn_readfirstlane(tid >> 6);
    bf16x8 Br[4], Bi[4]; dft_frags(Br, Bi, LOG2N, LOG2N == 7 ? wave : (wave & 3), lane);
    u32x4 va[NTASK], vb[NTASK];
#define P2_LOAD(item_) do { int bs_, g_, ka_, kb_, ip_; p2_decode(item_, bs_, g_, ka_, kb_, ip_); \
        const bf16_t* ib_ = inter + ((size_t)seq_base(bs_) * 8 + (size_t)g_ * S) * 64; \
        _Pragma("unroll") for (int j = 0; j < NTASK; ++j) { const int q = tid + NTHREADS * j, h = q / (4 * N2), r = q % (4 * N2), rp = r >> 3, ch = r & 7; \
            const bf16_t* src = ib_ + ((size_t)((h ? kb_ : ka_) * N2 + 2 * rp)) * 64 + ch * 8; va[j] = *(const u32x4*)src; vb[j] = *(const u32x4*)(src + 64); } } while (0)
    if (item0 < item_end) P2_LOAD(item0);
    LAS f32x2* R = (LAS f32x2*)(lds + LDS_R);
    LAS bf16_t* Ost = (LAS bf16_t*)(lds + LDS_OST);
    const float sc = rsqrtf((float)S);
    for (int item = item0; item < item_end; item += G) {
#pragma unroll
        for (int j = 0; j < NTASK; ++j) { const int q = tid + NTHREADS * j, h = q / (4 * N2), r = q % (4 * N2);
            xt_write(lds + LDS_XT + h * (64 * XSTR), r >> 3, r & 7, va[j], vb[j]); }
        if (item + G < item_end) P2_LOAD(item + G);
        LBAR();
        {
            f32x4 Pa[4], Qa[4]; const int quad = lane >> 4;
#pragma unroll
            for (int hh = 0; hh < (LOG2N == 7 ? 2 : 1); ++hh) {
                const int h = (LOG2N == 7) ? hh : (wave >> 2), kt = (LOG2N == 7) ? wave : (wave & 3);
                dft_mfma(lds + LDS_XT + h * (64 * XSTR), LOG2N, Br, Bi, Pa, Qa, lane);
                LAS f32x2* Rr = R + (h * N2 + 16 * kt + (lane & 15)) * RSTR + 2 * quad;
#pragma unroll
                for (int it = 0; it < 4; ++it)
                    *(LAS f32x4*)(Rr + 8 * it) = (f32x4){Pa[it][0] - Qa[it][1], Pa[it][1] + Qa[it][0], Pa[it][2] - Qa[it][3], Pa[it][3] + Qa[it][2]};
            }
        }
        LBAR();
        int bs, g, k1a, k1b, ip; p2_decode(item, bs, g, k1a, k1b, ip);
        const int tb = seq_base(bs);
        for (int idx = tid; idx < 2 * N2 * 32; idx += NTHREADS) {
            const int c = idx & 31, tl = idx >> 5, h = tl >> LOG2N, k2 = tl & (N2 - 1);
            const int ph = (ip == 0) ? h : 1 - h;
            const int k2p = (ip == 0 && h == 0) ? ((N2 - k2) & (N2 - 1)) : (N2 - 1 - k2);
            const f32x2 own = R[(h * N2 + k2) * RSTR + c], par = R[(ph * N2 + k2p) * RSTR + c];
            float v1 = (c == 0) ? 0.5f * (own.x + par.x) : own.x, v2 = (c == 0) ? 0.5f * (own.y + par.y) : par.x;
            v1 *= sc; v2 *= sc;
            float ss = v1 * v1 + v2 * v2;
            ss = xadd16(xadd8(xadd4(xadd2(xadd1(ss)))));
            const float rs = rsqrtf(ss * (1.f / 64.f) + EPS);
            Ost[tl * 64 + c] = (bf16_t)(cvt_pk_bf16(v1 * rs, 0.f) & 0xffffu);
            Ost[tl * 64 + (c == 0 ? 32 : 64 - c)] = (bf16_t)(cvt_pk_bf16(v2 * rs, 0.f) & 0xffffu);
        }
        LBAR();
        for (int idx = tid; idx < 2 * N2 * 8; idx += NTHREADS) {
            const int tl = idx >> 3, ch = idx & 7, h = tl >> LOG2N, k2 = tl & (N2 - 1);
            const int tok = tb + (h ? k1b : k1a) + 128 * k2;
            *(u32x4*)(Hm + (size_t)tok * D + 512 + g * 64 + ch * 8) = ((const LAS u32x4*)Ost)[idx];
        }
    }
    LBAR();
#undef P2_LOAD
}

__device__ __forceinline__ void fft_pass2s(const bf16_t* inter, bf16_t* Hm, LAS unsigned char* lds, int item0, int item_end, int G, int tid) {
    constexpr int N2 = 64, XS6 = 144, S = SS;
    const int lane = tid & 63, wave = __builtin_amdgcn_readfirstlane(tid >> 6);
    bf16x8 Br[4], Bi[4]; dft_frags(Br, Bi, 6, wave & 3, lane);
    u32x4 va[2], vb[2];
#define P2S_K1(ip_, hl_) ((hl_) == 0 ? (ip_) : ((ip_) == 0 ? 64 : 128 - (ip_)))
#define P2S_LOAD(item_) do { const int bs_ = BP + ((item_) >> 8), r_ = (item_) & 255, g_ = r_ >> 5, jp_ = r_ & 31; \
        const bf16_t* ib_ = inter + ((size_t)seq_base(bs_) * 8 + (size_t)g_ * S) * 64; \
        _Pragma("unroll") for (int j = 0; j < 2; ++j) { const int q = tid + NTHREADS * j, h = q >> 8, r = q & 255, rp = r >> 3, ch = r & 7, ip_ = 2 * jp_ + (h >> 1); \
            const bf16_t* src = ib_ + ((size_t)(P2S_K1(ip_, h & 1) * N2 + 2 * rp)) * 64 + ch * 8; va[j] = *(const u32x4*)src; vb[j] = *(const u32x4*)(src + 64); } } while (0)
    if (item0 < item_end) P2S_LOAD(item0);
    LAS f32x2* R = (LAS f32x2*)(lds + LDS_R);
    LAS bf16_t* Ost = (LAS bf16_t*)(lds + LDS_OST);
    const float sc = rsqrtf((float)S);
    for (int item = item0; item < item_end; item += G) {
#pragma unroll
        for (int j = 0; j < 2; ++j) { const int q = tid + NTHREADS * j, h = q >> 8, r = q & 255;
            xt_write<XS6>(lds + LDS_XT + h * (64 * XS6), r >> 3, r & 7, va[j], vb[j]); }
        if (item + G < item_end) P2S_LOAD(item + G);
        LBAR();
        {
            f32x4 Pa[4], Qa[4]; const int quad = lane >> 4, kt = wave & 3;
#pragma unroll
            for (int hh = 0; hh < 2; ++hh) { const int h = (wave >> 2) + 2 * hh;
                dft_mfma<XS6>(lds + LDS_XT + h * (64 * XS6), 6, Br, Bi, Pa, Qa, lane);
                LAS f32x2* Rr = R + (h * N2 + 16 * kt + (lane & 15)) * RSTR + 2 * quad;
#pragma unroll
                for (int it = 0; it < 4; ++it)
                    *(LAS f32x4*)(Rr + 8 * it) = (f32x4){Pa[it][0] - Qa[it][1], Pa[it][1] + Qa[it][0], Pa[it][2] - Qa[it][3], Pa[it][3] + Qa[it][2]};
            }
        }
        LBAR();
        const int bs = BP + (item >> 8), rr = item & 255, g = rr >> 5, jp = rr & 31, tb = seq_base(bs);
        for (int idx = tid; idx < 4 * N2 * 32; idx += NTHREADS) {
            const int c = idx & 31, tl = idx >> 5, h = tl >> 6, k2 = tl & (N2 - 1), ip = 2 * jp + (h >> 1);
            const int ph = (ip == 0) ? h : (h ^ 1);
            const int k2p = (ip == 0 && (h & 1) == 0) ? ((N2 - k2) & (N2 - 1)) : (N2 - 1 - k2);
            const f32x2 own = R[(h * N2 + k2) * RSTR + c], par = R[(ph * N2 + k2p) * RSTR + c];
            float v1 = (c == 0) ? 0.5f * (own.x + par.x) : own.x, v2 = (c == 0) ? 0.5f * (own.y + par.y) : par.x;
            v1 *= sc; v2 *= sc;
            float ss = v1 * v1 + v2 * v2;
            ss = xadd16(xadd8(xadd4(xadd2(xadd1(ss)))));
            const float rs = rsqrtf(ss * (1.f / 64.f) + EPS);
            Ost[tl * 64 + c] = (bf16_t)(cvt_pk_bf16(v1 * rs, 0.f) & 0xffffu);
            Ost[tl * 64 + (c == 0 ? 32 : 64 - c)] = (bf16_t)(cvt_pk_bf16(v2 * rs, 0.f) & 0xffffu);
        }
        LBAR();
        for (int idx = tid; idx < 4 * N2 * 8; idx += NTHREADS) {
            const int tl = idx >> 3, ch = idx & 7, h = tl >> 6, k2 = tl & (N2 - 1), ip = 2 * jp + (h >> 1);
            const int tok = tb + P2S_K1(ip, h & 1) + 128 * k2;
            *(u32x4*)(Hm + (size_t)tok * D + 512 + g * 64 + ch * 8) = ((const LAS u32x4*)Ost)[idx];
        }
    }
    LBAR();
#undef P2S_LOAD
#undef P2S_K1
}

#define XB_TMO      128
#define XB_XCNT(j)  (256  + 64 * (j))
#define XB_XSUB(j)  (1280 + 64 * (j))
#define XB_XGEN(j)  (2304 + 64 * (j))
#define XB_TOP      3328
#define XB_TOPGEN   3392
#define XCD_BAR_WORDS 3456
#define XB_SPIN_CAP (1u << 20)
__device__ __forceinline__ unsigned xb_ld(unsigned* p)              { return __hip_atomic_load(p, __ATOMIC_RELAXED, __HIP_MEMORY_SCOPE_AGENT); }
__device__ __forceinline__ unsigned xb_add(unsigned* p, unsigned v) { return __hip_atomic_fetch_add(p, v, __ATOMIC_RELAXED, __HIP_MEMORY_SCOPE_AGENT); }
__device__ __forceinline__ unsigned xb_xcc_id() { return (unsigned)__builtin_amdgcn_s_getreg((3 << 11) | 20) & 0xFu; }
#define XB_SPIN(cond, bar) do { unsigned _sp = 0; while (cond) { __builtin_amdgcn_s_sleep(1); \
    if ((++_sp & 255u) == 0u) { if (xb_ld(&(bar)[XB_TMO])) break; if (_sp > XB_SPIN_CAP) { atomicAdd(&(bar)[XB_TMO], 1u); break; } } } } while (0)
struct XcdBarrier { unsigned* bar; unsigned x; volatile LAS unsigned* st; };
__device__ __forceinline__ XcdBarrier xcd_barrier_post(unsigned* bar, volatile LAS unsigned* st) {
    XcdBarrier b; b.bar = bar; b.x = xb_xcc_id(); b.st = st;
    if (threadIdx.x == 0) (void)xb_add(&bar[XB_XCNT(b.x)], 1u);
    return b;
}
__device__ __forceinline__ void xcd_barrier_complete(unsigned* bar, unsigned x, unsigned& nloc, unsigned& nx) {
    const unsigned G = gridDim.x * gridDim.y * gridDim.z;
    unsigned sum, cnt, mine, sp = 0u;
    for (;;) {
        sum = 0u; cnt = 0u; mine = 0u;
#pragma unroll
        for (unsigned j = 0; j < 16; ++j) { const unsigned c = xb_ld(&bar[XB_XCNT(j)]); sum += c; cnt += (c > 0u) ? 1u : 0u; mine = (j == x) ? c : mine; }
        if (sum == G) break;
        __builtin_amdgcn_s_sleep(1);
        if ((++sp & 255u) == 0u) { if (xb_ld(&bar[XB_TMO])) break; if (sp > XB_SPIN_CAP) { atomicAdd(&bar[XB_TMO], 1u); break; } }
    }
    nloc = mine > 0u ? mine : 1u; nx = cnt > 0u ? cnt : 1u;
}
__device__ __forceinline__ void xcd_barrier(const XcdBarrier& b) {
    asm volatile("s_waitcnt vmcnt(0)" ::: "memory");
    __syncthreads();
    if (threadIdx.x == 0) {
        unsigned* bar = b.bar;
        __builtin_amdgcn_s_waitcnt(0);
        unsigned nloc = b.st[0], nx = b.st[1];
        if (nloc == 0u) { xcd_barrier_complete(bar, b.x, nloc, nx); b.st[0] = nloc; b.st[1] = nx; }
        const unsigned old = xb_add(&bar[XB_XSUB(b.x)], 1u);
        const unsigned gen = old / nloc;
        if (old + 1u == (gen + 1u) * nloc) {
            __builtin_amdgcn_fence(__ATOMIC_RELEASE, "agent");
            asm volatile("s_waitcnt vmcnt(0)" ::: "memory");
            const unsigned og = xb_add(&bar[XB_TOP], 1u);
            const unsigned tg = og / nx;
            if (og + 1u == (tg + 1u) * nx) xb_add(&bar[XB_TOPGEN], 1u);
            else XB_SPIN(xb_ld(&bar[XB_TOPGEN]) == tg, bar);
            __builtin_amdgcn_fence(__ATOMIC_ACQUIRE, "agent");
            xb_add(&bar[XB_XGEN(b.x)], 1u);
            asm volatile("s_waitcnt vmcnt(0)" ::: "memory");
        } else {
            XB_SPIN(xb_ld(&bar[XB_XGEN(b.x)]) == gen, bar);
            __builtin_amdgcn_fence(__ATOMIC_ACQUIRE, "agent");
            asm volatile("s_waitcnt vmcnt(0)" ::: "memory");
        }
    }
    __syncthreads();
}

__global__ void __launch_bounds__(NTHREADS, 2) fwd_megakernel(Params P) {
    extern __shared__ __attribute__((aligned(16))) unsigned char shm[];
    cg::grid_group grid = cg::this_grid();
    LAS unsigned char* lds = (LAS unsigned char*)shm;
    const int G = gridDim.x, bid = blockIdx.x, NGW = G * NWAVES;
#define FRESH() int tid = threadIdx.x; asm volatile("" : "+v"(tid)); const int lane = tid & 63, wave = __builtin_amdgcn_readfirstlane(tid >> 6), gw = bid * NWAVES + wave; (void)lane; (void)gw
#define TAB ((LAS float*)(lds + LDS_MISC))
    { FRESH();
      if (tid < 64) TAB[tid] = cospif((float)tid * (1.f / 32.f));
      if (tid < 4) ((volatile LAS unsigned*)(lds + LDS_MISC + 1024))[tid] = 0u; }
    __syncthreads();
    const XcdBarrier xbar = xcd_barrier_post((unsigned*)P.ws, (volatile LAS unsigned*)(lds + LDS_MISC + 1024));
#define GSYNC() xcd_barrier(xbar)

    unsigned char* ws = P.ws;
#define Xb ((bf16_t*)(ws + WS_X))
#define Hb ((bf16_t*)(ws + WS_H))
#define Pb ((bf16_t*)P.out)
#define Ib ((bf16_t*)(ws + WS_INTER))
#define MFb ((bf16_t*)(ws + WS_MF))
#define A0b ((bf16_t*)(ws + WS_H))
#define A1b ((bf16_t*)P.out)
#define RSb ((float*)(ws + WS_RS))

    {
        FRESH();
        LAS float* scr = (LAS float*)(lds + wave * 8704);
        constexpr int I_IN = 16 * 48, I_OUT = 16 * 32, I_UP = 16 * 128, I_DN = 64 * 32, I_F = 128, I_L = I_IN + I_OUT + I_UP + I_DN + I_F;
        for (int it = gw; it < NL * I_L; it += NGW) {
            const int l = it / I_L; int r = it % I_L;
            bf16_t* Wl = (bf16_t*)(ws + WS_W + (size_t)l * WL_SZ);
            const float* win = P.w_in + (size_t)l * D * DIN;
            if (r < I_IN) { p0_transpose_item<true>(win, D, DIN, 48, Wl + WL_IN / 2, P.g_mix_pre + l * D, scr, r, lane); continue; } r -= I_IN;
            if (r < I_OUT) {
                const int kb = r / 32; const float* gsrc = kb < 8 ? P.g_conv_out + l * 512 : P.g_fourier_out + l * 512 - 512;
                p0_transpose_item(P.w_out + (size_t)l * D * D, D, D, 32, Wl + WL_OUT / 2, gsrc, scr, r, lane); continue; } r -= I_OUT;
            if (r < I_UP) { p0_transpose_item(P.w_up + (size_t)l * D * DFF, D, DFF, 128, Wl + WL_UP / 2, P.g_mlp_pre + l * D, scr, r, lane); continue; } r -= I_UP;
            if (r < I_DN) { p0_transpose_item(P.w_down + (size_t)l * DFF * D, DFF, D, 32, Wl + WL_DN / 2, nullptr, scr, r, lane); continue; } r -= I_DN;
            p0_fold_item(win, P.g_mix_pre + l * D, Wl + WL_IN / 2, TAB, r, lane);
        }
        for (int t = gw * 4; t < T; t += NGW * 4) x_rows_init<4>(t < TP ? P.xp + (size_t)t * D : P.xs + (size_t)(t - TP) * D, Xb + (size_t)t * D, RSb + t, lane);
    }
    grid.sync();

    for (int l = 0; l < NL; ++l) {
        const bf16_t* Wl = (const bf16_t*)(ws + WS_W + (size_t)l * WL_SZ);
        { pg8::Gemm g{Xb, Wl + WL_IN / 2, T, DIN, D, nullptr, 1 << 20}; pg8::StaticOrder S; S.init(T, DIN, G, bid); pg8::EpiInProj E{Pb, RSb};
          pg8::gemm_phase(lds, g, S, E); }
        GSYNC();
        {
            FRESH();
            constexpr int NCONV = T / 128;
            for (int it = bid; it < NCONV; it += G) { const int t0 = it * 128 + wave * 16; const int S = t0 < TP ? SP : SS; const int pos0 = t0 < TP ? (t0 & (SP - 1)) : ((t0 - TP) & (SS - 1));
                conv_wave_item(Pb, P.conv_w + (size_t)l * 3 * 512, Hb, t0, pos0, S, lane); }
            fft_pass1(Pb, Ib, lds, bid, G, tid);
        }
        GSYNC();
        { FRESH(); fft_pass2<7>(Ib, Hb, lds, bid, 1024, G, tid); }
        { FRESH(); fft_pass2s(Ib, Hb, lds, bid, 2048, G, tid); }
        GSYNC();
        { pg8::Gemm g{Hb, Wl + WL_OUT / 2, T, D, D, nullptr, 1 << 20}; pg8::StaticOrder S; S.init(T, D, G, bid); pg8::EpiBf16 E{MFb, D, 0, nullptr, nullptr, 1 << 20};
          pg8::gemm_phase(lds, g, S, E); }
        GSYNC();
        { FRESH();
          for (int t = gw * 8; t < T; t += NGW * 8) row_pass_rows<8>(Xb, MFb, P.g_mix_post + l * D, RSb, nullptr, false, t, lane); }
        GSYNC();
        { pg8::Gemm g{Xb, Wl + WL_UP / 2, T, DFF, D, nullptr, 1 << 20}; pg8::StaticOrder S; S.init(T, DFF, G, bid); pg8::EpiBf16 E{A0b, DFF, 1, nullptr, A1b, TCH / 256};
          pg8::gemm_phase(lds, g, S, E); }
        GSYNC();
        { pg8::Gemm g{A0b, Wl + WL_DN / 2, T, D, DFF, A1b, TCH / 256}; pg8::StaticOrder S; S.init(T, D, G, bid); pg8::EpiBf16 E{MFb, D, 0, nullptr, nullptr, 1 << 20};
          pg8::gemm_phase(lds, g, S, E); }
        GSYNC();
        { FRESH();
          float* outf = (l + 1 < NL) ? nullptr : P.out;
          for (int t = gw * 8; t < T; t += NGW * 8) row_pass_rows<8>(Xb, MFb, P.g_mlp_post + l * D, RSb, outf, true, t, lane); }
        if (l + 1 < NL) GSYNC();
    }
}

extern "C" void kernel_launch(void* const* d_in, const int* in_sizes, int n_in, void* d_out, int out_size, void* d_ws, size_t ws_size, hipStream_t stream) {
    static int grid_blocks = 0;
    if (grid_blocks == 0) {
        if (n_in != 13 || out_size != T * D || ws_size < WS_END) { fprintf(stderr, "kernel_launch: unexpected shapes (n_in %d, out %d, ws %zu, need %zu)\n", n_in, out_size, ws_size, (size_t)WS_END); grid_blocks = -1; return; }
        int dev = 0, cus = 0, per_cu = 0;
        hipGetDevice(&dev);
        hipDeviceGetAttribute(&cus, hipDeviceAttributeMultiprocessorCount, dev);
        if (hipFuncSetAttribute((const void*)fwd_megakernel, hipFuncAttributeMaxDynamicSharedMemorySize, LDS_BYTES) != hipSuccess) { fprintf(stderr, "kernel_launch: hipFuncSetAttribute failed\n"); grid_blocks = -1; return; }
        hipOccupancyMaxActiveBlocksPerMultiprocessor(&per_cu, (const void*)fwd_megakernel, NTHREADS, LDS_BYTES);
        if (per_cu < 1) { fprintf(stderr, "kernel_launch: occupancy query says %d blocks per CU\n", per_cu); per_cu = 1; }
        grid_blocks = cus * per_cu;
    }
    if (grid_blocks < 0) return;
    Params p{};
    p.xp = (const float*)d_in[0]; p.xs = (const float*)d_in[1]; p.g_mix_pre = (const float*)d_in[2]; p.w_in = (const float*)d_in[3]; p.conv_w = (const float*)d_in[4];
    p.g_conv_out = (const float*)d_in[5]; p.g_fourier_out = (const float*)d_in[6]; p.w_out = (const float*)d_in[7]; p.g_mix_post = (const float*)d_in[8];
    p.g_mlp_pre = (const float*)d_in[9]; p.w_up = (const float*)d_in[10]; p.w_down = (const float*)d_in[11]; p.g_mlp_post = (const float*)d_in[12];
    p.out = (float*)d_out; p.ws = (unsigned char*)d_ws;
    if (hipMemsetAsync(d_ws, 0, 16384, stream) != hipSuccess) { fprintf(stderr, "kernel_launch: memset failed\n"); return; }
    void* args[] = {&p};
    hipError_t e = hipLaunchCooperativeKernel((const void*)fwd_megakernel, dim3(grid_blocks), dim3(NTHREADS), args, LDS_BYTES, stream);
    if (e != hipSuccess) fprintf(stderr, "cooperative launch failed: %s (grid %d)\n", hipGetErrorString(e), grid_blocks);
}
```

```cpp
#include <hip/hip_runtime.h>
#include <hip/hip_cooperative_groups.h>
#include <cstdio>
namespace cg = cooperative_groups;

#define LAS __attribute__((address_space(3)))
typedef unsigned short bf16_t;
typedef short bf16x8 __attribute__((ext_vector_type(8)));
typedef float f32x4 __attribute__((ext_vector_type(4)));
typedef float f32x2 __attribute__((ext_vector_type(2)));
typedef unsigned u32x4 __attribute__((ext_vector_type(4)));
typedef unsigned u32x2 __attribute__((ext_vector_type(2)));

constexpr int D = 1024, DIN = 2048, DFF = 4096, NL = 4;
constexpr int PLD = 1536;
constexpr int SP = 16384, BP = 2, SS = 8192, BS = 8;
constexpr int TP = BP * SP, TS = BS * SS, T = TP + TS;
constexpr float EPS = 1e-6f;
constexpr int NCH = 2;
constexpr int TCH = T / NCH;

constexpr size_t MiB = (size_t)1 << 20;
constexpr size_t WS_W = 1 * MiB;
constexpr size_t WL_IN = 0, WL_OUT = 4 * MiB, WL_UP = 6 * MiB, WL_DN = 14 * MiB, WL_SZ = 22 * MiB;
constexpr size_t WS_X = WS_W + NL * WL_SZ;
constexpr size_t WS_H = WS_X + (size_t)T * D * 2;
constexpr size_t WS_INTER = WS_H + (size_t)T * D * 2;
constexpr size_t WS_MF = WS_INTER + (size_t)T * 256 * 8;
constexpr size_t WS_RS = WS_MF + (size_t)T * D * 2;
constexpr size_t WS_END = WS_RS + 1 * MiB;

constexpr int LDS_STAGE = 131072, LDS_MISC = 139264, LDS_BYTES = LDS_MISC + 4096;
constexpr int NTHREADS = 512, NWAVES = 8;

struct Params {
    const float* xp; const float* xs; const float* g_mix_pre; const float* w_in; const float* conv_w;
    const float* g_conv_out; const float* g_fourier_out; const float* w_out; const float* g_mix_post;
    const float* g_mlp_pre; const float* w_up; const float* w_down; const float* g_mlp_post;
    float* out; unsigned char* ws;
};

__device__ __forceinline__ unsigned cvt_pk_bf16(float lo, float hi) { unsigned r; asm volatile("v_cvt_pk_bf16_f32 %0, %1, %2" : "=v"(r) : "v"(lo), "v"(hi)); return r; }
__device__ __forceinline__ float bf_lo(unsigned w) { return __uint_as_float(w << 16); }
__device__ __forceinline__ float bf_hi(unsigned w) { return __uint_as_float(w & 0xffff0000u); }
template <int CTRL> __device__ __forceinline__ float dpp_f(float x) { return __builtin_bit_cast(float, __builtin_amdgcn_update_dpp(0, __builtin_bit_cast(int, x), CTRL, 0xF, 0xF, true)); }
__device__ __forceinline__ float xadd1(float v) { return v + dpp_f<0xB1>(v); }
__device__ __forceinline__ float xadd2(float v) { return v + dpp_f<0x4E>(v); }
__device__ __forceinline__ float xadd4(float v) { return v + dpp_f<0x141>(v); }
__device__ __forceinline__ float xadd8(float v) { return v + dpp_f<0x140>(v); }
__device__ __forceinline__ float xadd16(float v) { float a = v, b = v; asm volatile("s_nop 1\n\tv_permlane16_swap_b32 %0, %1" : "+v"(a), "+v"(b)); return a + b; }
__device__ __forceinline__ float xadd32(float v) { float a = v, b = v; asm volatile("s_nop 1\n\tv_permlane32_swap_b32 %0, %1" : "+v"(a), "+v"(b)); return a + b; }
__device__ __forceinline__ float wave_sum(float v) { return xadd32(xadd16(xadd8(xadd4(xadd2(xadd1(v)))))); }
__device__ __forceinline__ void load8(const bf16_t* ptr, float (&v)[8]) {
    const u32x4 q = *(const u32x4*)ptr;
    v[0] = bf_lo(q.x); v[1] = bf_hi(q.x); v[2] = bf_lo(q.y); v[3] = bf_hi(q.y); v[4] = bf_lo(q.z); v[5] = bf_hi(q.z); v[6] = bf_lo(q.w); v[7] = bf_hi(q.w);
}

namespace pg8 {
constexpr int BM = 256, BK = 64, HALF = 128, HTB = HALF * BK * 2, STAGE_BYTES = 8 * HTB, NXCD = 8, WGM = 8;
__device__ __forceinline__ int lds_byte(int r, int c) { const int st = (r >> 4) * 2 + (c >> 5), rr = r & 15, cc = c & 31, ob = rr * 64 + cc * 2; return st * 1024 + (ob ^ (((ob >> 9) & 1) << 5)); }
__device__ __forceinline__ void stage_rc(int b, int& R, int& C) { const int st = b / 1024, sb = b % 1024, swz = sb ^ (((sb >> 9) & 1) << 5); R = (st >> 1) * 16 + swz / 64; C = (st & 1) * 32 + (swz % 64) / 2; }
__device__ __forceinline__ int perm32(int rho) { const int n = rho >> 4, i = rho & 15; return 8 * (i >> 2) + 4 * n + (i & 3); }

struct Unit { int pm, pn; };
struct Gemm { const bf16_t* A; const bf16_t* Bt; int M, N, K; const bf16_t* A2; int split; };

struct StaticOrder {
    int nM, nN, nwg, G, c;
    __device__ void init(int M, int N, int G_, int c_) { nM = M / BM; nN = N / BM; nwg = nM * nN; G = G_; c = c_; }
    __device__ bool next(int i, Unit& u) const {
        const long L = (long)i * G + c; if (L >= nwg) return false;
        int wgid = (int)L; { const int q = nwg / NXCD, r = nwg % NXCD, xcd = wgid % NXCD, off = wgid / NXCD; wgid = (xcd < r ? xcd * (q + 1) : r * (q + 1) + (xcd - r) * q) + off; }
        const int nig = WGM * nN, gid = wgid / nig, fm = gid * WGM, gsz = (nM - fm) < WGM ? (nM - fm) : WGM;
        u.pm = fm + ((wgid % nig) % gsz); u.pn = (wgid % nig) / gsz; return true;
    }
};

struct EpiBf16 {
    static constexpr bool FUSED = false;
    bf16_t* O; int ldc; int act; const float* rs; bf16_t* O2; int split;
    __device__ __forceinline__ void operator()(const f32x4 (&acc)[2][2][4][2], const Unit& u, int wr, int wc, int fr, int fq) const {
        const bool lo = u.pm < split; bf16_t* Ob = lo ? O : O2;
        const int grow0 = u.pm * BM + wr * 64 + fr, row0 = grow0 - (lo ? 0 : split * BM); const int col0 = u.pn * BM + wc * 32 + 8 * fq;
#pragma unroll
        for (int ai = 0; ai < 2; ++ai)
#pragma unroll
            for (int m = 0; m < 4; ++m) { bf16_t* rowp = Ob + (size_t)(row0 + ai * HALF + m * 16) * ldc + col0; const float sc = rs ? rs[grow0 + ai * HALF + m * 16] : 1.f;
#pragma unroll
                for (int bj = 0; bj < 2; ++bj) { f32x4 v0 = acc[ai][bj][m][0] * sc, v1 = acc[ai][bj][m][1] * sc;
                    if (act) {
#pragma unroll
                        for (int j = 0; j < 4; ++j) { float a0, a1; asm("v_max_f32 %0, 0, %1" : "=v"(a0) : "v"(v0[j])); asm("v_max_f32 %0, 0, %1" : "=v"(a1) : "v"(v1[j])); v0[j] = a0; v1[j] = a1; }
                        f32x2 p0 = (f32x2){v0[0], v0[1]}, p1 = (f32x2){v0[2], v0[3]}, p2 = (f32x2){v1[0], v1[1]}, p3 = (f32x2){v1[2], v1[3]};
                        p0 = p0 * p0; p1 = p1 * p1; p2 = p2 * p2; p3 = p3 * p3;
                        v0 = (f32x4){p0.x, p0.y, p1.x, p1.y}; v1 = (f32x4){p2.x, p2.y, p3.x, p3.y}; }
                    u32x4 w; w.x = cvt_pk_bf16(v0[0], v0[1]); w.y = cvt_pk_bf16(v0[2], v0[3]); w.z = cvt_pk_bf16(v1[0], v1[1]); w.w = cvt_pk_bf16(v1[2], v1[3]);
                    *(u32x4*)(rowp + bj * HALF) = w; } }
    }
};


struct EpiInProj {
    static constexpr bool FUSED = false;
    bf16_t* O; const float* rs;
    __device__ __forceinline__ void operator()(const f32x4 (&acc)[2][2][4][2], const Unit& u, int wr, int wc, int fr, int fq) const {
        const int row0 = u.pm * BM + wr * 64 + fr, sub = wc * 32 + 8 * fq;
        const bool isz = (u.pn >= 2 && u.pn < 6);
        const int cbase = isz ? 512 + (u.pn - 2) * 128 + sub : (u.pn < 2 ? u.pn * BM + sub : 1024 + (u.pn - 6) * BM + sub);
#pragma unroll
        for (int ai = 0; ai < 2; ++ai)
#pragma unroll
            for (int m = 0; m < 4; ++m) { const int row = row0 + ai * HALF + m * 16; bf16_t* rowp = O + (size_t)row * PLD + cbase; const float sc = rs[row];
                if (isz) { const float s2 = sc * sc; const f32x4 z0 = acc[ai][0][m][0] * acc[ai][1][m][0] * s2, z1 = acc[ai][0][m][1] * acc[ai][1][m][1] * s2;
                    u32x4 w; w.x = cvt_pk_bf16(z0[0], z0[1]); w.y = cvt_pk_bf16(z0[2], z0[3]); w.z = cvt_pk_bf16(z1[0], z1[1]); w.w = cvt_pk_bf16(z1[2], z1[3]);
                    *(u32x4*)rowp = w; }
                else {
#pragma unroll
                    for (int bj = 0; bj < 2; ++bj) { const f32x4 v0 = acc[ai][bj][m][0] * sc, v1 = acc[ai][bj][m][1] * sc;
                        u32x4 w; w.x = cvt_pk_bf16(v0[0], v0[1]); w.y = cvt_pk_bf16(v0[2], v0[3]); w.z = cvt_pk_bf16(v1[0], v1[1]); w.w = cvt_pk_bf16(v1[2], v1[3]);
                        *(u32x4*)(rowp + bj * HALF) = w; } } }
    }
};

template <class Epi, class Sched>
__device__ __forceinline__ void gemm_phase(LAS unsigned char* lds, const Gemm g, const Sched& S, const Epi& E) {
    int tid_ = threadIdx.x; asm volatile("" : "+v"(tid_));
    const int tid = tid_, wid = __builtin_amdgcn_readfirstlane(tid >> 6), lane = tid & 63, wr = wid >> 2, wc = wid & 3, fr = lane & 15, fq = lane >> 4;
    const int K = g.K, nt = K / BK;
    unsigned voffA[2], voffB[2];
#pragma unroll
    for (int i = 0; i < 2; ++i) { int R, C; stage_rc(tid * 16 + i * 8192, R, C); const int Rb = (R & ~31) + perm32(R & 31);
        voffA[i] = (unsigned)(R * K + C) * 2u; voffB[i] = (unsigned)(Rb * K + C) * 2u; }
    const size_t kstep = (size_t)(BK * 2);
    const size_t hstep = (size_t)HALF * K * 2;
    const size_t tstep = 2 * hstep;
    const unsigned ldsw = (unsigned)wid * 1024u;
    const int aoff = lds_byte(wr * 64 + fr, fq * 8), boff = lds_byte(wc * 32 + fr, fq * 8);
#define PG8_SA(b, h) (((b) * 2 + (h)) * HTB)
#define PG8_SB(b, h) ((4 + (b) * 2 + (h)) * HTB)
#define PG8_STAGE(bufoff, gbase, voff) do { _Pragma("unroll") for (int _i = 0; _i < 2; ++_i) \
        __builtin_amdgcn_global_load_lds((const unsigned*)((const char*)(gbase) + (voff)[_i]), (LAS unsigned*)(lds + (bufoff) + ldsw + _i * 8192), 16, 0, 0); } while (0)
#define PG8_LDA(dst, b, h) do { _Pragma("unroll") for (int m = 0; m < 4; ++m) _Pragma("unroll") for (int k = 0; k < 2; ++k) dst[m][k] = *(const LAS bf16x8*)(lds + PG8_SA(b, h) + aoff + m * 2048 + k * 1024); } while (0)
#define PG8_LDB(dst, b, h) do { _Pragma("unroll") for (int n = 0; n < 2; ++n) _Pragma("unroll") for (int k = 0; k < 2; ++k) dst[n][k] = *(const LAS bf16x8*)(lds + PG8_SB(b, h) + boff + n * 2048 + k * 1024); } while (0)
#define PG8_MMA(ai, bj, At, Bt) do { __builtin_amdgcn_s_setprio(1); _Pragma("unroll") for (int m = 0; m < 4; ++m) _Pragma("unroll") for (int n = 0; n < 2; ++n) _Pragma("unroll") for (int k = 0; k < 2; ++k) \
        acc[ai][bj][m][n] = __builtin_amdgcn_mfma_f32_16x16x32_bf16(Bt[n][k], At[m][k], acc[ai][bj][m][n], 0, 0, 0); __builtin_amdgcn_s_setprio(0); } while (0)
#define PG8_WAIT_V(n) asm volatile("s_waitcnt vmcnt(" #n ")" ::: "memory")
#define PG8_WAIT_L(n) asm volatile("s_waitcnt lgkmcnt(" #n ")" ::: "memory")
#define PG8_BAR __builtin_amdgcn_s_barrier()
#define PG8_SCHED __builtin_amdgcn_sched_barrier(0)
    Unit cur, nxt; int ui = 0;
    if (!S.next(0, cur)) return;
    f32x4 acc[2][2][4][2];
#pragma unroll
    for (int a = 0; a < 2; ++a)
#pragma unroll
        for (int b = 0; b < 2; ++b)
#pragma unroll
            for (int m = 0; m < 4; ++m)
#pragma unroll
                for (int n = 0; n < 2; ++n) acc[a][b][m][n] = (f32x4){0.f, 0.f, 0.f, 0.f};
    bf16x8 At[4][2], B0[2][2], B1[2][2];
#define PG8_APANEL(pm_) ((const char*)(((pm_) < g.split ? (unsigned long long)g.A : (unsigned long long)g.A2 - (unsigned long long)g.split * tstep) + (unsigned long long)(pm_) * tstep))
    const char* cA = PG8_APANEL(cur.pm); const char* cB = (const char*)g.Bt + (size_t)cur.pn * tstep;
    PG8_STAGE(PG8_SB(0, 0), cB, voffB); PG8_STAGE(PG8_SA(0, 0), cA, voffA); PG8_STAGE(PG8_SB(0, 1), cB + hstep, voffB); PG8_STAGE(PG8_SA(0, 1), cA + hstep, voffA);
    if (wr == 1) PG8_BAR;
    PG8_WAIT_V(4); PG8_BAR;
    PG8_STAGE(PG8_SB(1, 0), cB + kstep, voffB); PG8_STAGE(PG8_SA(1, 0), cA + kstep, voffA); PG8_STAGE(PG8_SB(1, 1), cB + hstep + kstep, voffB);
    PG8_WAIT_V(6); PG8_BAR;
    for (;;) {
        const bool has_next = S.next(ui + 1, nxt);
        const char* nA = has_next ? PG8_APANEL(nxt.pm) : cA; const char* nB = has_next ? (const char*)g.Bt + (size_t)nxt.pn * tstep : cB;
        for (int t = 0; t < nt; t += 2) {
            const bool last = (t == nt - 2);
            const char* a1 = cA + (size_t)(t + 1) * kstep;
            const char* a2 = last ? nA : cA + (size_t)(t + 2) * kstep; const char* b2 = last ? nB : cB + (size_t)(t + 2) * kstep;
            const char* a3 = a2 + kstep; const char* b3 = b2 + kstep;
            PG8_LDB(B0, 0, 0); PG8_SCHED; PG8_LDA(At, 0, 0); PG8_STAGE(PG8_SA(1, 1), a1 + hstep, voffA);
            PG8_WAIT_L(8); PG8_BAR; PG8_WAIT_L(0); PG8_MMA(0, 0, At, B0); PG8_BAR; PG8_SCHED;
            PG8_LDB(B1, 0, 1); PG8_STAGE(PG8_SB(0, 0), b2, voffB);
            PG8_BAR; PG8_WAIT_L(0); PG8_MMA(0, 1, At, B1); PG8_BAR;
            PG8_LDA(At, 0, 1); PG8_STAGE(PG8_SA(0, 0), a2, voffA);
            PG8_BAR; PG8_WAIT_L(0); PG8_MMA(1, 0, At, B0); PG8_BAR; PG8_SCHED;
            PG8_STAGE(PG8_SB(0, 1), b2 + hstep, voffB);
            PG8_WAIT_V(6); PG8_BAR; PG8_MMA(1, 1, At, B1); PG8_BAR;
            PG8_LDB(B0, 1, 0); PG8_SCHED; PG8_LDA(At, 1, 0); PG8_STAGE(PG8_SA(0, 1), a2 + hstep, voffA);
            PG8_WAIT_L(8); PG8_BAR; PG8_WAIT_L(0); PG8_MMA(0, 0, At, B0); PG8_BAR; PG8_SCHED;
            PG8_LDB(B1, 1, 1); PG8_STAGE(PG8_SB(1, 0), b3, voffB);
            PG8_BAR; PG8_WAIT_L(0); PG8_MMA(0, 1, At, B1); PG8_BAR;
            PG8_LDA(At, 1, 1); PG8_STAGE(PG8_SA(1, 0), a3, voffA);
            PG8_BAR; PG8_WAIT_L(0); PG8_MMA(1, 0, At, B0); PG8_BAR; PG8_SCHED;
            PG8_STAGE(PG8_SB(1, 1), b3 + hstep, voffB);
            PG8_WAIT_V(6); PG8_BAR; PG8_MMA(1, 1, At, B1); PG8_BAR;
        }
        if (wr == 0) PG8_BAR;
        E(acc, cur, wr, wc, fr, fq);
        if (wr == 1) PG8_BAR;
        if (!has_next) break;
#pragma unroll
        for (int a = 0; a < 2; ++a)
#pragma unroll
            for (int b = 0; b < 2; ++b)
#pragma unroll
                for (int m = 0; m < 4; ++m)
#pragma unroll
                    for (int n = 0; n < 2; ++n) acc[a][b][m][n] = (f32x4){0.f, 0.f, 0.f, 0.f};
        cur = nxt; cA = nA; cB = nB; ++ui;
    }
    PG8_WAIT_V(0);
    if (wr == 0) PG8_BAR;
    PG8_BAR;
#undef PG8_APANEL
#undef PG8_SA
#undef PG8_SB
#undef PG8_STAGE
#undef PG8_LDA
#undef PG8_LDB
#undef PG8_MMA
#undef PG8_WAIT_V
#undef PG8_WAIT_L
#undef PG8_BAR
#undef PG8_SCHED
}
}

template <bool INPROJ = false>
__device__ __forceinline__ void p0_transpose_item(const float* W, int K, int ldN, int nblk, bf16_t* WT, const float* gain, LAS float* scr, int item, int lane) {
    const int kb = item / nblk, nb = item % nblk, k0 = 64 * kb, n0 = 32 * nb;
    const int dn0 = !INPROJ || n0 < 512 ? n0 : (n0 < 1024 ? 512 + ((n0 - 512) >> 7) * 256 + ((n0 - 512) & 127) : 512 + ((n0 - 1024) >> 7) * 256 + 128 + ((n0 - 1024) & 127));
    float wv[32];
#pragma unroll
    for (int i = 0; i < 32; ++i) wv[i] = W[(size_t)(k0 + 2 * i + (lane >> 5)) * ldN + n0 + (lane & 31)];
#pragma unroll
    for (int i = 0; i < 32; ++i) { const int kk = 2 * i + (lane >> 5); const float gk = gain ? gain[k0 + kk] : 1.f;
        scr[kk * 33 + (lane & 31)] = wv[i] * gk; }
    asm volatile("s_waitcnt lgkmcnt(0)" ::: "memory");
    const int c = lane & 7;
#pragma unroll
    for (int j = 0; j < 4; ++j) { const int n = (lane >> 3) + 8 * j; const LAS float* s = scr + (8 * c) * 33 + n;
        u32x4 o; o.x = cvt_pk_bf16(s[0 * 33], s[1 * 33]); o.y = cvt_pk_bf16(s[2 * 33], s[3 * 33]); o.z = cvt_pk_bf16(s[4 * 33], s[5 * 33]); o.w = cvt_pk_bf16(s[6 * 33], s[7 * 33]);
        *(u32x4*)(WT + (size_t)(dn0 + n) * K + k0 + 8 * c) = o; }
    asm volatile("s_waitcnt lgkmcnt(0)" ::: "memory");
}
__device__ __forceinline__ void p0_fold_item(const float* Win  , const float* gpre, bf16_t* WT  , const LAS float* tab, int item, int lane) {
    const int kb = item >> 3, g = item & 7, k = kb * 64 + lane;
    const float gk = gpre[k] * 0.125f;
    const f32x4* src = (const f32x4*)(Win + (size_t)k * DIN + 1536 + g * 64);
    float row[64];
#pragma unroll
    for (int i = 0; i < 16; ++i) { const f32x4 v = src[i]; row[4 * i] = v.x * gk; row[4 * i + 1] = v.y * gk; row[4 * i + 2] = v.z * gk; row[4 * i + 3] = v.w * gk; }
    for (int j = 0; j < 64; ++j) {
        const int cj = (j == 0) ? 0 : (j == 1 ? 32 : (j >> 1)), off = (j >= 2 && (j & 1)) ? 16 : 0;
        float acc = 0.f;
#pragma unroll
        for (int d = 0; d < 64; ++d) acc += row[d] * tab[(cj * d + off) & 63];
        WT[(size_t)(1536 + g * 64 + j) * D + k] = (bf16_t)(cvt_pk_bf16(acc, 0.f) & 0xffffu);
    }
}
template <int NR>
__device__ __forceinline__ void x_rows_init(const float* xrow0, bf16_t* orow0, float* rs, int lane) {
    f32x4 v[NR][4];
#pragma unroll
    for (int r = 0; r < NR; ++r) { const f32x4* xr = (const f32x4*)(xrow0 + (size_t)r * D) + lane;
#pragma unroll
        for (int j = 0; j < 4; ++j) v[r][j] = xr[64 * j]; }
#pragma unroll
    for (int r = 0; r < NR; ++r) { float s = 0.f;
#pragma unroll
        for (int j = 0; j < 4; ++j) s += (v[r][j].x * v[r][j].x + v[r][j].y * v[r][j].y) + (v[r][j].z * v[r][j].z + v[r][j].w * v[r][j].w);
        const float rstd = rsqrtf(wave_sum(s) * (1.f / D) + EPS);
        u32x2* o8 = (u32x2*)(orow0 + (size_t)r * D) + lane;
#pragma unroll
        for (int j = 0; j < 4; ++j) { u32x2 w; w.x = cvt_pk_bf16(v[r][j].x, v[r][j].y); w.y = cvt_pk_bf16(v[r][j].z, v[r][j].w); o8[64 * j] = w; }
        if (lane == 0) rs[r] = rstd; }
}

template <int NR>
__device__ __forceinline__ void row_pass_rows(bf16_t* X, const bf16_t* MF, const float* gain, float* rs, float* outf, bool unscaled, int t0, int lane) {
    u32x4 xa[NR][2], ma[NR][2];
#pragma unroll
    for (int r = 0; r < NR; ++r) { const u32x4* xr = (const u32x4*)(X + (size_t)(t0 + r) * D); const u32x4* mr = (const u32x4*)(MF + (size_t)(t0 + r) * D);
        xa[r][0] = xr[lane]; xa[r][1] = xr[64 + lane]; ma[r][0] = mr[lane]; ma[r][1] = mr[64 + lane]; }
    float g[16];
    { const f32x4* g0 = (const f32x4*)(gain + lane * 8); const f32x4* g1 = (const f32x4*)(gain + 512 + lane * 8);
#pragma unroll
      for (int h = 0; h < 2; ++h) { const f32x4 a = g0[h], b = g1[h];
#pragma unroll
        for (int k = 0; k < 4; ++k) { g[4 * h + k] = a[k]; g[8 + 4 * h + k] = b[k]; } } }
#pragma unroll
    for (int r = 0; r < NR; ++r) {
        float x[16], m[16];
#pragma unroll
        for (int h = 0; h < 2; ++h) { const u32x4 xq = xa[r][h], mq = ma[r][h];
            x[8 * h + 0] = bf_lo(xq.x); x[8 * h + 1] = bf_hi(xq.x); x[8 * h + 2] = bf_lo(xq.y); x[8 * h + 3] = bf_hi(xq.y); x[8 * h + 4] = bf_lo(xq.z); x[8 * h + 5] = bf_hi(xq.z); x[8 * h + 6] = bf_lo(xq.w); x[8 * h + 7] = bf_hi(xq.w);
            m[8 * h + 0] = bf_lo(mq.x); m[8 * h + 1] = bf_hi(mq.x); m[8 * h + 2] = bf_lo(mq.y); m[8 * h + 3] = bf_hi(mq.y); m[8 * h + 4] = bf_lo(mq.z); m[8 * h + 5] = bf_hi(mq.z); m[8 * h + 6] = bf_lo(mq.w); m[8 * h + 7] = bf_hi(mq.w); }
        float sm = 0.f;
#pragma unroll
        for (int k = 0; k < 16; ++k) sm += m[k] * m[k];
        float eps_eff = EPS; if (unscaled) { const float rr = rs[t0 + r], r2 = rr * rr; eps_eff = EPS / (r2 * r2); }
        const float rm = rsqrtf(wave_sum(sm) * (1.f / D) + eps_eff);
        float s1 = 0.f;
#pragma unroll
        for (int k = 0; k < 16; ++k) { x[k] = x[k] + m[k] * rm * g[k]; s1 += x[k] * x[k]; }
        if (outf) {
            f32x4* o = (f32x4*)(outf + (size_t)(t0 + r) * D);
            o[lane * 2] = (f32x4){x[0], x[1], x[2], x[3]}; o[lane * 2 + 1] = (f32x4){x[4], x[5], x[6], x[7]};
            o[128 + lane * 2] = (f32x4){x[8], x[9], x[10], x[11]}; o[128 + lane * 2 + 1] = (f32x4){x[12], x[13], x[14], x[15]};
        } else {
            const float r1 = rsqrtf(wave_sum(s1) * (1.f / D) + EPS);
            u32x4* xo = (u32x4*)(X + (size_t)(t0 + r) * D);
            u32x4 w0, w1;
            w0.x = cvt_pk_bf16(x[0], x[1]); w0.y = cvt_pk_bf16(x[2], x[3]); w0.z = cvt_pk_bf16(x[4], x[5]); w0.w = cvt_pk_bf16(x[6], x[7]);
            w1.x = cvt_pk_bf16(x[8], x[9]); w1.y = cvt_pk_bf16(x[10], x[11]); w1.z = cvt_pk_bf16(x[12], x[13]); w1.w = cvt_pk_bf16(x[14], x[15]);
            xo[lane] = w0; xo[64 + lane] = w1;
            if (lane == 0) rs[t0 + r] = r1;
        }
    }
}

__device__ __forceinline__ void conv_wave_item(const bf16_t* p, const float* cw, bf16_t* Hm, int t0, int pos0, int S, int lane) {
    float w0[8], w1[8], w2[8];
    { const f32x4* a = (const f32x4*)(cw + lane * 8); const f32x4* b = (const f32x4*)(cw + 512 + lane * 8); const f32x4* c = (const f32x4*)(cw + 1024 + lane * 8);
#pragma unroll
      for (int h = 0; h < 2; ++h) { const f32x4 va = a[h], vb = b[h], vc = c[h];
#pragma unroll
        for (int k = 0; k < 4; ++k) { w0[4 * h + k] = va[k]; w1[4 * h + k] = vb[k]; w2[4 * h + k] = vc[k]; } } }
    float zp[8], zc[8], zn[8], gb[8];
    const bf16_t* base = p + (size_t)t0 * PLD + lane * 8;
    if (pos0 == 0) {
#pragma unroll
        for (int k = 0; k < 8; ++k) zp[k] = 0.f;
    } else load8(base - PLD + 512, zp);
    load8(base + 512, zc);
#pragma unroll 8
    for (int i = 0; i < 16; ++i) {
        const bf16_t* r = base + (size_t)i * PLD;
        if (pos0 + i + 1 == S) {
#pragma unroll
            for (int k = 0; k < 8; ++k) zn[k] = 0.f;
        } else load8(r + PLD + 512, zn);
        load8(r, gb);
        float y[8], ss = 0.f;
#pragma unroll
        for (int k = 0; k < 8; ++k) { y[k] = gb[k] * (zp[k] * w0[k] + zc[k] * w1[k] + zn[k] * w2[k]); ss += y[k] * y[k]; }
        ss = xadd4(xadd2(xadd1(ss)));
        const float rs = rsqrtf(ss * (1.f / 64.f) + EPS);
        u32x4 o; o.x = cvt_pk_bf16(y[0] * rs, y[1] * rs); o.y = cvt_pk_bf16(y[2] * rs, y[3] * rs); o.z = cvt_pk_bf16(y[4] * rs, y[5] * rs); o.w = cvt_pk_bf16(y[6] * rs, y[7] * rs);
        *(u32x4*)(Hm + (size_t)(t0 + i) * D + lane * 8) = o;
#pragma unroll
        for (int k = 0; k < 8; ++k) { zp[k] = zc[k]; zc[k] = zn[k]; }
    }
}

constexpr int XSTR = 272;
constexpr int RSTR = 34;
constexpr int LDS_XT = 0, LDS_R = 36864, LDS_OST = 106496;
#define LBAR() do { asm volatile("s_waitcnt lgkmcnt(0)" ::: "memory"); __builtin_amdgcn_s_barrier(); asm volatile("" ::: "memory"); } while (0)
__device__ __forceinline__ int seq_base(int bs) { return bs < BP ? bs * SP : TP + (bs - BP) * SS; }

__device__ __forceinline__ void dft_frags(bf16x8 (&Br)[4], bf16x8 (&Bi)[4], int log2n, int kt, int lane) {
    const int N = 1 << log2n, k = 16 * kt + (lane & 15); const float sc = 2.f / (float)N;
#pragma unroll
    for (int ks = 0; ks < 4; ++ks) { u32x4 wr, wi;
#pragma unroll
        for (int e2 = 0; e2 < 4; ++e2) { float c0, s0, c1, s1; const int n0 = 32 * ks + 8 * (lane >> 4) + 2 * e2;
            sincospif(-(float)((n0 * k) & (N - 1)) * sc, &s0, &c0); sincospif(-(float)(((n0 + 1) * k) & (N - 1)) * sc, &s1, &c1);
            wr[e2] = cvt_pk_bf16(c0, c1); wi[e2] = cvt_pk_bf16(s0, s1); }
        Br[ks] = __builtin_bit_cast(bf16x8, wr); Bi[ks] = __builtin_bit_cast(bf16x8, wi); }
}
template <int XS = XSTR>
__device__ __forceinline__ void xt_write(LAS unsigned char* xt, int rp, int ch, const u32x4 va, const u32x4 vb) {
    LAS unsigned char* base = xt + (8 * ch) * XS + ((((rp >> 2) ^ ch) << 4) + (rp & 3) * 4);
#pragma unroll
    for (int e2 = 0; e2 < 4; ++e2) {
        *(LAS unsigned*)(base + (2 * e2) * XS) = (va[e2] & 0xffffu) | (vb[e2] << 16);
        *(LAS unsigned*)(base + (2 * e2 + 1) * XS) = (va[e2] >> 16) | (vb[e2] & 0xffff0000u); }
}
template <int XS = XSTR>
__device__ __forceinline__ void dft_mfma(const LAS unsigned char* xt, int log2n, const bf16x8 (&Br)[4], const bf16x8 (&Bi)[4], f32x4 (&Pa)[4], f32x4 (&Qa)[4], int lane) {
#pragma unroll
    for (int it = 0; it < 4; ++it) { Pa[it] = (f32x4){0.f, 0.f, 0.f, 0.f}; Qa[it] = (f32x4){0.f, 0.f, 0.f, 0.f}; }
#pragma unroll
    for (int ks = 0; ks < 4; ++ks) if (ks < (1 << (log2n - 5))) {
#pragma unroll
        for (int it = 0; it < 4; ++it) { const int col = 16 * it + (lane & 15), gr = 4 * ks + (lane >> 4);
            const bf16x8 a = *(const LAS bf16x8*)(xt + col * XS + ((gr ^ (col >> 3)) << 4));
            Pa[it] = __builtin_amdgcn_mfma_f32_16x16x32_bf16(a, Br[ks], Pa[it], 0, 0, 0);
            Qa[it] = __builtin_amdgcn_mfma_f32_16x16x32_bf16(a, Bi[ks], Qa[it], 0, 0, 0); } }
}

__device__ __forceinline__ void p1_decode(int item, int& bs, int& g, int& n2, int& S, int& log2N2) {
    if (item < 2048) { bs = item >> 10; const int r = item & 1023; n2 = r >> 3; g = r & 7; S = SP; log2N2 = 7; }
    else { const int it = item - 2048; bs = BP + (it >> 9); const int r = it & 511; n2 = r >> 3; g = r & 7; S = SS; log2N2 = 6; }
}
__device__ __forceinline__ void p1_load(const bf16_t* p, int item, int rp, int ch, u32x4& va, u32x4& vb) {
    int bs, g, n2, S, l2; p1_decode(item, bs, g, n2, S, l2);
    const bf16_t* src = p + (size_t)(seq_base(bs) + ((2 * rp) << l2) + n2) * PLD + 1024 + g * 64 + ch * 8;
    va = *(const u32x4*)src; vb = *(const u32x4*)(src + ((size_t)PLD << l2));
}
__device__ __forceinline__ void fft_pass1(const bf16_t* p, bf16_t* inter, LAS unsigned char* lds, int bid, int G, int tid) {
    constexpr int NP1 = 2048 + 4096;
    const int lane = tid & 63, wave = __builtin_amdgcn_readfirstlane(tid >> 6), rp = tid >> 3, ch = tid & 7;
    bf16x8 Br[4], Bi[4]; dft_frags(Br, Bi, 7, wave, lane);
    u32x4 va, vb;
    if (bid < NP1) p1_load(p, bid, rp, ch, va, vb);
    int par = 0;
    for (int item = bid; item < NP1; item += G, par ^= 1) {
        LAS unsigned char* xt = lds + LDS_XT + par * (64 * XSTR);
        xt_write(xt, rp, ch, va, vb);
        if (item + G < NP1) p1_load(p, item + G, rp, ch, va, vb);
        LBAR();
        f32x4 Pa[4], Qa[4]; dft_mfma(xt, 7, Br, Bi, Pa, Qa, lane);
        int bs, g, n2, S, l2; p1_decode(item, bs, g, n2, S, l2);
        const int k1 = 16 * wave + (lane & 15), quad = lane >> 4;
        float sn, cs; sincospif(-2.0f * (float)(n2 * k1) / (float)S, &sn, &cs);
        bf16_t* dst = inter + ((size_t)seq_base(bs) * 8 + (size_t)g * S + ((size_t)k1 << l2) + n2) * 64 + 4 * quad;
#pragma unroll
        for (int it = 0; it < 4; ++it) {
            const float r0 = Pa[it][0] - Qa[it][1], i0 = Pa[it][1] + Qa[it][0], r1 = Pa[it][2] - Qa[it][3], i1 = Pa[it][3] + Qa[it][2];
            u32x2 w; w.x = cvt_pk_bf16(r0 * cs - i0 * sn, r0 * sn + i0 * cs); w.y = cvt_pk_bf16(r1 * cs - i1 * sn, r1 * sn + i1 * cs);
            *(u32x2*)(dst + 16 * it) = w; }
    }
    LBAR();
}

template <int LOG2N, int NT>
__device__ __forceinline__ void p2_assemble(const LAS f32x2* R, bf16_t* Hm, int tb, int g, int ipbase, float sc, int tid) {
    constexpr int N2 = 1 << LOG2N;
#pragma unroll
    for (int rep_ = 0; rep_ < (NT * N2 * 4) / NTHREADS; ++rep_) {
        const int task = tid + NTHREADS * rep_, q = task & 3, tl = task >> 2, h = tl >> LOG2N, k2 = tl & (N2 - 1), ip = ipbase + (h >> 1);
        const int ph = (ip == 0) ? h : (h ^ 1);
        const int k2p = (ip == 0 && (h & 1) == 0) ? ((N2 - k2) & (N2 - 1)) : (N2 - 1 - k2);
        const LAS f32x4* po = (const LAS f32x4*)(R + (h * N2 + k2) * RSTR + 8 * q);
        const LAS f32x4* pp = (const LAS f32x4*)(R + (ph * N2 + k2p) * RSTR + 8 * q);
        f32x4 o[4], p[4];
#pragma unroll
        for (int i = 0; i < 4; ++i) { o[i] = po[i]; p[i] = pp[i]; }
        float v1[8], v2[8], ss = 0.f;
#pragma unroll
        for (int j = 0; j < 8; ++j) { v1[j] = o[j >> 1][(j & 1) * 2] * sc; v2[j] = p[j >> 1][(j & 1) * 2] * sc; }
        if (q == 0) { v1[0] = 0.5f * (o[0][0] + p[0][0]) * sc; v2[0] = 0.5f * (o[0][1] + p[0][1]) * sc; }
#pragma unroll
        for (int j = 0; j < 8; ++j) ss += v1[j] * v1[j] + v2[j] * v2[j];
        ss = xadd2(xadd1(ss));
        const float rs = rsqrtf(ss * (1.f / 64.f) + EPS);
        const float nb = dpp_f<0x39>(v2[0]);
        const int hl = h & 1, k1 = hl == 0 ? ip : (ip == 0 ? 64 : 128 - ip);
        bf16_t* dst = Hm + (size_t)(tb + k1 + 128 * k2) * D + 512 + g * 64;
        u32x4 w0, w1;
        w0.x = cvt_pk_bf16(v1[0] * rs, v1[1] * rs); w0.y = cvt_pk_bf16(v1[2] * rs, v1[3] * rs); w0.z = cvt_pk_bf16(v1[4] * rs, v1[5] * rs); w0.w = cvt_pk_bf16(v1[6] * rs, v1[7] * rs);
        w1.x = cvt_pk_bf16(nb * rs, v2[7] * rs); w1.y = cvt_pk_bf16(v2[6] * rs, v2[5] * rs); w1.z = cvt_pk_bf16(v2[4] * rs, v2[3] * rs); w1.w = cvt_pk_bf16(v2[2] * rs, v2[1] * rs);
        *(u32x4*)(dst + 8 * q) = w0; *(u32x4*)(dst + 56 - 8 * q) = w1;
    }
}

__device__ __forceinline__ void p2_decode(int item, int& bs, int& g, int& k1a, int& k1b, int& ip) {
    int r;
    if (item < 1024) { bs = item >> 9; r = item & 511; } else { const int it = item - 1024; bs = BP + (it >> 9); r = it & 511; }
    g = r >> 6; ip = r & 63; k1a = ip; k1b = ip == 0 ? 64 : 128 - ip;
}
template <int LOG2N>
__device__ __forceinline__ void fft_pass2(const bf16_t* inter, bf16_t* Hm, LAS unsigned char* lds, int item0, int item_end, int G, int tid) {
    constexpr int N2 = 1 << LOG2N, NTASK = N2 / 64, S = (LOG2N == 7) ? SP : SS;
    const int lane = tid & 63, wave = __builtin_amdgcn_readfirstlane(tid >> 6);
    bf16x8 Br[4], Bi[4]; dft_frags(Br, Bi, LOG2N, LOG2N == 7 ? wave : (wave & 3), lane);
    u32x4 va[NTASK], vb[NTASK];
#define P2_LOAD(item_) do { int bs_, g_, ka_, kb_, ip_; p2_decode(item_, bs_, g_, ka_, kb_, ip_); \
        const bf16_t* ib_ = inter + ((size_t)seq_base(bs_) * 8 + (size_t)g_ * S) * 64; \
        _Pragma("unroll") for (int j = 0; j < NTASK; ++j) { const int q = tid + NTHREADS * j, h = q / (4 * N2), r = q % (4 * N2), rp = r >> 3, ch = r & 7; \
            const bf16_t* src = ib_ + ((size_t)((h ? kb_ : ka_) * N2 + 2 * rp)) * 64 + ch * 8; va[j] = *(const u32x4*)src; vb[j] = *(const u32x4*)(src + 64); } } while (0)
    if (item0 < item_end) P2_LOAD(item0);
    LAS f32x2* R = (LAS f32x2*)(lds + LDS_R);
    LAS bf16_t* Ost = (LAS bf16_t*)(lds + LDS_OST);
    const float sc = rsqrtf((float)S);
    for (int item = item0; item < item_end; item += G) {
#pragma unroll
        for (int j = 0; j < NTASK; ++j) { const int q = tid + NTHREADS * j, h = q / (4 * N2), r = q % (4 * N2);
            xt_write(lds + LDS_XT + h * (64 * XSTR), r >> 3, r & 7, va[j], vb[j]); }
        if (item + G < item_end) P2_LOAD(item + G);
        LBAR();
        {
            f32x4 Pa[4], Qa[4]; const int quad = lane >> 4;
#pragma unroll
            for (int hh = 0; hh < (LOG2N == 7 ? 2 : 1); ++hh) {
                const int h = (LOG2N == 7) ? hh : (wave >> 2), kt = (LOG2N == 7) ? wave : (wave & 3);
                dft_mfma(lds + LDS_XT + h * (64 * XSTR), LOG2N, Br, Bi, Pa, Qa, lane);
                LAS f32x2* Rr = R + (h * N2 + 16 * kt + (lane & 15)) * RSTR + 2 * quad;
#pragma unroll
                for (int it = 0; it < 4; ++it)
                    *(LAS f32x4*)(Rr + 8 * it) = (f32x4){Pa[it][0] - Qa[it][1], Pa[it][1] + Qa[it][0], Pa[it][2] - Qa[it][3], Pa[it][3] + Qa[it][2]};
            }
        }
        LBAR();
        int bs, g, k1a, k1b, ip; p2_decode(item, bs, g, k1a, k1b, ip);
        const int tb = seq_base(bs);
        p2_assemble<LOG2N, 2>(R, Hm, tb, g, ip, sc, tid);
    }
    LBAR();
#undef P2_LOAD
}

__device__ __forceinline__ void fft_pass2s(const bf16_t* inter, bf16_t* Hm, LAS unsigned char* lds, int item0, int item_end, int G, int tid) {
    constexpr int N2 = 64, XS6 = 144, S = SS;
    const int lane = tid & 63, wave = __builtin_amdgcn_readfirstlane(tid >> 6);
    bf16x8 Br[4], Bi[4]; dft_frags(Br, Bi, 6, wave & 3, lane);
    u32x4 va[2], vb[2];
#define P2S_K1(ip_, hl_) ((hl_) == 0 ? (ip_) : ((ip_) == 0 ? 64 : 128 - (ip_)))
#define P2S_LOAD(item_) do { const int bs_ = BP + ((item_) >> 8), r_ = (item_) & 255, g_ = r_ >> 5, jp_ = r_ & 31; \
        const bf16_t* ib_ = inter + ((size_t)seq_base(bs_) * 8 + (size_t)g_ * S) * 64; \
        _Pragma("unroll") for (int j = 0; j < 2; ++j) { const int q = tid + NTHREADS * j, h = q >> 8, r = q & 255, rp = r >> 3, ch = r & 7, ip_ = 2 * jp_ + (h >> 1); \
            const bf16_t* src = ib_ + ((size_t)(P2S_K1(ip_, h & 1) * N2 + 2 * rp)) * 64 + ch * 8; va[j] = *(const u32x4*)src; vb[j] = *(const u32x4*)(src + 64); } } while (0)
    if (item0 < item_end) P2S_LOAD(item0);
    LAS f32x2* R = (LAS f32x2*)(lds + LDS_R);
    LAS bf16_t* Ost = (LAS bf16_t*)(lds + LDS_OST);
    const float sc = rsqrtf((float)S);
    for (int item = item0; item < item_end; item += G) {
#pragma unroll
        for (int j = 0; j < 2; ++j) { const int q = tid + NTHREADS * j, h = q >> 8, r = q & 255;
            xt_write<XS6>(lds + LDS_XT + h * (64 * XS6), r >> 3, r & 7, va[j], vb[j]); }
        if (item + G < item_end) P2S_LOAD(item + G);
        LBAR();
        {
            f32x4 Pa[4], Qa[4]; const int quad = lane >> 4, kt = wave & 3;
#pragma unroll
            for (int hh = 0; hh < 2; ++hh) { const int h = (wave >> 2) + 2 * hh;
                dft_mfma<XS6>(lds + LDS_XT + h * (64 * XS6), 6, Br, Bi, Pa, Qa, lane);
                LAS f32x2* Rr = R + (h * N2 + 16 * kt + (lane & 15)) * RSTR + 2 * quad;
#pragma unroll
                for (int it = 0; it < 4; ++it)
                    *(LAS f32x4*)(Rr + 8 * it) = (f32x4){Pa[it][0] - Qa[it][1], Pa[it][1] + Qa[it][0], Pa[it][2] - Qa[it][3], Pa[it][3] + Qa[it][2]};
            }
        }
        LBAR();
        const int bs = BP + (item >> 8), rr = item & 255, g = rr >> 5, jp = rr & 31, tb = seq_base(bs);
        p2_assemble<6, 4>(R, Hm, tb, g, 2 * jp, sc, tid);
    }
    LBAR();
#undef P2S_LOAD
#undef P2S_K1
}

#define XB_TMO      128
#define XB_XCNT(j)  (256  + 64 * (j))
#define XB_XSUB(j)  (1280 + 64 * (j))
#define XB_XGEN(j)  (2304 + 64 * (j))
#define XB_TOP      3328
#define XB_TOPGEN   3392
#define XCD_BAR_WORDS 3456
#define XB_SPIN_CAP (1u << 20)
__device__ __forceinline__ unsigned xb_ld(unsigned* p)              { return __hip_atomic_load(p, __ATOMIC_RELAXED, __HIP_MEMORY_SCOPE_AGENT); }
__device__ __forceinline__ unsigned xb_add(unsigned* p, unsigned v) { return __hip_atomic_fetch_add(p, v, __ATOMIC_RELAXED, __HIP_MEMORY_SCOPE_AGENT); }
__device__ __forceinline__ unsigned xb_xcc_id() { return (unsigned)__builtin_amdgcn_s_getreg((3 << 11) | 20) & 0xFu; }
#define XB_SPIN(cond, bar) do { unsigned _sp = 0; while (cond) { __builtin_amdgcn_s_sleep(1); \
    if ((++_sp & 255u) == 0u) { if (xb_ld(&(bar)[XB_TMO])) break; if (_sp > XB_SPIN_CAP) { atomicAdd(&(bar)[XB_TMO], 1u); break; } } } } while (0)
struct XcdBarrier { unsigned* bar; unsigned x; volatile LAS unsigned* st; };
__device__ __forceinline__ XcdBarrier xcd_barrier_post(unsigned* bar, volatile LAS unsigned* st) {
    XcdBarrier b; b.bar = bar; b.x = xb_xcc_id(); b.st = st;
    if (threadIdx.x == 0) (void)xb_add(&bar[XB_XCNT(b.x)], 1u);
    return b;
}
__device__ __forceinline__ void xcd_barrier_complete(unsigned* bar, unsigned x, unsigned& nloc, unsigned& nx) {
    const unsigned G = gridDim.x * gridDim.y * gridDim.z;
    unsigned sum, cnt, mine, sp = 0u;
    for (;;) {
        sum = 0u; cnt = 0u; mine = 0u;
#pragma unroll
        for (unsigned j = 0; j < 16; ++j) { const unsigned c = xb_ld(&bar[XB_XCNT(j)]); sum += c; cnt += (c > 0u) ? 1u : 0u; mine = (j == x) ? c : mine; }
        if (sum == G) break;
        __builtin_amdgcn_s_sleep(1);
        if ((++sp & 255u) == 0u) { if (xb_ld(&bar[XB_TMO])) break; if (sp > XB_SPIN_CAP) { atomicAdd(&bar[XB_TMO], 1u); break; } }
    }
    nloc = mine > 0u ? mine : 1u; nx = cnt > 0u ? cnt : 1u;
}
__device__ __forceinline__ void xcd_barrier(const XcdBarrier& b) {
    asm volatile("s_waitcnt vmcnt(0)" ::: "memory");
    __syncthreads();
    if (threadIdx.x == 0) {
        unsigned* bar = b.bar;
        __builtin_amdgcn_s_waitcnt(0);
        unsigned nloc = b.st[0], nx = b.st[1];
        if (nloc == 0u) { xcd_barrier_complete(bar, b.x, nloc, nx); b.st[0] = nloc; b.st[1] = nx; }
        const unsigned old = xb_add(&bar[XB_XSUB(b.x)], 1u);
        const unsigned gen = old / nloc;
        if (old + 1u == (gen + 1u) * nloc) {
            __builtin_amdgcn_fence(__ATOMIC_RELEASE, "agent");
            asm volatile("s_waitcnt vmcnt(0)" ::: "memory");
            const unsigned og = xb_add(&bar[XB_TOP], 1u);
            const unsigned tg = og / nx;
            if (og + 1u == (tg + 1u) * nx) xb_add(&bar[XB_TOPGEN], 1u);
            else XB_SPIN(xb_ld(&bar[XB_TOPGEN]) == tg, bar);
            __builtin_amdgcn_fence(__ATOMIC_ACQUIRE, "agent");
            xb_add(&bar[XB_XGEN(b.x)], 1u);
            asm volatile("s_waitcnt vmcnt(0)" ::: "memory");
        } else {
            XB_SPIN(xb_ld(&bar[XB_XGEN(b.x)]) == gen, bar);
            __builtin_amdgcn_fence(__ATOMIC_ACQUIRE, "agent");
            asm volatile("s_waitcnt vmcnt(0)" ::: "memory");
        }
    }
    __syncthreads();
}

__global__ void __launch_bounds__(NTHREADS, 2) fwd_megakernel(Params P) {
    extern __shared__ __attribute__((aligned(16))) unsigned char shm[];
    cg::grid_group grid = cg::this_grid();
    LAS unsigned char* lds = (LAS unsigned char*)shm;
    const int G = gridDim.x, bid = blockIdx.x, NGW = G * NWAVES;
#define FRESH() int tid = threadIdx.x; asm volatile("" : "+v"(tid)); const int lane = tid & 63, wave = __builtin_amdgcn_readfirstlane(tid >> 6), gw = bid * NWAVES + wave; (void)lane; (void)gw
#define TAB ((LAS float*)(lds + LDS_MISC))
    { FRESH();
      if (tid < 64) TAB[tid] = cospif((float)tid * (1.f / 32.f));
      if (tid < 4) ((volatile LAS unsigned*)(lds + LDS_MISC + 1024))[tid] = 0u; }
    __syncthreads();
    const XcdBarrier xbar = xcd_barrier_post((unsigned*)P.ws, (volatile LAS unsigned*)(lds + LDS_MISC + 1024));
#define GSYNC() xcd_barrier(xbar)

    unsigned char* ws = P.ws;
#define Xb ((bf16_t*)(ws + WS_X))
#define Hb ((bf16_t*)(ws + WS_H))
#define Pb ((bf16_t*)P.out)
#define Ib ((bf16_t*)(ws + WS_INTER))
#define MFb ((bf16_t*)(ws + WS_MF))
#define A0b ((bf16_t*)(ws + WS_H))
#define A1b ((bf16_t*)P.out)
#define RSb ((float*)(ws + WS_RS))

    {
        FRESH();
        LAS float* scr = (LAS float*)(lds + wave * 8704);
        constexpr int I_IN = 16 * 48, I_OUT = 16 * 32, I_UP = 16 * 128, I_DN = 64 * 32, I_F = 128, I_L = I_IN + I_OUT + I_UP + I_DN + I_F;
        for (int it = gw; it < NL * I_L; it += NGW) {
            const int l = it / I_L; int r = it % I_L;
            bf16_t* Wl = (bf16_t*)(ws + WS_W + (size_t)l * WL_SZ);
            const float* win = P.w_in + (size_t)l * D * DIN;
            if (r < I_IN) { p0_transpose_item<true>(win, D, DIN, 48, Wl + WL_IN / 2, P.g_mix_pre + l * D, scr, r, lane); continue; } r -= I_IN;
            if (r < I_OUT) {
                const int kb = r / 32; const float* gsrc = kb < 8 ? P.g_conv_out + l * 512 : P.g_fourier_out + l * 512 - 512;
                p0_transpose_item(P.w_out + (size_t)l * D * D, D, D, 32, Wl + WL_OUT / 2, gsrc, scr, r, lane); continue; } r -= I_OUT;
            if (r < I_UP) { p0_transpose_item(P.w_up + (size_t)l * D * DFF, D, DFF, 128, Wl + WL_UP / 2, P.g_mlp_pre + l * D, scr, r, lane); continue; } r -= I_UP;
            if (r < I_DN) { p0_transpose_item(P.w_down + (size_t)l * DFF * D, DFF, D, 32, Wl + WL_DN / 2, nullptr, scr, r, lane); continue; } r -= I_DN;
            p0_fold_item(win, P.g_mix_pre + l * D, Wl + WL_IN / 2, TAB, r, lane);
        }
        for (int t = gw * 4; t < T; t += NGW * 4) x_rows_init<4>(t < TP ? P.xp + (size_t)t * D : P.xs + (size_t)(t - TP) * D, Xb + (size_t)t * D, RSb + t, lane);
    }
    grid.sync();

    for (int l = 0; l < NL; ++l) {
        const bf16_t* Wl = (const bf16_t*)(ws + WS_W + (size_t)l * WL_SZ);
        { pg8::Gemm g{Xb, Wl + WL_IN / 2, T, DIN, D, nullptr, 1 << 20}; pg8::StaticOrder S; S.init(T, DIN, G, bid); pg8::EpiInProj E{Pb, RSb};
          pg8::gemm_phase(lds, g, S, E); }
        GSYNC();
        {
            FRESH();
            constexpr int NCONV = T / 128;
            for (int it = bid; it < NCONV; it += G) { const int t0 = it * 128 + wave * 16; const int S = t0 < TP ? SP : SS; const int pos0 = t0 < TP ? (t0 & (SP - 1)) : ((t0 - TP) & (SS - 1));
                conv_wave_item(Pb, P.conv_w + (size_t)l * 3 * 512, Hb, t0, pos0, S, lane); }
            fft_pass1(Pb, Ib, lds, bid, G, tid);
        }
        GSYNC();
        { FRESH(); fft_pass2<7>(Ib, Hb, lds, bid, 1024, G, tid); }
        { FRESH(); fft_pass2s(Ib, Hb, lds, bid, 2048, G, tid); }
        GSYNC();
        { pg8::Gemm g{Hb, Wl + WL_OUT / 2, T, D, D, nullptr, 1 << 20}; pg8::StaticOrder S; S.init(T, D, G, bid); pg8::EpiBf16 E{MFb, D, 0, nullptr, nullptr, 1 << 20};
          pg8::gemm_phase(lds, g, S, E); }
        GSYNC();
        { FRESH();
          for (int t = gw * 8; t < T; t += NGW * 8) row_pass_rows<8>(Xb, MFb, P.g_mix_post + l * D, RSb, nullptr, false, t, lane); }
        GSYNC();
        { pg8::Gemm g{Xb, Wl + WL_UP / 2, T, DFF, D, nullptr, 1 << 20}; pg8::StaticOrder S; S.init(T, DFF, G, bid); pg8::EpiBf16 E{A0b, DFF, 1, nullptr, A1b, TCH / 256};
          pg8::gemm_phase(lds, g, S, E); }
        GSYNC();
        { pg8::Gemm g{A0b, Wl + WL_DN / 2, T, D, DFF, A1b, TCH / 256}; pg8::StaticOrder S; S.init(T, D, G, bid); pg8::EpiBf16 E{MFb, D, 0, nullptr, nullptr, 1 << 20};
          pg8::gemm_phase(lds, g, S, E); }
        GSYNC();
        { FRESH();
          float* outf = (l + 1 < NL) ? nullptr : P.out;
          for (int t = gw * 8; t < T; t += NGW * 8) row_pass_rows<8>(Xb, MFb, P.g_mlp_post + l * D, RSb, outf, true, t, lane); }
        if (l + 1 < NL) GSYNC();
    }
}

extern "C" void kernel_launch(void* const* d_in, const int* in_sizes, int n_in, void* d_out, int out_size, void* d_ws, size_t ws_size, hipStream_t stream) {
    static int grid_blocks = 0;
    if (grid_blocks == 0) {
        if (n_in != 13 || out_size != T * D || ws_size < WS_END) { fprintf(stderr, "kernel_launch: unexpected shapes (n_in %d, out %d, ws %zu, need %zu)\n", n_in, out_size, ws_size, (size_t)WS_END); grid_blocks = -1; return; }
        int dev = 0, cus = 0, per_cu = 0;
        hipGetDevice(&dev);
        hipDeviceGetAttribute(&cus, hipDeviceAttributeMultiprocessorCount, dev);
        if (hipFuncSetAttribute((const void*)fwd_megakernel, hipFuncAttributeMaxDynamicSharedMemorySize, LDS_BYTES) != hipSuccess) { fprintf(stderr, "kernel_launch: hipFuncSetAttribute failed\n"); grid_blocks = -1; return; }
        hipOccupancyMaxActiveBlocksPerMultiprocessor(&per_cu, (const void*)fwd_megakernel, NTHREADS, LDS_BYTES);
        if (per_cu < 1) { fprintf(stderr, "kernel_launch: occupancy query says %d blocks per CU\n", per_cu); per_cu = 1; }
        grid_blocks = cus * per_cu;
    }
    if (grid_blocks < 0) return;
    Params p{};
    p.xp = (const float*)d_in[0]; p.xs = (const float*)d_in[1]; p.g_mix_pre = (const float*)d_in[2]; p.w_in = (const float*)d_in[3]; p.conv_w = (const float*)d_in[4];
    p.g_conv_out = (const float*)d_in[5]; p.g_fourier_out = (const float*)d_in[6]; p.w_out = (const float*)d_in[7]; p.g_mix_post = (const float*)d_in[8];
    p.g_mlp_pre = (const float*)d_in[9]; p.w_up = (const float*)d_in[10]; p.w_down = (const float*)d_in[11]; p.g_mlp_post = (const float*)d_in[12];
    p.out = (float*)d_out; p.ws = (unsigned char*)d_ws;
    if (hipMemsetAsync(d_ws, 0, 16384, stream) != hipSuccess) { fprintf(stderr, "kernel_launch: memset failed\n"); return; }
    void* args[] = {&p};
    hipError_t e = hipLaunchCooperativeKernel((const void*)fwd_megakernel, dim3(grid_blocks), dim3(NTHREADS), args, LDS_BYTES, stream);
    if (e != hipSuccess) fprintf(stderr, "cooperative launch failed: %s (grid %d)\n", hipGetErrorString(e), grid_blocks);
}
```

```cpp
#include <hip/hip_runtime.h>
#include <hip/hip_cooperative_groups.h>
#include <cstdio>
namespace cg = cooperative_groups;

#define LAS __attribute__((address_space(3)))
typedef unsigned short bf16_t;
typedef short bf16x8 __attribute__((ext_vector_type(8)));
typedef float f32x4 __attribute__((ext_vector_type(4)));
typedef float f32x2 __attribute__((ext_vector_type(2)));
typedef unsigned u32x4 __attribute__((ext_vector_type(4)));
typedef unsigned u32x2 __attribute__((ext_vector_type(2)));

constexpr int D = 1024, DIN = 2048, DFF = 4096, NL = 4;
constexpr int PLD = 1536;
constexpr int SP = 16384, BP = 2, SS = 8192, BS = 8;
constexpr int TP = BP * SP, TS = BS * SS, T = TP + TS;
constexpr float EPS = 1e-6f;
constexpr int NCH = 2;
constexpr int TCH = T / NCH;

constexpr size_t MiB = (size_t)1 << 20;
constexpr size_t WS_W = 1 * MiB;
constexpr size_t WL_IN = 0, WL_OUT = 4 * MiB, WL_UP = 6 * MiB, WL_DN = 14 * MiB, WL_SZ = 22 * MiB;
constexpr size_t WS_X = WS_W + NL * WL_SZ;
constexpr size_t WS_H = WS_X + (size_t)T * D * 2;
constexpr size_t WS_INTER = WS_H + (size_t)T * D * 2;
constexpr size_t WS_MF = WS_INTER + (size_t)T * 256 * 8;
constexpr size_t WS_RS = WS_MF + (size_t)T * D * 2;
constexpr size_t WS_END = WS_RS + 1 * MiB;

constexpr int LDS_STAGE = 131072, LDS_MISC = 139264, LDS_BYTES = LDS_MISC + 4096;
constexpr int NTHREADS = 512, NWAVES = 8;

struct Params {
    const float* xp; const float* xs; const float* g_mix_pre; const float* w_in; const float* conv_w;
    const float* g_conv_out; const float* g_fourier_out; const float* w_out; const float* g_mix_post;
    const float* g_mlp_pre; const float* w_up; const float* w_down; const float* g_mlp_post;
    float* out; unsigned char* ws;
};

__device__ __forceinline__ unsigned cvt_pk_bf16(float lo, float hi) { unsigned r; asm volatile("v_cvt_pk_bf16_f32 %0, %1, %2" : "=v"(r) : "v"(lo), "v"(hi)); return r; }
__device__ __forceinline__ float bf_lo(unsigned w) { return __uint_as_float(w << 16); }
__device__ __forceinline__ float bf_hi(unsigned w) { return __uint_as_float(w & 0xffff0000u); }
template <int CTRL> __device__ __forceinline__ float dpp_f(float x) { return __builtin_bit_cast(float, __builtin_amdgcn_update_dpp(0, __builtin_bit_cast(int, x), CTRL, 0xF, 0xF, true)); }
__device__ __forceinline__ float xadd1(float v) { return v + dpp_f<0xB1>(v); }
__device__ __forceinline__ float xadd2(float v) { return v + dpp_f<0x4E>(v); }
__device__ __forceinline__ float xadd4(float v) { return v + dpp_f<0x141>(v); }
__device__ __forceinline__ float xadd8(float v) { return v + dpp_f<0x140>(v); }
__device__ __forceinline__ float wave_sum(float v) {
    v = xadd8(xadd4(xadd2(xadd1(v))));
    const int b = __builtin_bit_cast(int, v);
    const float r0 = __builtin_bit_cast(float, __builtin_amdgcn_readlane(b, 0)), r1 = __builtin_bit_cast(float, __builtin_amdgcn_readlane(b, 16));
    const float r2 = __builtin_bit_cast(float, __builtin_amdgcn_readlane(b, 32)), r3 = __builtin_bit_cast(float, __builtin_amdgcn_readlane(b, 48));
    return (r0 + r1) + (r2 + r3);
}
__device__ __forceinline__ void load8(const bf16_t* ptr, float (&v)[8]) {
    const u32x4 q = *(const u32x4*)ptr;
    v[0] = bf_lo(q.x); v[1] = bf_hi(q.x); v[2] = bf_lo(q.y); v[3] = bf_hi(q.y); v[4] = bf_lo(q.z); v[5] = bf_hi(q.z); v[6] = bf_lo(q.w); v[7] = bf_hi(q.w);
}

namespace pg8 {
constexpr int BM = 256, BK = 64, HALF = 128, HTB = HALF * BK * 2, STAGE_BYTES = 8 * HTB, NXCD = 8, WGM = 8;
__device__ __forceinline__ int lds_byte(int r, int c) { const int st = (r >> 4) * 2 + (c >> 5), rr = r & 15, cc = c & 31, ob = rr * 64 + cc * 2; return st * 1024 + (ob ^ (((ob >> 9) & 1) << 5)); }
__device__ __forceinline__ void stage_rc(int b, int& R, int& C) { const int st = b / 1024, sb = b % 1024, swz = sb ^ (((sb >> 9) & 1) << 5); R = (st >> 1) * 16 + swz / 64; C = (st & 1) * 32 + (swz % 64) / 2; }
__device__ __forceinline__ int perm32(int rho) { const int n = rho >> 4, i = rho & 15; return 8 * (i >> 2) + 4 * n + (i & 3); }

struct Unit { int pm, pn; };
struct Gemm { const bf16_t* A; const bf16_t* Bt; int M, N, K; const bf16_t* A2; int split; };

struct StaticOrder {
    int nM, nN, nwg, G, c;
    __device__ void init(int M, int N, int G_, int c_) { nM = M / BM; nN = N / BM; nwg = nM * nN; G = G_; c = c_; }
    __device__ bool next(int i, Unit& u) const {
        const long L = (long)i * G + c; if (L >= nwg) return false;
        int wgid = (int)L; { const int q = nwg / NXCD, r = nwg % NXCD, xcd = wgid % NXCD, off = wgid / NXCD; wgid = (xcd < r ? xcd * (q + 1) : r * (q + 1) + (xcd - r) * q) + off; }
        const int nig = WGM * nN, gid = wgid / nig, fm = gid * WGM, gsz = (nM - fm) < WGM ? (nM - fm) : WGM;
        u.pm = fm + ((wgid % nig) % gsz); u.pn = (wgid % nig) / gsz; return true;
    }
};

struct EpiBf16 {
    static constexpr bool FUSED = false;
    bf16_t* O; int ldc; int act; const float* rs; bf16_t* O2; int split;
    __device__ __forceinline__ void operator()(const f32x4 (&acc)[2][2][4][2], const Unit& u, int wr, int wc, int fr, int fq) const {
        const bool lo = u.pm < split; bf16_t* Ob = lo ? O : O2;
        const int grow0 = u.pm * BM + wr * 64 + fr, row0 = grow0 - (lo ? 0 : split * BM); const int col0 = u.pn * BM + wc * 32 + 8 * fq;
#pragma unroll
        for (int ai = 0; ai < 2; ++ai)
#pragma unroll
            for (int m = 0; m < 4; ++m) { bf16_t* rowp = Ob + (size_t)(row0 + ai * HALF + m * 16) * ldc + col0; const float sc = rs ? rs[grow0 + ai * HALF + m * 16] : 1.f;
#pragma unroll
                for (int bj = 0; bj < 2; ++bj) { f32x4 v0 = acc[ai][bj][m][0] * sc, v1 = acc[ai][bj][m][1] * sc;
                    if (act) {
#pragma unroll
                        for (int j = 0; j < 4; ++j) { float a0, a1; asm("v_max_f32 %0, 0, %1" : "=v"(a0) : "v"(v0[j])); asm("v_max_f32 %0, 0, %1" : "=v"(a1) : "v"(v1[j])); v0[j] = a0; v1[j] = a1; }
                        f32x2 p0 = (f32x2){v0[0], v0[1]}, p1 = (f32x2){v0[2], v0[3]}, p2 = (f32x2){v1[0], v1[1]}, p3 = (f32x2){v1[2], v1[3]};
                        p0 = p0 * p0; p1 = p1 * p1; p2 = p2 * p2; p3 = p3 * p3;
                        v0 = (f32x4){p0.x, p0.y, p1.x, p1.y}; v1 = (f32x4){p2.x, p2.y, p3.x, p3.y}; }
                    u32x4 w; w.x = cvt_pk_bf16(v0[0], v0[1]); w.y = cvt_pk_bf16(v0[2], v0[3]); w.z = cvt_pk_bf16(v1[0], v1[1]); w.w = cvt_pk_bf16(v1[2], v1[3]);
                    *(u32x4*)(rowp + bj * HALF) = w; } }
    }
};


struct EpiInProj {
    static constexpr bool FUSED = false;
    bf16_t* O; const float* rs;
    __device__ __forceinline__ void operator()(const f32x4 (&acc)[2][2][4][2], const Unit& u, int wr, int wc, int fr, int fq) const {
        const int row0 = u.pm * BM + wr * 64 + fr, sub = wc * 32 + 8 * fq;
        const bool isz = (u.pn >= 2 && u.pn < 6);
        const int cbase = isz ? 512 + (u.pn - 2) * 128 + sub : (u.pn < 2 ? u.pn * BM + sub : 1024 + (u.pn - 6) * BM + sub);
#pragma unroll
        for (int ai = 0; ai < 2; ++ai)
#pragma unroll
            for (int m = 0; m < 4; ++m) { const int row = row0 + ai * HALF + m * 16; bf16_t* rowp = O + (size_t)row * PLD + cbase; const float sc = rs[row];
                if (isz) { const float s2 = sc * sc; const f32x4 z0 = acc[ai][0][m][0] * acc[ai][1][m][0] * s2, z1 = acc[ai][0][m][1] * acc[ai][1][m][1] * s2;
                    u32x4 w; w.x = cvt_pk_bf16(z0[0], z0[1]); w.y = cvt_pk_bf16(z0[2], z0[3]); w.z = cvt_pk_bf16(z1[0], z1[1]); w.w = cvt_pk_bf16(z1[2], z1[3]);
                    *(u32x4*)rowp = w; }
                else {
#pragma unroll
                    for (int bj = 0; bj < 2; ++bj) { const f32x4 v0 = acc[ai][bj][m][0] * sc, v1 = acc[ai][bj][m][1] * sc;
                        u32x4 w; w.x = cvt_pk_bf16(v0[0], v0[1]); w.y = cvt_pk_bf16(v0[2], v0[3]); w.z = cvt_pk_bf16(v1[0], v1[1]); w.w = cvt_pk_bf16(v1[2], v1[3]);
                        *(u32x4*)(rowp + bj * HALF) = w; } } }
    }
};

template <class Epi, class Sched>
__device__ __forceinline__ void gemm_phase(LAS unsigned char* lds, const Gemm g, const Sched& S, const Epi& E) {
    int tid_ = threadIdx.x; asm volatile("" : "+v"(tid_));
    const int tid = tid_, wid = __builtin_amdgcn_readfirstlane(tid >> 6), lane = tid & 63, wr = wid >> 2, wc = wid & 3, fr = lane & 15, fq = lane >> 4;
    const int K = g.K, nt = K / BK;
    unsigned voffA[2], voffB[2];
#pragma unroll
    for (int i = 0; i < 2; ++i) { int R, C; stage_rc(tid * 16 + i * 8192, R, C); const int Rb = (R & ~31) + perm32(R & 31);
        voffA[i] = (unsigned)(R * K + C) * 2u; voffB[i] = (unsigned)(Rb * K + C) * 2u; }
    const size_t kstep = (size_t)(BK * 2);
    const size_t hstep = (size_t)HALF * K * 2;
    const size_t tstep = 2 * hstep;
    const unsigned ldsw = (unsigned)wid * 1024u;
    const int aoff = lds_byte(wr * 64 + fr, fq * 8), boff = lds_byte(wc * 32 + fr, fq * 8);
#define PG8_SA(b, h) (((b) * 2 + (h)) * HTB)
#define PG8_SB(b, h) ((4 + (b) * 2 + (h)) * HTB)
#define PG8_STAGE(bufoff, gbase, voff) do { _Pragma("unroll") for (int _i = 0; _i < 2; ++_i) \
        __builtin_amdgcn_global_load_lds((const unsigned*)((const char*)(gbase) + (voff)[_i]), (LAS unsigned*)(lds + (bufoff) + ldsw + _i * 8192), 16, 0, 0); } while (0)
#define PG8_LDA(dst, b, h) do { _Pragma("unroll") for (int m = 0; m < 4; ++m) _Pragma("unroll") for (int k = 0; k < 2; ++k) dst[m][k] = *(const LAS bf16x8*)(lds + PG8_SA(b, h) + aoff + m * 2048 + k * 1024); } while (0)
#define PG8_LDB(dst, b, h) do { _Pragma("unroll") for (int n = 0; n < 2; ++n) _Pragma("unroll") for (int k = 0; k < 2; ++k) dst[n][k] = *(const LAS bf16x8*)(lds + PG8_SB(b, h) + boff + n * 2048 + k * 1024); } while (0)
#define PG8_MMA(ai, bj, At, Bt) do { __builtin_amdgcn_s_setprio(1); _Pragma("unroll") for (int m = 0; m < 4; ++m) _Pragma("unroll") for (int n = 0; n < 2; ++n) _Pragma("unroll") for (int k = 0; k < 2; ++k) \
        acc[ai][bj][m][n] = __builtin_amdgcn_mfma_f32_16x16x32_bf16(Bt[n][k], At[m][k], acc[ai][bj][m][n], 0, 0, 0); __builtin_amdgcn_s_setprio(0); } while (0)
#define PG8_WAIT_V(n) asm volatile("s_waitcnt vmcnt(" #n ")" ::: "memory")
#define PG8_WAIT_L(n) asm volatile("s_waitcnt lgkmcnt(" #n ")" ::: "memory")
#define PG8_BAR __builtin_amdgcn_s_barrier()
#define PG8_SCHED __builtin_amdgcn_sched_barrier(0)
    Unit cur, nxt; int ui = 0;
    if (!S.next(0, cur)) return;
    f32x4 acc[2][2][4][2];
#pragma unroll
    for (int a = 0; a < 2; ++a)
#pragma unroll
        for (int b = 0; b < 2; ++b)
#pragma unroll
            for (int m = 0; m < 4; ++m)
#pragma unroll
                for (int n = 0; n < 2; ++n) acc[a][b][m][n] = (f32x4){0.f, 0.f, 0.f, 0.f};
    bf16x8 At[4][2], B0[2][2], B1[2][2];
#define PG8_APANEL(pm_) ((const char*)(((pm_) < g.split ? (unsigned long long)g.A : (unsigned long long)g.A2 - (unsigned long long)g.split * tstep) + (unsigned long long)(pm_) * tstep))
    const char* cA = PG8_APANEL(cur.pm); const char* cB = (const char*)g.Bt + (size_t)cur.pn * tstep;
    PG8_STAGE(PG8_SB(0, 0), cB, voffB); PG8_STAGE(PG8_SA(0, 0), cA, voffA); PG8_STAGE(PG8_SB(0, 1), cB + hstep, voffB); PG8_STAGE(PG8_SA(0, 1), cA + hstep, voffA);
    if (wr == 1) PG8_BAR;
    PG8_WAIT_V(4); PG8_BAR;
    PG8_STAGE(PG8_SB(1, 0), cB + kstep, voffB); PG8_STAGE(PG8_SA(1, 0), cA + kstep, voffA); PG8_STAGE(PG8_SB(1, 1), cB + hstep + kstep, voffB);
    PG8_WAIT_V(6); PG8_BAR;
    for (;;) {
        const bool has_next = S.next(ui + 1, nxt);
        const char* nA = has_next ? PG8_APANEL(nxt.pm) : cA; const char* nB = has_next ? (const char*)g.Bt + (size_t)nxt.pn * tstep : cB;
        for (int t = 0; t < nt; t += 2) {
            const bool last = (t == nt - 2);
            const char* a1 = cA + (size_t)(t + 1) * kstep;
            const char* a2 = last ? nA : cA + (size_t)(t + 2) * kstep; const char* b2 = last ? nB : cB + (size_t)(t + 2) * kstep;
            const char* a3 = a2 + kstep; const char* b3 = b2 + kstep;
            PG8_LDB(B0, 0, 0); PG8_SCHED; PG8_LDA(At, 0, 0); PG8_STAGE(PG8_SA(1, 1), a1 + hstep, voffA);
            PG8_WAIT_L(8); PG8_BAR; PG8_WAIT_L(0); PG8_MMA(0, 0, At, B0); PG8_BAR; PG8_SCHED;
            PG8_LDB(B1, 0, 1); PG8_STAGE(PG8_SB(0, 0), b2, voffB);
            PG8_BAR; PG8_WAIT_L(0); PG8_MMA(0, 1, At, B1); PG8_BAR;
            PG8_LDA(At, 0, 1); PG8_STAGE(PG8_SA(0, 0), a2, voffA);
            PG8_BAR; PG8_WAIT_L(0); PG8_MMA(1, 0, At, B0); PG8_BAR; PG8_SCHED;
            PG8_STAGE(PG8_SB(0, 1), b2 + hstep, voffB);
            PG8_WAIT_V(6); PG8_BAR; PG8_MMA(1, 1, At, B1); PG8_BAR;
            PG8_LDB(B0, 1, 0); PG8_SCHED; PG8_LDA(At, 1, 0); PG8_STAGE(PG8_SA(0, 1), a2 + hstep, voffA);
            PG8_WAIT_L(8); PG8_BAR; PG8_WAIT_L(0); PG8_MMA(0, 0, At, B0); PG8_BAR; PG8_SCHED;
            PG8_LDB(B1, 1, 1); PG8_STAGE(PG8_SB(1, 0), b3, voffB);
            PG8_BAR; PG8_WAIT_L(0); PG8_MMA(0, 1, At, B1); PG8_BAR;
            PG8_LDA(At, 1, 1); PG8_STAGE(PG8_SA(1, 0), a3, voffA);
            PG8_BAR; PG8_WAIT_L(0); PG8_MMA(1, 0, At, B0); PG8_BAR; PG8_SCHED;
            PG8_STAGE(PG8_SB(1, 1), b3 + hstep, voffB);
            PG8_WAIT_V(6); PG8_BAR; PG8_MMA(1, 1, At, B1); PG8_BAR;
        }
        if (wr == 0) PG8_BAR;
        E(acc, cur, wr, wc, fr, fq);
        if (wr == 1) PG8_BAR;
        if (!has_next) break;
#pragma unroll
        for (int a = 0; a < 2; ++a)
#pragma unroll
            for (int b = 0; b < 2; ++b)
#pragma unroll
                for (int m = 0; m < 4; ++m)
#pragma unroll
                    for (int n = 0; n < 2; ++n) acc[a][b][m][n] = (f32x4){0.f, 0.f, 0.f, 0.f};
        cur = nxt; cA = nA; cB = nB; ++ui;
    }
    PG8_WAIT_V(0);
    if (wr == 0) PG8_BAR;
    PG8_BAR;
#undef PG8_APANEL
#undef PG8_SA
#undef PG8_SB
#undef PG8_STAGE
#undef PG8_LDA
#undef PG8_LDB
#undef PG8_MMA
#undef PG8_WAIT_V
#undef PG8_WAIT_L
#undef PG8_BAR
#undef PG8_SCHED
}
}

template <bool INPROJ = false>
__device__ __forceinline__ void p0_transpose_item(const float* W, int K, int ldN, int nblk, bf16_t* WT, const float* gain, LAS float* scr, int item, int lane) {
    const int kb = item / nblk, nb = item % nblk, k0 = 64 * kb, n0 = 32 * nb;
    const int dn0 = !INPROJ || n0 < 512 ? n0 : (n0 < 1024 ? 512 + ((n0 - 512) >> 7) * 256 + ((n0 - 512) & 127) : 512 + ((n0 - 1024) >> 7) * 256 + 128 + ((n0 - 1024) & 127));
    float wv[32];
#pragma unroll
    for (int i = 0; i < 32; ++i) wv[i] = W[(size_t)(k0 + 2 * i + (lane >> 5)) * ldN + n0 + (lane & 31)];
#pragma unroll
    for (int i = 0; i < 32; ++i) { const int kk = 2 * i + (lane >> 5); const float gk = gain ? gain[k0 + kk] : 1.f;
        scr[kk * 33 + (lane & 31)] = wv[i] * gk; }
    asm volatile("s_waitcnt lgkmcnt(0)" ::: "memory");
    const int c = lane & 7;
#pragma unroll
    for (int j = 0; j < 4; ++j) { const int n = (lane >> 3) + 8 * j; const LAS float* s = scr + (8 * c) * 33 + n;
        u32x4 o; o.x = cvt_pk_bf16(s[0 * 33], s[1 * 33]); o.y = cvt_pk_bf16(s[2 * 33], s[3 * 33]); o.z = cvt_pk_bf16(s[4 * 33], s[5 * 33]); o.w = cvt_pk_bf16(s[6 * 33], s[7 * 33]);
        *(u32x4*)(WT + (size_t)(dn0 + n) * K + k0 + 8 * c) = o; }
    asm volatile("s_waitcnt lgkmcnt(0)" ::: "memory");
}
__device__ __forceinline__ void p0_fold_item(const float* Win  , const float* gpre, bf16_t* WT  , const LAS float* tab, int item, int lane) {
    const int kb = item >> 3, g = item & 7, k = kb * 64 + lane;
    const float gk = gpre[k] * 0.125f;
    const f32x4* src = (const f32x4*)(Win + (size_t)k * DIN + 1536 + g * 64);
    float row[64];
#pragma unroll
    for (int i = 0; i < 16; ++i) { const f32x4 v = src[i]; row[4 * i] = v.x * gk; row[4 * i + 1] = v.y * gk; row[4 * i + 2] = v.z * gk; row[4 * i + 3] = v.w * gk; }
    for (int j = 0; j < 64; ++j) {
        const int cj = (j == 0) ? 0 : (j == 1 ? 32 : (j >> 1)), off = (j >= 2 && (j & 1)) ? 16 : 0;
        float acc = 0.f;
#pragma unroll
        for (int d = 0; d < 64; ++d) acc += row[d] * tab[(cj * d + off) & 63];
        WT[(size_t)(1536 + g * 64 + j) * D + k] = (bf16_t)(cvt_pk_bf16(acc, 0.f) & 0xffffu);
    }
}
template <int NR>
__device__ __forceinline__ void x_rows_init(const float* xrow0, bf16_t* orow0, float* rs, int lane) {
    f32x4 v[NR][4];
#pragma unroll
    for (int r = 0; r < NR; ++r) { const f32x4* xr = (const f32x4*)(xrow0 + (size_t)r * D) + lane;
#pragma unroll
        for (int j = 0; j < 4; ++j) v[r][j] = xr[64 * j]; }
#pragma unroll
    for (int r = 0; r < NR; ++r) { float s = 0.f;
#pragma unroll
        for (int j = 0; j < 4; ++j) s += (v[r][j].x * v[r][j].x + v[r][j].y * v[r][j].y) + (v[r][j].z * v[r][j].z + v[r][j].w * v[r][j].w);
        const float rstd = rsqrtf(wave_sum(s) * (1.f / D) + EPS);
        u32x2* o8 = (u32x2*)(orow0 + (size_t)r * D) + lane;
#pragma unroll
        for (int j = 0; j < 4; ++j) { u32x2 w; w.x = cvt_pk_bf16(v[r][j].x, v[r][j].y); w.y = cvt_pk_bf16(v[r][j].z, v[r][j].w); o8[64 * j] = w; }
        if (lane == 0) rs[r] = rstd; }
}

template <int NR>
__device__ __forceinline__ void row_pass_rows(bf16_t* X, const bf16_t* MF, const float* gain, float* rs, float* outf, bool unscaled, int t0, int lane) {
    u32x4 xa[NR][2], ma[NR][2];
#pragma unroll
    for (int r = 0; r < NR; ++r) { const u32x4* xr = (const u32x4*)(X + (size_t)(t0 + r) * D); const u32x4* mr = (const u32x4*)(MF + (size_t)(t0 + r) * D);
        xa[r][0] = xr[lane]; xa[r][1] = xr[64 + lane]; ma[r][0] = mr[lane]; ma[r][1] = mr[64 + lane]; }
    float g[16];
    { const f32x4* g0 = (const f32x4*)(gain + lane * 8); const f32x4* g1 = (const f32x4*)(gain + 512 + lane * 8);
#pragma unroll
      for (int h = 0; h < 2; ++h) { const f32x4 a = g0[h], b = g1[h];
#pragma unroll
        for (int k = 0; k < 4; ++k) { g[4 * h + k] = a[k]; g[8 + 4 * h + k] = b[k]; } } }
#pragma unroll
    for (int r = 0; r < NR; ++r) {
        float x[16], m[16];
#pragma unroll
        for (int h = 0; h < 2; ++h) { const u32x4 xq = xa[r][h], mq = ma[r][h];
            x[8 * h + 0] = bf_lo(xq.x); x[8 * h + 1] = bf_hi(xq.x); x[8 * h + 2] = bf_lo(xq.y); x[8 * h + 3] = bf_hi(xq.y); x[8 * h + 4] = bf_lo(xq.z); x[8 * h + 5] = bf_hi(xq.z); x[8 * h + 6] = bf_lo(xq.w); x[8 * h + 7] = bf_hi(xq.w);
            m[8 * h + 0] = bf_lo(mq.x); m[8 * h + 1] = bf_hi(mq.x); m[8 * h + 2] = bf_lo(mq.y); m[8 * h + 3] = bf_hi(mq.y); m[8 * h + 4] = bf_lo(mq.z); m[8 * h + 5] = bf_hi(mq.z); m[8 * h + 6] = bf_lo(mq.w); m[8 * h + 7] = bf_hi(mq.w); }
        float sm = 0.f;
#pragma unroll
        for (int k = 0; k < 16; ++k) sm += m[k] * m[k];
        float eps_eff = EPS; if (unscaled) { const float rr = rs[t0 + r], r2 = rr * rr; eps_eff = EPS / (r2 * r2); }
        const float rm = rsqrtf(wave_sum(sm) * (1.f / D) + eps_eff);
        float s1 = 0.f;
#pragma unroll
        for (int k = 0; k < 16; ++k) { x[k] = x[k] + m[k] * rm * g[k]; s1 += x[k] * x[k]; }
        if (outf) {
            f32x4* o = (f32x4*)(outf + (size_t)(t0 + r) * D);
            o[lane * 2] = (f32x4){x[0], x[1], x[2], x[3]}; o[lane * 2 + 1] = (f32x4){x[4], x[5], x[6], x[7]};
            o[128 + lane * 2] = (f32x4){x[8], x[9], x[10], x[11]}; o[128 + lane * 2 + 1] = (f32x4){x[12], x[13], x[14], x[15]};
        } else {
            const float r1 = rsqrtf(wave_sum(s1) * (1.f / D) + EPS);
            u32x4* xo = (u32x4*)(X + (size_t)(t0 + r) * D);
            u32x4 w0, w1;
            w0.x = cvt_pk_bf16(x[0], x[1]); w0.y = cvt_pk_bf16(x[2], x[3]); w0.z = cvt_pk_bf16(x[4], x[5]); w0.w = cvt_pk_bf16(x[6], x[7]);
            w1.x = cvt_pk_bf16(x[8], x[9]); w1.y = cvt_pk_bf16(x[10], x[11]); w1.z = cvt_pk_bf16(x[12], x[13]); w1.w = cvt_pk_bf16(x[14], x[15]);
            xo[lane] = w0; xo[64 + lane] = w1;
            if (lane == 0) rs[t0 + r] = r1;
        }
    }
}

__device__ __forceinline__ void conv_wave_item(const bf16_t* p, const float* cw, bf16_t* Hm, int t0, int pos0, int S, int lane) {
    float w0[8], w1[8], w2[8];
    { const f32x4* a = (const f32x4*)(cw + lane * 8); const f32x4* b = (const f32x4*)(cw + 512 + lane * 8); const f32x4* c = (const f32x4*)(cw + 1024 + lane * 8);
#pragma unroll
      for (int h = 0; h < 2; ++h) { const f32x4 va = a[h], vb = b[h], vc = c[h];
#pragma unroll
        for (int k = 0; k < 4; ++k) { w0[4 * h + k] = va[k]; w1[4 * h + k] = vb[k]; w2[4 * h + k] = vc[k]; } } }
    float zp[8], zc[8], zn[8], gb[8];
    const bf16_t* base = p + (size_t)t0 * PLD + lane * 8;
    if (pos0 == 0) {
#pragma unroll
        for (int k = 0; k < 8; ++k) zp[k] = 0.f;
    } else load8(base - PLD + 512, zp);
    load8(base + 512, zc);
#pragma unroll 8
    for (int i = 0; i < 16; ++i) {
        const bf16_t* r = base + (size_t)i * PLD;
        if (pos0 + i + 1 == S) {
#pragma unroll
            for (int k = 0; k < 8; ++k) zn[k] = 0.f;
        } else load8(r + PLD + 512, zn);
        load8(r, gb);
        float y[8], ss = 0.f;
#pragma unroll
        for (int k = 0; k < 8; ++k) { y[k] = gb[k] * (zp[k] * w0[k] + zc[k] * w1[k] + zn[k] * w2[k]); ss += y[k] * y[k]; }
        ss = xadd4(xadd2(xadd1(ss)));
        const float rs = rsqrtf(ss * (1.f / 64.f) + EPS);
        u32x4 o; o.x = cvt_pk_bf16(y[0] * rs, y[1] * rs); o.y = cvt_pk_bf16(y[2] * rs, y[3] * rs); o.z = cvt_pk_bf16(y[4] * rs, y[5] * rs); o.w = cvt_pk_bf16(y[6] * rs, y[7] * rs);
        *(u32x4*)(Hm + (size_t)(t0 + i) * D + lane * 8) = o;
#pragma unroll
        for (int k = 0; k < 8; ++k) { zp[k] = zc[k]; zc[k] = zn[k]; }
    }
}

constexpr int XSTR = 272;
constexpr int RSTR = 34;
constexpr int LDS_XT = 0, LDS_R = 36864, LDS_OST = 106496;
#define LBAR() do { asm volatile("s_waitcnt lgkmcnt(0)" ::: "memory"); __builtin_amdgcn_s_barrier(); asm volatile("" ::: "memory"); } while (0)
__device__ __forceinline__ int seq_base(int bs) { return bs < BP ? bs * SP : TP + (bs - BP) * SS; }

__device__ __forceinline__ void dft_frags(bf16x8 (&Br)[4], bf16x8 (&Bi)[4], int log2n, int kt, int lane) {
    const int N = 1 << log2n, k = 16 * kt + (lane & 15); const float sc = 2.f / (float)N;
#pragma unroll
    for (int ks = 0; ks < 4; ++ks) { u32x4 wr, wi;
#pragma unroll
        for (int e2 = 0; e2 < 4; ++e2) { float c0, s0, c1, s1; const int n0 = 32 * ks + 8 * (lane >> 4) + 2 * e2;
            sincospif(-(float)((n0 * k) & (N - 1)) * sc, &s0, &c0); sincospif(-(float)(((n0 + 1) * k) & (N - 1)) * sc, &s1, &c1);
            wr[e2] = cvt_pk_bf16(c0, c1); wi[e2] = cvt_pk_bf16(s0, s1); }
        Br[ks] = __builtin_bit_cast(bf16x8, wr); Bi[ks] = __builtin_bit_cast(bf16x8, wi); }
}
template <int XS = XSTR>
__device__ __forceinline__ void xt_write(LAS unsigned char* xt, int rp, int ch, const u32x4 va, const u32x4 vb) {
    LAS unsigned char* base = xt + (8 * ch) * XS + ((((rp >> 2) ^ ch) << 4) + (rp & 3) * 4);
#pragma unroll
    for (int e2 = 0; e2 < 4; ++e2) {
        *(LAS unsigned*)(base + (2 * e2) * XS) = (va[e2] & 0xffffu) | (vb[e2] << 16);
        *(LAS unsigned*)(base + (2 * e2 + 1) * XS) = (va[e2] >> 16) | (vb[e2] & 0xffff0000u); }
}
template <int XS = XSTR>
__device__ __forceinline__ void dft_mfma(const LAS unsigned char* xt, int log2n, const bf16x8 (&Br)[4], const bf16x8 (&Bi)[4], f32x4 (&Pa)[4], f32x4 (&Qa)[4], int lane) {
#pragma unroll
    for (int it = 0; it < 4; ++it) { Pa[it] = (f32x4){0.f, 0.f, 0.f, 0.f}; Qa[it] = (f32x4){0.f, 0.f, 0.f, 0.f}; }
#pragma unroll
    for (int ks = 0; ks < 4; ++ks) if (ks < (1 << (log2n - 5))) {
#pragma unroll
        for (int it = 0; it < 4; ++it) { const int col = 16 * it + (lane & 15), gr = 4 * ks + (lane >> 4);
            const bf16x8 a = *(const LAS bf16x8*)(xt + col * XS + ((gr ^ (col >> 3)) << 4));
            Pa[it] = __builtin_amdgcn_mfma_f32_16x16x32_bf16(a, Br[ks], Pa[it], 0, 0, 0);
            Qa[it] = __builtin_amdgcn_mfma_f32_16x16x32_bf16(a, Bi[ks], Qa[it], 0, 0, 0); } }
}

__device__ __forceinline__ void p1_decode(int item, int& bs, int& g, int& n2, int& S, int& log2N2) {
    if (item < 2048) { bs = item >> 10; const int r = item & 1023; n2 = r >> 3; g = r & 7; S = SP; log2N2 = 7; }
    else { const int it = item - 2048; bs = BP + (it >> 9); const int r = it & 511; n2 = r >> 3; g = r & 7; S = SS; log2N2 = 6; }
}
__device__ __forceinline__ void p1_load(const bf16_t* p, int item, int rp, int ch, u32x4& va, u32x4& vb) {
    int bs, g, n2, S, l2; p1_decode(item, bs, g, n2, S, l2);
    const bf16_t* src = p + (size_t)(seq_base(bs) + ((2 * rp) << l2) + n2) * PLD + 1024 + g * 64 + ch * 8;
    va = *(const u32x4*)src; vb = *(const u32x4*)(src + ((size_t)PLD << l2));
}
__device__ __forceinline__ void fft_pass1(const bf16_t* p, bf16_t* inter, LAS unsigned char* lds, int bid, int G, int tid) {
    constexpr int NP1 = 2048 + 4096;
    const int lane = tid & 63, wave = __builtin_amdgcn_readfirstlane(tid >> 6), rp = tid >> 3, ch = tid & 7;
    bf16x8 Br[4], Bi[4]; dft_frags(Br, Bi, 7, wave, lane);
    u32x4 va, vb;
    if (bid < NP1) p1_load(p, bid, rp, ch, va, vb);
    int par = 0;
    for (int item = bid; item < NP1; item += G, par ^= 1) {
        LAS unsigned char* xt = lds + LDS_XT + par * (64 * XSTR);
        xt_write(xt, rp, ch, va, vb);
        if (item + G < NP1) p1_load(p, item + G, rp, ch, va, vb);
        LBAR();
        f32x4 Pa[4], Qa[4]; dft_mfma(xt, 7, Br, Bi, Pa, Qa, lane);
        int bs, g, n2, S, l2; p1_decode(item, bs, g, n2, S, l2);
        const int k1 = 16 * wave + (lane & 15), quad = lane >> 4;
        float sn, cs; sincospif(-2.0f * (float)(n2 * k1) / (float)S, &sn, &cs);
        bf16_t* dst = inter + ((size_t)seq_base(bs) * 8 + (size_t)g * S + ((size_t)k1 << l2) + n2) * 64 + 4 * quad;
#pragma unroll
        for (int it = 0; it < 4; ++it) {
            const float r0 = Pa[it][0] - Qa[it][1], i0 = Pa[it][1] + Qa[it][0], r1 = Pa[it][2] - Qa[it][3], i1 = Pa[it][3] + Qa[it][2];
            u32x2 w; w.x = cvt_pk_bf16(r0 * cs - i0 * sn, r0 * sn + i0 * cs); w.y = cvt_pk_bf16(r1 * cs - i1 * sn, r1 * sn + i1 * cs);
            *(u32x2*)(dst + 16 * it) = w; }
    }
    LBAR();
}

template <int LOG2N, int NT>
__device__ __forceinline__ void p2_assemble(const LAS f32x2* R, bf16_t* Hm, int tb, int g, int ipbase, float sc, int tid) {
    constexpr int N2 = 1 << LOG2N;
#pragma unroll
    for (int rep_ = 0; rep_ < (NT * N2 * 4) / NTHREADS; ++rep_) {
        const int task = tid + NTHREADS * rep_, q = task & 3, tl = task >> 2, h = tl >> LOG2N, k2 = tl & (N2 - 1), ip = ipbase + (h >> 1);
        const int ph = (ip == 0) ? h : (h ^ 1);
        const int k2p = (ip == 0 && (h & 1) == 0) ? ((N2 - k2) & (N2 - 1)) : (N2 - 1 - k2);
        const LAS f32x4* po = (const LAS f32x4*)(R + (h * N2 + k2) * RSTR + 8 * q);
        const LAS f32x4* pp = (const LAS f32x4*)(R + (ph * N2 + k2p) * RSTR + 8 * q);
        f32x4 o[4], p[4];
#pragma unroll
        for (int i = 0; i < 4; ++i) { o[i] = po[i]; p[i] = pp[i]; }
        float v1[8], v2[8], ss = 0.f;
#pragma unroll
        for (int j = 0; j < 8; ++j) { v1[j] = o[j >> 1][(j & 1) * 2] * sc; v2[j] = p[j >> 1][(j & 1) * 2] * sc; }
        if (q == 0) { v1[0] = 0.5f * (o[0][0] + p[0][0]) * sc; v2[0] = 0.5f * (o[0][1] + p[0][1]) * sc; }
#pragma unroll
        for (int j = 0; j < 8; ++j) ss += v1[j] * v1[j] + v2[j] * v2[j];
        ss = xadd2(xadd1(ss));
        const float rs = rsqrtf(ss * (1.f / 64.f) + EPS);
        const float nb = dpp_f<0x39>(v2[0]);
        const int hl = h & 1, k1 = hl == 0 ? ip : (ip == 0 ? 64 : 128 - ip);
        bf16_t* dst = Hm + (size_t)(tb + k1 + 128 * k2) * D + 512 + g * 64;
        u32x4 w0, w1;
        w0.x = cvt_pk_bf16(v1[0] * rs, v1[1] * rs); w0.y = cvt_pk_bf16(v1[2] * rs, v1[3] * rs); w0.z = cvt_pk_bf16(v1[4] * rs, v1[5] * rs); w0.w = cvt_pk_bf16(v1[6] * rs, v1[7] * rs);
        w1.x = cvt_pk_bf16(nb * rs, v2[7] * rs); w1.y = cvt_pk_bf16(v2[6] * rs, v2[5] * rs); w1.z = cvt_pk_bf16(v2[4] * rs, v2[3] * rs); w1.w = cvt_pk_bf16(v2[2] * rs, v2[1] * rs);
        *(u32x4*)(dst + 8 * q) = w0; *(u32x4*)(dst + 56 - 8 * q) = w1;
    }
}

__device__ __forceinline__ void p2_decode(int item, int& bs, int& g, int& k1a, int& k1b, int& ip) {
    int r;
    if (item < 1024) { bs = item >> 9; r = item & 511; } else { const int it = item - 1024; bs = BP + (it >> 9); r = it & 511; }
    g = r >> 6; ip = r & 63; k1a = ip; k1b = ip == 0 ? 64 : 128 - ip;
}
template <int LOG2N>
__device__ __forceinline__ void fft_pass2(const bf16_t* inter, bf16_t* Hm, LAS unsigned char* lds, int item0, int item_end, int G, int tid) {
    constexpr int N2 = 1 << LOG2N, NTASK = N2 / 64, S = (LOG2N == 7) ? SP : SS;
    const int lane = tid & 63, wave = __builtin_amdgcn_readfirstlane(tid >> 6);
    bf16x8 Br[4], Bi[4]; dft_frags(Br, Bi, LOG2N, LOG2N == 7 ? wave : (wave & 3), lane);
    u32x4 va[NTASK], vb[NTASK];
#define P2_LOAD(item_) do { int bs_, g_, ka_, kb_, ip_; p2_decode(item_, bs_, g_, ka_, kb_, ip_); \
        const bf16_t* ib_ = inter + ((size_t)seq_base(bs_) * 8 + (size_t)g_ * S) * 64; \
        _Pragma("unroll") for (int j = 0; j < NTASK; ++j) { const int q = tid + NTHREADS * j, h = q / (4 * N2), r = q % (4 * N2), rp = r >> 3, ch = r & 7; \
            const bf16_t* src = ib_ + ((size_t)((h ? kb_ : ka_) * N2 + 2 * rp)) * 64 + ch * 8; va[j] = *(const u32x4*)src; vb[j] = *(const u32x4*)(src + 64); } } while (0)
    if (item0 < item_end) P2_LOAD(item0);
    LAS f32x2* R = (LAS f32x2*)(lds + LDS_R);
    LAS bf16_t* Ost = (LAS bf16_t*)(lds + LDS_OST);
    const float sc = rsqrtf((float)S);
    for (int item = item0; item < item_end; item += G) {
#pragma unroll
        for (int j = 0; j < NTASK; ++j) { const int q = tid + NTHREADS * j, h = q / (4 * N2), r = q % (4 * N2);
            xt_write(lds + LDS_XT + h * (64 * XSTR), r >> 3, r & 7, va[j], vb[j]); }
        if (item + G < item_end) P2_LOAD(item + G);
        LBAR();
        {
            f32x4 Pa[4], Qa[4]; const int quad = lane >> 4;
#pragma unroll
            for (int hh = 0; hh < (LOG2N == 7 ? 2 : 1); ++hh) {
                const int h = (LOG2N == 7) ? hh : (wave >> 2), kt = (LOG2N == 7) ? wave : (wave & 3);
                dft_mfma(lds + LDS_XT + h * (64 * XSTR), LOG2N, Br, Bi, Pa, Qa, lane);
                LAS f32x2* Rr = R + (h * N2 + 16 * kt + (lane & 15)) * RSTR + 2 * quad;
#pragma unroll
                for (int it = 0; it < 4; ++it)
                    *(LAS f32x4*)(Rr + 8 * it) = (f32x4){Pa[it][0] - Qa[it][1], Pa[it][1] + Qa[it][0], Pa[it][2] - Qa[it][3], Pa[it][3] + Qa[it][2]};
            }
        }
        LBAR();
        int bs, g, k1a, k1b, ip; p2_decode(item, bs, g, k1a, k1b, ip);
        const int tb = seq_base(bs);
        p2_assemble<LOG2N, 2>(R, Hm, tb, g, ip, sc, tid);
    }
    LBAR();
#undef P2_LOAD
}

__device__ __forceinline__ void fft_pass2s(const bf16_t* inter, bf16_t* Hm, LAS unsigned char* lds, int item0, int item_end, int G, int tid) {
    constexpr int N2 = 64, XS6 = 144, S = SS;
    const int lane = tid & 63, wave = __builtin_amdgcn_readfirstlane(tid >> 6);
    bf16x8 Br[4], Bi[4]; dft_frags(Br, Bi, 6, wave & 3, lane);
    u32x4 va[2], vb[2];
#define P2S_K1(ip_, hl_) ((hl_) == 0 ? (ip_) : ((ip_) == 0 ? 64 : 128 - (ip_)))
#define P2S_LOAD(item_) do { const int bs_ = BP + ((item_) >> 8), r_ = (item_) & 255, g_ = r_ >> 5, jp_ = r_ & 31; \
        const bf16_t* ib_ = inter + ((size_t)seq_base(bs_) * 8 + (size_t)g_ * S) * 64; \
        _Pragma("unroll") for (int j = 0; j < 2; ++j) { const int q = tid + NTHREADS * j, h = q >> 8, r = q & 255, rp = r >> 3, ch = r & 7, ip_ = 2 * jp_ + (h >> 1); \
            const bf16_t* src = ib_ + ((size_t)(P2S_K1(ip_, h & 1) * N2 + 2 * rp)) * 64 + ch * 8; va[j] = *(const u32x4*)src; vb[j] = *(const u32x4*)(src + 64); } } while (0)
    if (item0 < item_end) P2S_LOAD(item0);
    LAS f32x2* R = (LAS f32x2*)(lds + LDS_R);
    LAS bf16_t* Ost = (LAS bf16_t*)(lds + LDS_OST);
    const float sc = rsqrtf((float)S);
    for (int item = item0; item < item_end; item += G) {
#pragma unroll
        for (int j = 0; j < 2; ++j) { const int q = tid + NTHREADS * j, h = q >> 8, r = q & 255;
            xt_write<XS6>(lds + LDS_XT + h * (64 * XS6), r >> 3, r & 7, va[j], vb[j]); }
        if (item + G < item_end) P2S_LOAD(item + G);
        LBAR();
        {
            f32x4 Pa[4], Qa[4]; const int quad = lane >> 4, kt = wave & 3;
#pragma unroll
            for (int hh = 0; hh < 2; ++hh) { const int h = (wave >> 2) + 2 * hh;
                dft_mfma<XS6>(lds + LDS_XT + h * (64 * XS6), 6, Br, Bi, Pa, Qa, lane);
                LAS f32x2* Rr = R + (h * N2 + 16 * kt + (lane & 15)) * RSTR + 2 * quad;
#pragma unroll
                for (int it = 0; it < 4; ++it)
                    *(LAS f32x4*)(Rr + 8 * it) = (f32x4){Pa[it][0] - Qa[it][1], Pa[it][1] + Qa[it][0], Pa[it][2] - Qa[it][3], Pa[it][3] + Qa[it][2]};
            }
        }
        LBAR();
        const int bs = BP + (item >> 8), rr = item & 255, g = rr >> 5, jp = rr & 31, tb = seq_base(bs);
        p2_assemble<6, 4>(R, Hm, tb, g, 2 * jp, sc, tid);
    }
    LBAR();
#undef P2S_LOAD
#undef P2S_K1
}

#define XB_TMO      128
#define XB_XCNT(j)  (256  + 64 * (j))
#define XB_XSUB(j)  (1280 + 64 * (j))
#define XB_XGEN(j)  (2304 + 64 * (j))
#define XB_TOP      3328
#define XB_TOPGEN   3392
#define XCD_BAR_WORDS 3456
#define XB_SPIN_CAP (1u << 20)
__device__ __forceinline__ unsigned xb_ld(unsigned* p)              { return __hip_atomic_load(p, __ATOMIC_RELAXED, __HIP_MEMORY_SCOPE_AGENT); }
__device__ __forceinline__ unsigned xb_add(unsigned* p, unsigned v) { return __hip_atomic_fetch_add(p, v, __ATOMIC_RELAXED, __HIP_MEMORY_SCOPE_AGENT); }
__device__ __forceinline__ unsigned xb_xcc_id() { return (unsigned)__builtin_amdgcn_s_getreg((3 << 11) | 20) & 0xFu; }
#define XB_SPIN(cond, bar) do { unsigned _sp = 0; while (cond) { __builtin_amdgcn_s_sleep(1); \
    if ((++_sp & 255u) == 0u) { if (xb_ld(&(bar)[XB_TMO])) break; if (_sp > XB_SPIN_CAP) { atomicAdd(&(bar)[XB_TMO], 1u); break; } } } } while (0)
struct XcdBarrier { unsigned* bar; unsigned x; volatile LAS unsigned* st; };
__device__ __forceinline__ XcdBarrier xcd_barrier_post(unsigned* bar, volatile LAS unsigned* st) {
    XcdBarrier b; b.bar = bar; b.x = xb_xcc_id(); b.st = st;
    if (threadIdx.x == 0) (void)xb_add(&bar[XB_XCNT(b.x)], 1u);
    return b;
}
__device__ __forceinline__ void xcd_barrier_complete(unsigned* bar, unsigned x, unsigned& nloc, unsigned& nx) {
    const unsigned G = gridDim.x * gridDim.y * gridDim.z;
    unsigned sum, cnt, mine, sp = 0u;
    for (;;) {
        sum = 0u; cnt = 0u; mine = 0u;
#pragma unroll
        for (unsigned j = 0; j < 16; ++j) { const unsigned c = xb_ld(&bar[XB_XCNT(j)]); sum += c; cnt += (c > 0u) ? 1u : 0u; mine = (j == x) ? c : mine; }
        if (sum == G) break;
        __builtin_amdgcn_s_sleep(1);
        if ((++sp & 255u) == 0u) { if (xb_ld(&bar[XB_TMO])) break; if (sp > XB_SPIN_CAP) { atomicAdd(&bar[XB_TMO], 1u); break; } }
    }
    nloc = mine > 0u ? mine : 1u; nx = cnt > 0u ? cnt : 1u;
}
__device__ __forceinline__ void xcd_barrier(const XcdBarrier& b) {
    asm volatile("s_waitcnt vmcnt(0)" ::: "memory");
    __syncthreads();
    if (threadIdx.x == 0) {
        unsigned* bar = b.bar;
        __builtin_amdgcn_s_waitcnt(0);
        unsigned nloc = b.st[0], nx = b.st[1];
        if (nloc == 0u) { xcd_barrier_complete(bar, b.x, nloc, nx); b.st[0] = nloc; b.st[1] = nx; }
        const unsigned old = xb_add(&bar[XB_XSUB(b.x)], 1u);
        const unsigned gen = old / nloc;
        if (old + 1u == (gen + 1u) * nloc) {
            __builtin_amdgcn_fence(__ATOMIC_RELEASE, "agent");
            asm volatile("s_waitcnt vmcnt(0)" ::: "memory");
            const unsigned og = xb_add(&bar[XB_TOP], 1u);
            const unsigned tg = og / nx;
            if (og + 1u == (tg + 1u) * nx) xb_add(&bar[XB_TOPGEN], 1u);
            else XB_SPIN(xb_ld(&bar[XB_TOPGEN]) == tg, bar);
            __builtin_amdgcn_fence(__ATOMIC_ACQUIRE, "agent");
            xb_add(&bar[XB_XGEN(b.x)], 1u);
            asm volatile("s_waitcnt vmcnt(0)" ::: "memory");
        } else {
            XB_SPIN(xb_ld(&bar[XB_XGEN(b.x)]) == gen, bar);
            __builtin_amdgcn_fence(__ATOMIC_ACQUIRE, "agent");
            asm volatile("s_waitcnt vmcnt(0)" ::: "memory");
        }
    }
    __syncthreads();
}

__global__ void __launch_bounds__(NTHREADS, 2) fwd_megakernel(Params P) {
    extern __shared__ __attribute__((aligned(16))) unsigned char shm[];
    cg::grid_group grid = cg::this_grid();
    LAS unsigned char* lds = (LAS unsigned char*)shm;
    const int G = gridDim.x, bid = blockIdx.x, NGW = G * NWAVES;
#define FRESH() int tid = threadIdx.x; asm volatile("" : "+v"(tid)); const int lane = tid & 63, wave = __builtin_amdgcn_readfirstlane(tid >> 6), gw = bid * NWAVES + wave; (void)lane; (void)gw
#define TAB ((LAS float*)(lds + LDS_MISC))
    { FRESH();
      if (tid < 64) TAB[tid] = cospif((float)tid * (1.f / 32.f));
      if (tid < 4) ((volatile LAS unsigned*)(lds + LDS_MISC + 1024))[tid] = 0u; }
    __syncthreads();
    const XcdBarrier xbar = xcd_barrier_post((unsigned*)P.ws, (volatile LAS unsigned*)(lds + LDS_MISC + 1024));
#define GSYNC() xcd_barrier(xbar)

    unsigned char* ws = P.ws;
#define Xb ((bf16_t*)(ws + WS_X))
#define Hb ((bf16_t*)(ws + WS_H))
#define Pb ((bf16_t*)P.out)
#define Ib ((bf16_t*)(ws + WS_INTER))
#define MFb ((bf16_t*)(ws + WS_MF))
#define A0b ((bf16_t*)(ws + WS_H))
#define A1b ((bf16_t*)P.out)
#define RSb ((float*)(ws + WS_RS))

    {
        FRESH();
        LAS float* scr = (LAS float*)(lds + wave * 8704);
        constexpr int I_IN = 16 * 48, I_OUT = 16 * 32, I_UP = 16 * 128, I_DN = 64 * 32, I_F = 128, I_L = I_IN + I_OUT + I_UP + I_DN + I_F;
        for (int it = gw; it < NL * I_L; it += NGW) {
            const int l = it / I_L; int r = it % I_L;
            bf16_t* Wl = (bf16_t*)(ws + WS_W + (size_t)l * WL_SZ);
            const float* win = P.w_in + (size_t)l * D * DIN;
            if (r < I_IN) { p0_transpose_item<true>(win, D, DIN, 48, Wl + WL_IN / 2, P.g_mix_pre + l * D, scr, r, lane); continue; } r -= I_IN;
            if (r < I_OUT) {
                const int kb = r / 32; const float* gsrc = kb < 8 ? P.g_conv_out + l * 512 : P.g_fourier_out + l * 512 - 512;
                p0_transpose_item(P.w_out + (size_t)l * D * D, D, D, 32, Wl + WL_OUT / 2, gsrc, scr, r, lane); continue; } r -= I_OUT;
            if (r < I_UP) { p0_transpose_item(P.w_up + (size_t)l * D * DFF, D, DFF, 128, Wl + WL_UP / 2, P.g_mlp_pre + l * D, scr, r, lane); continue; } r -= I_UP;
            if (r < I_DN) { p0_transpose_item(P.w_down + (size_t)l * DFF * D, DFF, D, 32, Wl + WL_DN / 2, nullptr, scr, r, lane); continue; } r -= I_DN;
            p0_fold_item(win, P.g_mix_pre + l * D, Wl + WL_IN / 2, TAB, r, lane);
        }
        for (int t = gw * 4; t < T; t += NGW * 4) x_rows_init<4>(t < TP ? P.xp + (size_t)t * D : P.xs + (size_t)(t - TP) * D, Xb + (size_t)t * D, RSb + t, lane);
    }
    grid.sync();

    for (int l = 0; l < NL; ++l) {
        const bf16_t* Wl = (const bf16_t*)(ws + WS_W + (size_t)l * WL_SZ);
        { pg8::Gemm g{Xb, Wl + WL_IN / 2, T, DIN, D, nullptr, 1 << 20}; pg8::StaticOrder S; S.init(T, DIN, G, bid); pg8::EpiInProj E{Pb, RSb};
          pg8::gemm_phase(lds, g, S, E); }
        GSYNC();
        {
            FRESH();
            constexpr int NCONV = T / 128;
            for (int it = bid; it < NCONV; it += G) { const int t0 = it * 128 + wave * 16; const int S = t0 < TP ? SP : SS; const int pos0 = t0 < TP ? (t0 & (SP - 1)) : ((t0 - TP) & (SS - 1));
                conv_wave_item(Pb, P.conv_w + (size_t)l * 3 * 512, Hb, t0, pos0, S, lane); }
            fft_pass1(Pb, Ib, lds, bid, G, tid);
        }
        GSYNC();
        { FRESH(); fft_pass2<7>(Ib, Hb, lds, bid, 1024, G, tid); }
        { FRESH(); fft_pass2s(Ib, Hb, lds, bid, 2048, G, tid); }
        GSYNC();
        { pg8::Gemm g{Hb, Wl + WL_OUT / 2, T, D, D, nullptr, 1 << 20}; pg8::StaticOrder S; S.init(T, D, G, bid); pg8::EpiBf16 E{MFb, D, 0, nullptr, nullptr, 1 << 20};
          pg8::gemm_phase(lds, g, S, E); }
        GSYNC();
        { FRESH();
          for (int t = gw * 8; t < T; t += NGW * 8) row_pass_rows<8>(Xb, MFb, P.g_mix_post + l * D, RSb, nullptr, false, t, lane); }
        GSYNC();
        { pg8::Gemm g{Xb, Wl + WL_UP / 2, T, DFF, D, nullptr, 1 << 20}; pg8::StaticOrder S; S.init(T, DFF, G, bid); pg8::EpiBf16 E{A0b, DFF, 1, nullptr, A1b, TCH / 256};
          pg8::gemm_phase(lds, g, S, E); }
        GSYNC();
        { pg8::Gemm g{A0b, Wl + WL_DN / 2, T, D, DFF, A1b, TCH / 256}; pg8::StaticOrder S; S.init(T, D, G, bid); pg8::EpiBf16 E{MFb, D, 0, nullptr, nullptr, 1 << 20};
          pg8::gemm_phase(lds, g, S, E); }
        GSYNC();
        { FRESH();
          float* outf = (l + 1 < NL) ? nullptr : P.out;
          for (int t = gw * 8; t < T; t += NGW * 8) row_pass_rows<8>(Xb, MFb, P.g_mlp_post + l * D, RSb, outf, true, t, lane); }
        if (l + 1 < NL) GSYNC();
    }
}

extern "C" void kernel_launch(void* const* d_in, const int* in_sizes, int n_in, void* d_out, int out_size, void* d_ws, size_t ws_size, hipStream_t stream) {
    static int grid_blocks = 0;
    if (grid_blocks == 0) {
        if (n_in != 13 || out_size != T * D || ws_size < WS_END) { fprintf(stderr, "kernel_launch: unexpected shapes (n_in %d, out %d, ws %zu, need %zu)\n", n_in, out_size, ws_size, (size_t)WS_END); grid_blocks = -1; return; }
        int dev = 0, cus = 0, per_cu = 0;
        hipGetDevice(&dev);
        hipDeviceGetAttribute(&cus, hipDeviceAttributeMultiprocessorCount, dev);
        if (hipFuncSetAttribute((const void*)fwd_megakernel, hipFuncAttributeMaxDynamicSharedMemorySize, LDS_BYTES) != hipSuccess) { fprintf(stderr, "kernel_launch: hipFuncSetAttribute failed\n"); grid_blocks = -1; return; }
        hipOccupancyMaxActiveBlocksPerMultiprocessor(&per_cu, (const void*)fwd_megakernel, NTHREADS, LDS_BYTES);
        if (per_cu < 1) { fprintf(stderr, "kernel_launch: occupancy query says %d blocks per CU\n", per_cu); per_cu = 1; }
        grid_blocks = cus * per_cu;
    }
    if (grid_blocks < 0) return;
    Params p{};
    p.xp = (const float*)d_in[0]; p.xs = (const float*)d_in[1]; p.g_mix_pre = (const float*)d_in[2]; p.w_in = (const float*)d_in[3]; p.conv_w = (const float*)d_in[4];
    p.g_conv_out = (const float*)d_in[5]; p.g_fourier_out = (const float*)d_in[6]; p.w_out = (const float*)d_in[7]; p.g_mix_post = (const float*)d_in[8];
    p.g_mlp_pre = (const float*)d_in[9]; p.w_up = (const float*)d_in[10]; p.w_down = (const float*)d_in[11]; p.g_mlp_post = (const float*)d_in[12];
    p.out = (float*)d_out; p.ws = (unsigned char*)d_ws;
    if (hipMemsetAsync(d_ws, 0, 16384, stream) != hipSuccess) { fprintf(stderr, "kernel_launch: memset failed\n"); return; }
    void* args[] = {&p};
    hipError_t e = hipLaunchCooperativeKernel((const void*)fwd_megakernel, dim3(grid_blocks), dim3(NTHREADS), args, LDS_BYTES, stream);
    if (e != hipSuccess) fprintf(stderr, "cooperative launch failed: %s (grid %d)\n", hipGetErrorString(e), grid_blocks);
}
```
